# Optimizing an MI355X kernel written in HIP

```python
import jax, jax.numpy as jnp
from jax import lax
import numpy as np

D_MODEL = 1024
BATCH = 8
SEQ = 4096
DEPTH = 1

ATTN_HEADS = 8
HEAD_DIM = D_MODEL // 16
ATTN_WIDTH = ATTN_HEADS * HEAD_DIM
DILATED_BRANCHES = ((128, 1), (512, 4), (2048, 16))
ATTN_BLOCK = 128
SGU_GROUPS = 8
SGU_GROUP_DIM = D_MODEL // 16
SGU_WIDTH = SGU_GROUPS * SGU_GROUP_DIM
SGU_CHUNK = 128
MIX_WIDTH = ATTN_WIDTH + SGU_WIDTH
IN_WIDTH = 3 * ATTN_WIDTH + 2 * SGU_WIDTH
PEER_HEADS = 8
PEER_KEY_DIM = 256
N_SUB_KEYS = 128
N_EXPERTS = N_SUB_KEYS * N_SUB_KEYS
PEER_TOPK = 16
PEER_TOKEN_BLOCK = 128
EPS = 1e-6
NEG_INF = -1e30

kernel_name = 'hybrid_dilated_attn_sgu_peer_layer'


def rms_norm(x, g):
    xf = x.astype(jnp.float32)
    y = xf * lax.rsqrt(jnp.mean(xf * xf, axis=-1, keepdims=True) + EPS)
    return (y * g.astype(jnp.float32)).astype(x.dtype)


def alibi_slopes(n_heads):
    i = jnp.arange(1, n_heads + 1, dtype=jnp.float32)
    return jnp.exp2(-8.0 * i / n_heads)


def dilated_branch(q, k, v, slopes, window, dilation):
    b, s, h, dh = q.shape
    sub_len = s // dilation
    w_sub = window // dilation
    c = ATTN_BLOCK
    n = -(-sub_len // c)
    padded = n * c

    def to_sub(t):
        t = t.reshape(b, sub_len, dilation, h, dh).transpose(0, 2, 3, 1, 4)
        return jnp.pad(t, ((0, 0), (0, 0), (0, 0), (0, padded - sub_len), (0, 0)))

    def band(t):
        tp = jnp.pad(t, ((0, 0), (0, 0), (0, 0), (c, 0), (0, 0)))
        prev = tp[:, :, :, :padded].reshape(b, dilation, h, n, c, dh)
        cur = t.reshape(b, dilation, h, n, c, dh)
        return jnp.concatenate([prev, cur], axis=4)

    qs, ks, vs = to_sub(q), to_sub(k), to_sub(v)
    qb = qs.reshape(b, dilation, h, n, c, dh)
    kb, vb = band(ks), band(vs)
    scores = jnp.einsum('bdhnqe,bdhnke->bdhnqk', qb, kb).astype(jnp.float32) * (dh ** -0.5)
    qi = jnp.arange(c)[:, None]
    ki = jnp.arange(2 * c)[None, :]
    dist = c + qi - ki
    blk = jnp.arange(n)[:, None, None]
    valid = (dist >= 0) & (dist <= w_sub) & ((blk > 0) | (ki >= c))
    bias = -slopes[:, None, None, None] * (dilation * dist).astype(jnp.float32)
    scores = jnp.where(valid, scores + bias, NEG_INF)
    m = jnp.max(scores, axis=-1)
    p = jnp.exp(scores - m[..., None])
    l = jnp.sum(p, axis=-1)
    o = jnp.einsum('bdhnqk,bdhnke->bdhnqe', p, vb.astype(jnp.float32)) / l[..., None]

    def from_sub(t):
        t = t.reshape((b, dilation, h, padded) + t.shape[5:])[:, :, :, :sub_len]
        perm = (0, 3, 1, 2) + tuple(range(4, t.ndim))
        return t.transpose(perm).reshape((b, s, h) + t.shape[4:])

    return from_sub(o), from_sub(m), from_sub(l)


def dilated_attention(q, k, v, slopes):
    outs = [dilated_branch(q, k, v, slopes, w, d) for (w, d) in DILATED_BRANCHES]
    m_all = jnp.stack([m for (_, m, _) in outs])
    m_max = jnp.max(m_all, axis=0)
    wts = jnp.stack([l * jnp.exp(m - m_max) for (_, m, l) in outs])
    num = sum(wts[i][..., None] * outs[i][0] for i in range(len(outs)))
    return (num / jnp.sum(wts, axis=0)[..., None]).astype(q.dtype)


def spatial_gating(su, sv, sgu_norm_g, sgu_w, sgu_b):
    b, s, _ = su.shape
    nc = s // SGU_CHUNK
    svn = rms_norm(sv.reshape(b, s, SGU_GROUPS, SGU_GROUP_DIM), sgu_norm_g.reshape(SGU_GROUPS, SGU_GROUP_DIM))
    svn = svn.reshape(b, nc, SGU_CHUNK, SGU_GROUPS, SGU_GROUP_DIM)
    causal = jnp.tril(jnp.ones((SGU_CHUNK, SGU_CHUNK), dtype=bool))
    w = jnp.where(causal[None], sgu_w, 0.0).astype(sgu_w.dtype)
    mixed = jnp.einsum('gts,bcsge->bctge', w, svn) + sgu_b.T[:, :, None]
    return su * mixed.reshape(b, s, SGU_WIDTH)


def peer(h, w_query, sub_keys, expert_u, expert_v):
    b, s, d = h.shape
    t = b * s
    hf = h.reshape(t, d)
    q = (hf @ w_query).reshape(t, PEER_HEADS, 2, PEER_KEY_DIM // 2).astype(jnp.float32)
    s1 = jnp.einsum('thk,nk->thn', q[:, :, 0], sub_keys[0].astype(jnp.float32))
    s2 = jnp.einsum('thk,nk->thn', q[:, :, 1], sub_keys[1].astype(jnp.float32))
    v1, i1 = lax.top_k(s1, PEER_TOPK)
    v2, i2 = lax.top_k(s2, PEER_TOPK)
    cand = (v1[..., :, None] + v2[..., None, :]).reshape(t, PEER_HEADS, PEER_TOPK * PEER_TOPK)
    cidx = (i1[..., :, None] * N_SUB_KEYS + i2[..., None, :]).reshape(t, PEER_HEADS, PEER_TOPK * PEER_TOPK)
    best, pos = lax.top_k(cand, PEER_TOPK)
    eidx = jnp.take_along_axis(cidx, pos, axis=-1).reshape(t, PEER_HEADS * PEER_TOPK)
    gates = jax.nn.softmax(best, axis=-1).reshape(t, PEER_HEADS * PEER_TOPK)
    nb = t // PEER_TOKEN_BLOCK

    def block(args):
        hb, eb, gb = args
        u = jnp.take(expert_u, eb, axis=0)
        a = jnp.einsum('cd,ced->ce', hb, u).astype(jnp.float32)
        coef = gb * jax.nn.gelu(a, approximate=False)
        vv = jnp.take(expert_v, eb, axis=0)
        return jnp.einsum('ce,ced->cd', coef.astype(vv.dtype), vv)

    out = lax.map(block, (hf.reshape(nb, PEER_TOKEN_BLOCK, d),
                          eidx.reshape(nb, PEER_TOKEN_BLOCK, PEER_HEADS * PEER_TOPK),
                          gates.reshape(nb, PEER_TOKEN_BLOCK, PEER_HEADS * PEER_TOPK)))
    return out.reshape(b, s, d).astype(h.dtype)


def setup_inputs(seed: int = 0) -> dict:
    key = jax.random.key(seed)
    ks = jax.random.split(key, 16)
    f32 = jnp.float32
    nrm = lambda k, shp: jax.random.normal(k, shp, f32)
    gain = lambda k, shp: 1.0 + 0.01 * nrm(k, shp)
    return {
        'x': nrm(ks[0], (BATCH, SEQ, D_MODEL)),
        'norm1_g': gain(ks[1], (DEPTH, D_MODEL)),
        'w_in': nrm(ks[2], (DEPTH, D_MODEL, IN_WIDTH)) * D_MODEL ** -0.5,
        'q_norm_g': gain(ks[3], (DEPTH, HEAD_DIM)),
        'k_norm_g': gain(ks[4], (DEPTH, HEAD_DIM)),
        'sgu_norm_g': gain(ks[5], (DEPTH, SGU_WIDTH)),
        'sgu_w': nrm(ks[6], (DEPTH, SGU_GROUPS, SGU_CHUNK, SGU_CHUNK)) * SGU_CHUNK ** -0.5,
        'sgu_b': 1.0 + 0.1 * nrm(ks[7], (DEPTH, SGU_GROUPS, SGU_CHUNK)),
        'attn_out_g': gain(ks[8], (DEPTH, ATTN_WIDTH)),
        'sgu_out_g': gain(ks[9], (DEPTH, SGU_WIDTH)),
        'w_out': nrm(ks[10], (DEPTH, MIX_WIDTH, D_MODEL)) * MIX_WIDTH ** -0.5,
        'norm2_g': gain(ks[11], (DEPTH, D_MODEL)),
        'w_query': nrm(ks[12], (DEPTH, D_MODEL, PEER_HEADS * PEER_KEY_DIM)) * D_MODEL ** -0.5,
        'sub_keys': nrm(ks[13], (DEPTH, 2, N_SUB_KEYS, PEER_KEY_DIM // 2)) * (PEER_KEY_DIM // 2) ** -0.5,
        'expert_u': nrm(ks[14], (DEPTH, N_EXPERTS, D_MODEL)) * D_MODEL ** -0.5,
        'expert_v': nrm(ks[15], (DEPTH, N_EXPERTS, D_MODEL)) * 0.1,
    }


def reference(x, norm1_g, w_in, q_norm_g, k_norm_g, sgu_norm_g, sgu_w, sgu_b, attn_out_g, sgu_out_g,
              w_out, norm2_g, w_query, sub_keys, expert_u, expert_v):
    b, s, _ = x.shape
    slopes = alibi_slopes(ATTN_HEADS)
    splits = [ATTN_WIDTH, 2 * ATTN_WIDTH, 3 * ATTN_WIDTH, 3 * ATTN_WIDTH + SGU_WIDTH]
    for layer in range(DEPTH):
        h = rms_norm(x, norm1_g[layer])
        proj = h @ w_in[layer]
        q, k, v, su, sv = jnp.split(proj, splits, axis=-1)
        q = rms_norm(q.reshape(b, s, ATTN_HEADS, HEAD_DIM), q_norm_g[layer])
        k = rms_norm(k.reshape(b, s, ATTN_HEADS, HEAD_DIM), k_norm_g[layer])
        v = v.reshape(b, s, ATTN_HEADS, HEAD_DIM)
        attn = dilated_attention(q, k, v, slopes).reshape(b, s, ATTN_WIDTH)
        gated = spatial_gating(su, sv, sgu_norm_g[layer], sgu_w[layer], sgu_b[layer])
        mixed = jnp.concatenate([rms_norm(attn, attn_out_g[layer]),
                                 rms_norm(gated, sgu_out_g[layer])], axis=-1)
        x = x + mixed @ w_out[layer]
        h2 = rms_norm(x, norm2_g[layer])
        x = x + peer(h2, w_query[layer], sub_keys[layer], expert_u[layer], expert_v[layer])
    return x
```

```cpp
#include <hip/hip_runtime.h>
#include <cstdio>
#include <cstdint>
#include <cmath>
namespace pg8 {
#define PG8_LAS __attribute__((address_space(3)))
typedef unsigned short bf16_t;
typedef short bf16x8 __attribute__((ext_vector_type(8)));
typedef float f32x4 __attribute__((ext_vector_type(4)));
typedef unsigned u32x4 __attribute__((ext_vector_type(4)));
constexpr int BM = 256, BK = 64, HALF = 128, HTB = HALF * BK * 2  , STAGE_BYTES = 8 * HTB, NXCD = 8, WGM = 8;

__host__ __device__ __forceinline__ int lds_byte(int r, int c) { const int st = (r >> 4) * 2 + (c >> 5), rr = r & 15, cc = c & 31, ob = rr * 64 + cc * 2; return st * 1024 + (ob ^ (((ob >> 9) & 1) << 5)); }
__host__ __device__ __forceinline__ void stage_rc(int b, int& R, int& C) { const int st = b / 1024, sb = b % 1024, swz = sb ^ (((sb >> 9) & 1) << 5); R = (st >> 1) * 16 + swz / 64; C = (st & 1) * 32 + (swz % 64) / 2; }
__host__ __device__ __forceinline__ int perm32(int rho) { const int n = rho >> 4, i = rho & 15; return 8 * (i >> 2) + 4 * n + (i & 3); }

struct Unit { int pm, pn; };
struct Gemm { const bf16_t* A; const bf16_t* Bt; int M, N, K; };

struct StaticOrder {
    int nM, nN, nwg, G, c;
    __host__ __device__ void init(int M, int N, int G_, int c_) { nM = M / BM; nN = N / BM; nwg = nM * nN; G = G_; c = c_; }
    __host__ __device__ bool next(int i, Unit& u) const {
        const long L = (long)i * G + c; if (L >= nwg) return false;
        int wgid = (int)L; { const int q = nwg / NXCD, r = nwg % NXCD, xcd = wgid % NXCD, off = wgid / NXCD; wgid = (xcd < r ? xcd * (q + 1) : r * (q + 1) + (xcd - r) * q) + off; }
        const int nig = WGM * nN, gid = wgid / nig, fm = gid * WGM, gsz = (nM - fm) < WGM ? (nM - fm) : WGM;
        u.pm = fm + ((wgid % nig) % gsz); u.pn = (wgid % nig) / gsz; return true;
    }
    __device__ __forceinline__ void a_ready(const Unit&) const {}
    __device__ __forceinline__ void done(const Unit&) const {}
};


__device__ __forceinline__ unsigned cvt_pk_bf16(float lo, float hi) { unsigned r; asm volatile("v_cvt_pk_bf16_f32 %0, %1, %2" : "=v"(r) : "v"(lo), "v"(hi)); return r; }

constexpr float EPS_F = 1e-6f;
constexpr float QSCALE = 0.125f * 1.4426950408889634f;

struct EpiInProj {
    static constexpr bool PERM = true; static constexpr int MID_T = 0;
    const float* rstd1; const float* gq; const float* gk; const float* gsgu; bf16_t* out0; size_t type_stride;
    __device__ __forceinline__ void operator()(const f32x4 (&acc)[2][2][4][2], const Unit& u, int, int wr, int wc, int fr, int fq) const {
        const int type = u.pn >> 1, half = u.pn & 1;
        bf16_t* base = out0 + (size_t)type * type_stride;
        const int colb = 256 * half + 64 * wc + 8 * fq;
        const bool normed = (type == 0) || (type == 1) || (type == 4);
        float g[2][8];
#pragma unroll
        for (int bj = 0; bj < 2; ++bj)
#pragma unroll
            for (int e = 0; e < 8; ++e) {
                float gv = 1.f;
                if (type == 0) gv = gq[32 * bj + 8 * fq + e] * QSCALE;
                else if (type == 1) gv = gk[32 * bj + 8 * fq + e];
                else if (type == 4) gv = gsgu[colb + 32 * bj + e];
                g[bj][e] = gv;
            }
        float rsv[2][4];
#pragma unroll
        for (int ai = 0; ai < 2; ++ai)
#pragma unroll
            for (int m = 0; m < 4; ++m) rsv[ai][m] = rstd1[u.pm * BM + ai * HALF + wr * 64 + m * 16 + fr];
#pragma unroll
        for (int ai = 0; ai < 2; ++ai)
#pragma unroll
            for (int m = 0; m < 4; ++m) {
                const int row = u.pm * BM + ai * HALF + wr * 64 + m * 16 + fr;
                const float rs = rsv[ai][m];
                f32x4 v[2][2];
                float ss = 0.f;
#pragma unroll
                for (int bj = 0; bj < 2; ++bj)
#pragma unroll
                    for (int n = 0; n < 2; ++n) { v[bj][n] = acc[ai][bj][m][n] * rs; const f32x4 x = v[bj][n]; ss += (x[0] * x[0] + x[1] * x[1]) + (x[2] * x[2] + x[3] * x[3]); }
                float r = 1.f;
                if (normed) { ss += __shfl_xor(ss, 16); ss += __shfl_xor(ss, 32); r = 1.0f / sqrtf(ss * (1.0f / 64.0f) + EPS_F); }
                bf16_t* rowp = base + (size_t)row * 512 + colb;
#pragma unroll
                for (int bj = 0; bj < 2; ++bj) {
                    const f32x4 a = v[bj][0], b = v[bj][1];
                    u32x4 w;
                    w.x = cvt_pk_bf16(a[0] * r * g[bj][0], a[1] * r * g[bj][1]); w.y = cvt_pk_bf16(a[2] * r * g[bj][2], a[3] * r * g[bj][3]);
                    w.z = cvt_pk_bf16(b[0] * r * g[bj][4], b[1] * r * g[bj][5]); w.w = cvt_pk_bf16(b[2] * r * g[bj][6], b[3] * r * g[bj][7]);
                    *(u32x4*)(rowp + 32 * bj) = w;
                }
            }
    }
};

struct EpiOutProj {
    static constexpr bool PERM = true; static constexpr int MID_T = 8;
    const float* x; float* x1; bf16_t* x1b; float* ssq2p; float* maxp; const PG8_LAS float* tab;
    __device__ __forceinline__ void mid(f32x4 (&acc)[2][2][4][2], const Unit&, int ui, int wr, int, int fr, int) const {
#pragma unroll
        for (int ai = 0; ai < 2; ++ai)
#pragma unroll
            for (int m = 0; m < 4; ++m) {
                const float rt = tab[(ui * 256 + ai * HALF + wr * 64 + m * 16 + fr) * 2];
#pragma unroll
                for (int bj = 0; bj < 2; ++bj)
#pragma unroll
                    for (int n = 0; n < 2; ++n) acc[ai][bj][m][n] *= rt;
            }
    }
    __device__ __forceinline__ void operator()(const f32x4 (&acc)[2][2][4][2], const Unit& u, int ui, int wr, int wc, int fr, int fq) const {
        const size_t cbase = (size_t)u.pn * BM + wc * 32 + 8 * fq;
        f32x4 xn[2][2];
#define OP_LOADX(it_) do { const int r_ = u.pm * BM + ((it_) >> 2) * HALF + wr * 64 + ((it_) & 3) * 16 + fr; \
            _Pragma("unroll") for (int bj = 0; bj < 2; ++bj) { xn[bj][0] = __builtin_nontemporal_load((const f32x4*)(x + (size_t)r_ * 1024 + cbase + bj * HALF)); xn[bj][1] = __builtin_nontemporal_load((const f32x4*)(x + (size_t)r_ * 1024 + cbase + bj * HALF + 4)); } } while (0)
        OP_LOADX(0);
#pragma unroll
        for (int it = 0; it < 8; ++it) {
            const int ai = it >> 2, m = it & 3;
            const int lr = ai * HALF + wr * 64 + m * 16 + fr, row = u.pm * BM + lr;
            const float rs = tab[(ui * 256 + lr) * 2 + 1];
            f32x4 xc[2][2];
#pragma unroll
            for (int bj = 0; bj < 2; ++bj) { xc[bj][0] = xn[bj][0]; xc[bj][1] = xn[bj][1]; }
            if (it + 1 < 8) OP_LOADX(it + 1);
            float ss = 0.f, mx = 0.f;
#pragma unroll
            for (int bj = 0; bj < 2; ++bj) {
                const size_t off = (size_t)row * 1024 + cbase + bj * HALF;
                const f32x4 a = xc[bj][0] + acc[ai][bj][m][0] * rs, b = xc[bj][1] + acc[ai][bj][m][1] * rs;
                ss += (a[0] * a[0] + a[1] * a[1]) + (a[2] * a[2] + a[3] * a[3]) + (b[0] * b[0] + b[1] * b[1]) + (b[2] * b[2] + b[3] * b[3]);
                mx = fmaxf(mx, fmaxf(fmaxf(fmaxf(fabsf(a[0]), fabsf(a[1])), fmaxf(fabsf(a[2]), fabsf(a[3]))), fmaxf(fmaxf(fabsf(b[0]), fabsf(b[1])), fmaxf(fabsf(b[2]), fabsf(b[3])))));
                u32x4 w; w.x = cvt_pk_bf16(a[0], a[1]); w.y = cvt_pk_bf16(a[2], a[3]); w.z = cvt_pk_bf16(b[0], b[1]); w.w = cvt_pk_bf16(b[2], b[3]);
                *(u32x4*)(x1b + off) = w;
            }
            ss += __shfl_xor(ss, 16); ss += __shfl_xor(ss, 32); mx = fmaxf(mx, __shfl_xor(mx, 16)); mx = fmaxf(mx, __shfl_xor(mx, 32));
            if (fq == 0) { ssq2p[(size_t)row * 16 + u.pn * 4 + wc] = ss; maxp[(size_t)row * 16 + u.pn * 4 + wc] = mx; }
        }
#undef OP_LOADX
    }
};

struct EpiQuery {
    static constexpr bool PERM = true; static constexpr int MID_T = 0;
    bf16_t* qp; const PG8_LAS float* tab;
    __device__ __forceinline__ void operator()(const f32x4 (&acc)[2][2][4][2], const Unit& u, int ui, int wr, int wc, int fr, int fq) const {
#pragma unroll
        for (int ai = 0; ai < 2; ++ai)
#pragma unroll
            for (int m = 0; m < 4; ++m) {
                const int lr = ai * HALF + wr * 64 + m * 16 + fr, row = u.pm * BM + lr;
                const float rs = tab[ui * 256 + lr];
#pragma unroll
                for (int bj = 0; bj < 2; ++bj) {
                    const size_t off = ((((size_t)(row >> 5) * 8 + u.pn) * 2 + bj) * 8 + 2 * wc + (fq >> 1)) * 512 + (size_t)(32 * (fq & 1) + (row & 31)) * 8;
                    const f32x4 a = acc[ai][bj][m][0] * rs, b = acc[ai][bj][m][1] * rs;
                    u32x4 w; w.x = cvt_pk_bf16(a[0], a[1]); w.y = cvt_pk_bf16(a[2], a[3]); w.z = cvt_pk_bf16(b[0], b[1]); w.w = cvt_pk_bf16(b[2], b[3]);
                    *(u32x4*)(qp + off) = w;
                }
            }
    }
};

template <class Epi, class Sched, bool ALIGN_EPI = false, bool SP2 = false>
__device__ __forceinline__ void gemm_phase(PG8_LAS unsigned char* lds, const Gemm g, const Sched& S, const Epi& E) {
    const int tid = threadIdx.x, wid = __builtin_amdgcn_readfirstlane(tid >> 6), lane = tid & 63, wr = wid >> 2, wc = wid & 3, fr = lane & 15, fq = lane >> 4;
    const int K = g.K, nt = K / BK;
    unsigned voffA[2], voffB[2];
#pragma unroll
    for (int i = 0; i < 2; ++i) { int R, C; stage_rc(tid * 16 + i * 8192, R, C); const int Rb = Epi::PERM ? ((R & ~31) + perm32(R & 31)) : R;
        voffA[i] = (unsigned)(R * K + C) * 2u; voffB[i] = (unsigned)(Rb * K + C) * 2u; }
    const size_t kstep = (size_t)(BK * 2);
    const size_t hstep = (size_t)HALF * K * 2;
    const size_t tstep = 2 * hstep;
    const unsigned ldsw = (unsigned)wid * 1024u;
    const int aoff = lds_byte(wr * 64 + fr, fq * 8), boff = lds_byte(wc * 32 + fr, fq * 8);
#define PG8_SA(b, h) (((b) * 2 + (h)) * HTB)
#define PG8_SB(b, h) ((4 + (b) * 2 + (h)) * HTB)
#define PG8_STAGE(bufoff, gbase, voff) do { _Pragma("unroll") for (int _i = 0; _i < 2; ++_i) \
        __builtin_amdgcn_global_load_lds((const unsigned*)((const char*)(gbase) + (voff)[_i]), (PG8_LAS unsigned*)(lds + (bufoff) + ldsw + _i * 8192), 16, 0, 0); } while (0)
#define PG8_LDA(dst, b, h) do { _Pragma("unroll") for (int m = 0; m < 4; ++m) _Pragma("unroll") for (int k = 0; k < 2; ++k) dst[m][k] = *(const PG8_LAS bf16x8*)(lds + PG8_SA(b, h) + aoff + m * 2048 + k * 1024); } while (0)
#define PG8_LDB(dst, b, h) do { _Pragma("unroll") for (int n = 0; n < 2; ++n) _Pragma("unroll") for (int k = 0; k < 2; ++k) dst[n][k] = *(const PG8_LAS bf16x8*)(lds + PG8_SB(b, h) + boff + n * 2048 + k * 1024); } while (0)
#define PG8_MMA(ai, bj, At, Bt) do { __builtin_amdgcn_s_setprio(1); _Pragma("unroll") for (int m = 0; m < 4; ++m) _Pragma("unroll") for (int n = 0; n < 2; ++n) _Pragma("unroll") for (int k = 0; k < 2; ++k) \
        acc[ai][bj][m][n] = __builtin_amdgcn_mfma_f32_16x16x32_bf16(Bt[n][k], At[m][k], acc[ai][bj][m][n], 0, 0, 0); __builtin_amdgcn_s_setprio(0); } while (0)
#define PG8_WAIT_V(n) asm volatile("s_waitcnt vmcnt(" #n ")" ::: "memory")
#define PG8_WAIT_L(n) asm volatile("s_waitcnt lgkmcnt(" #n ")" ::: "memory")
#define PG8_BAR __builtin_amdgcn_s_barrier()
#define PG8_SCHED __builtin_amdgcn_sched_barrier(0)
    Unit cur, nxt; int ui = 0;
    if (!S.next(0, cur)) return;
    f32x4 acc[2][2][4][2];
#pragma unroll
    for (int a = 0; a < 2; ++a)
#pragma unroll
        for (int b = 0; b < 2; ++b)
#pragma unroll
            for (int m = 0; m < 4; ++m)
#pragma unroll
                for (int n = 0; n < 2; ++n) acc[a][b][m][n] = (f32x4){0.f, 0.f, 0.f, 0.f};
    bf16x8 At[4][2], B0[2][2], B1[2][2];
    const char* cA = (const char*)g.A + (size_t)cur.pm * tstep; const char* cB = (const char*)g.Bt + (size_t)cur.pn * tstep;
    S.a_ready(cur);
    if constexpr (SP2) {
        PG8_STAGE(PG8_SB(0, 0), cB, voffB); PG8_STAGE(PG8_SB(0, 1), cB + hstep, voffB); PG8_STAGE(PG8_SA(0, 0), cA, voffA); PG8_STAGE(PG8_SA(0, 1), cA + hstep, voffA);
        if (wr == 1) PG8_BAR;
        PG8_WAIT_V(2); PG8_BAR;
        PG8_STAGE(PG8_SB(1, 0), cB + kstep, voffB); PG8_STAGE(PG8_SA(1, 0), cA + kstep, voffA); PG8_STAGE(PG8_SB(1, 1), cB + hstep + kstep, voffB);
        PG8_WAIT_V(6); PG8_BAR;
    } else {
        PG8_STAGE(PG8_SB(0, 0), cB, voffB); PG8_STAGE(PG8_SA(0, 0), cA, voffA); PG8_STAGE(PG8_SB(0, 1), cB + hstep, voffB); PG8_STAGE(PG8_SA(0, 1), cA + hstep, voffA);
        if (wr == 1) PG8_BAR;
        PG8_WAIT_V(4); PG8_BAR;
        PG8_STAGE(PG8_SB(1, 0), cB + kstep, voffB); PG8_STAGE(PG8_SA(1, 0), cA + kstep, voffA); PG8_STAGE(PG8_SB(1, 1), cB + hstep + kstep, voffB);
        PG8_WAIT_V(6); PG8_BAR;
    }
    for (;;) {
        const bool has_next = S.next(ui + 1, nxt);
        const char* nA = has_next ? (const char*)g.A + (size_t)nxt.pm * tstep : cA; const char* nB = has_next ? (const char*)g.Bt + (size_t)nxt.pn * tstep : cB;
        for (int t = 0; t < nt; t += 2) {
            if constexpr (Epi::MID_T > 0) { if (t == Epi::MID_T) E.mid(acc, cur, ui, wr, wc, fr, fq); }
            const bool last = (t == nt - 2);
            const char* a1 = cA + (size_t)(t + 1) * kstep;
            const char* a2 = last ? nA : cA + (size_t)(t + 2) * kstep; const char* b2 = last ? nB : cB + (size_t)(t + 2) * kstep;
            const char* a3 = a2 + kstep; const char* b3 = b2 + kstep;
            if (last && has_next) S.a_ready(nxt);
            if constexpr (SP2) {
            PG8_LDB(B0, 0, 0); PG8_LDB(B1, 0, 1); PG8_SCHED; PG8_LDA(At, 0, 0); PG8_STAGE(PG8_SA(1, 1), a1 + hstep, voffA);
            PG8_WAIT_V(8); PG8_WAIT_L(0); PG8_BAR; PG8_MMA(0, 0, At, B0); PG8_MMA(0, 1, At, B1); PG8_BAR; PG8_SCHED;
            PG8_LDA(At, 0, 1); PG8_STAGE(PG8_SB(0, 0), b2, voffB); PG8_STAGE(PG8_SB(0, 1), b2 + hstep, voffB); PG8_STAGE(PG8_SA(0, 0), a2, voffA);
            PG8_WAIT_V(8); PG8_WAIT_L(0); PG8_BAR; PG8_MMA(1, 0, At, B0); PG8_MMA(1, 1, At, B1); PG8_BAR; PG8_SCHED;
            PG8_LDB(B0, 1, 0); PG8_LDB(B1, 1, 1); PG8_SCHED; PG8_LDA(At, 1, 0); PG8_STAGE(PG8_SA(0, 1), a2 + hstep, voffA);
            PG8_WAIT_V(8); PG8_WAIT_L(0); PG8_BAR; PG8_MMA(0, 0, At, B0); PG8_MMA(0, 1, At, B1); PG8_BAR; PG8_SCHED;
            PG8_LDA(At, 1, 1); PG8_STAGE(PG8_SB(1, 0), b3, voffB); PG8_STAGE(PG8_SB(1, 1), b3 + hstep, voffB); PG8_STAGE(PG8_SA(1, 0), a3, voffA);
            PG8_WAIT_V(8); PG8_WAIT_L(0); PG8_BAR; PG8_MMA(1, 0, At, B0); PG8_MMA(1, 1, At, B1); PG8_BAR; PG8_SCHED;
            } else {
            PG8_LDB(B0, 0, 0); PG8_SCHED; PG8_LDA(At, 0, 0); PG8_STAGE(PG8_SA(1, 1), a1 + hstep, voffA);
            PG8_WAIT_L(8); PG8_BAR; PG8_WAIT_L(0); PG8_MMA(0, 0, At, B0); PG8_BAR; PG8_SCHED;
            PG8_LDB(B1, 0, 1); PG8_STAGE(PG8_SB(0, 0), b2, voffB);
            PG8_BAR; PG8_WAIT_L(0); PG8_MMA(0, 1, At, B1); PG8_BAR;
            PG8_LDA(At, 0, 1); PG8_STAGE(PG8_SA(0, 0), a2, voffA);
            PG8_BAR; PG8_WAIT_L(0); PG8_MMA(1, 0, At, B0); PG8_BAR; PG8_SCHED;
            PG8_STAGE(PG8_SB(0, 1), b2 + hstep, voffB);
            PG8_WAIT_V(6); PG8_BAR; PG8_MMA(1, 1, At, B1); PG8_BAR;
            PG8_LDB(B0, 1, 0); PG8_SCHED; PG8_LDA(At, 1, 0); PG8_STAGE(PG8_SA(0, 1), a2 + hstep, voffA);
            PG8_WAIT_L(8); PG8_BAR; PG8_WAIT_L(0); PG8_MMA(0, 0, At, B0); PG8_BAR; PG8_SCHED;
            PG8_LDB(B1, 1, 1); PG8_STAGE(PG8_SB(1, 0), b3, voffB);
            PG8_BAR; PG8_WAIT_L(0); PG8_MMA(0, 1, At, B1); PG8_BAR;
            PG8_LDA(At, 1, 1); PG8_STAGE(PG8_SA(1, 0), a3, voffA);
            PG8_BAR; PG8_WAIT_L(0); PG8_MMA(1, 0, At, B0); PG8_BAR; PG8_SCHED;
            PG8_STAGE(PG8_SB(1, 1), b3 + hstep, voffB);
            PG8_WAIT_V(6); PG8_BAR; PG8_MMA(1, 1, At, B1); PG8_BAR;
            }
        }
        if constexpr (ALIGN_EPI) { if (wr == 0) PG8_BAR; }
        E(acc, cur, ui, wr, wc, fr, fq); S.done(cur);
        if (!has_next) break;
#pragma unroll
        for (int a = 0; a < 2; ++a)
#pragma unroll
            for (int b = 0; b < 2; ++b)
#pragma unroll
                for (int m = 0; m < 4; ++m)
#pragma unroll
                    for (int n = 0; n < 2; ++n) acc[a][b][m][n] = (f32x4){0.f, 0.f, 0.f, 0.f};
        cur = nxt; cA = nA; cB = nB; ++ui;
        if constexpr (ALIGN_EPI) { if (wr == 1) PG8_BAR; }
    }
    PG8_WAIT_V(0);
    if constexpr (!ALIGN_EPI) { if (wr == 0) PG8_BAR; }
    PG8_BAR;
#undef PG8_SA
#undef PG8_SB
#undef PG8_STAGE
#undef PG8_LDA
#undef PG8_LDB
#undef PG8_MMA
#undef PG8_WAIT_V
#undef PG8_WAIT_L
#undef PG8_BAR
#undef PG8_SCHED
}
}

constexpr int NWAVES = 8;
constexpr int DM = 1024, BATCH = 8, SEQ = 4096, TOK = BATCH * SEQ;
constexpr int AW = 512, INW = 2560, QPW = 2048, NEXP = 16384;
constexpr int NPHASE = 7;
#ifndef MK_N_LAUNCHES
#define MK_N_LAUNCHES 1
#endif
constexpr int N_LAUNCHES = MK_N_LAUNCHES;

constexpr size_t MiB = 1u << 20;
constexpr size_t WS_CTL = 0, CTL_ZERO_BYTES = 64 * 1024;
constexpr size_t WS_WIN = 2 * MiB, WS_WOUT = 8 * MiB, WS_WQ = 10 * MiB, WS_SK = 14 * MiB, WS_SGUW = 14 * MiB + 512 * 1024, WS_RSTD1 = 15 * MiB;
constexpr size_t WS_SCU = 15 * MiB + 256 * 1024, WS_SCV = 15 * MiB + 512 * 1024;
constexpr size_t WS_UB = 16 * MiB, WS_VB = 48 * MiB;
constexpr size_t WS_XB = 80 * MiB;
constexpr size_t WS_Q = 144 * MiB, WS_TYPE_STRIDE = 32 * MiB;
constexpr size_t WS_QP = 144 * MiB;
constexpr size_t WS_MIX = 304 * MiB;
constexpr size_t WS_SSQA = 368 * MiB, WS_SSQS = 369 * MiB, WS_SSQ2P = 370 * MiB, WS_MAXP = 372 * MiB, WS_HINV = 374 * MiB;
constexpr size_t WS_PA = 144 * MiB;
constexpr size_t WS_COEF = 304 * MiB, WS_COEF0 = 320 * MiB, WS_H8 = 324 * MiB, WS_HS = 356 * MiB;
constexpr size_t WS_EIDX = 376 * MiB, WS_GATE = 392 * MiB, WS_END = 408 * MiB;
constexpr int CW_BAR = 1024;

constexpr int RING_OFF = 0, RING_BYTES = 131072;
constexpr int TAB_OFF = RING_BYTES, TAB_BYTES = 8192;
constexpr int LDSCTL_OFF = 153600, MISC_OFF = LDSCTL_OFF + 64;
constexpr int LDS_BYTES = 155648;
static_assert(MISC_OFF + 128 <= LDS_BYTES, "LDS map");

#define GAS __attribute__((address_space(1)))
#define LAS __attribute__((address_space(3)))
typedef unsigned short bf16;
typedef unsigned v4u __attribute__((ext_vector_type(4)));
typedef unsigned v2u __attribute__((ext_vector_type(2)));
typedef float f32x4 __attribute__((ext_vector_type(4)));
typedef float f32x16 __attribute__((ext_vector_type(16)));
typedef short bf16x8 __attribute__((ext_vector_type(8)));
typedef short s16x4 __attribute__((ext_vector_type(4)));
typedef __bf16 bf16x2_t __attribute__((ext_vector_type(2)));
typedef GAS unsigned gu32;
#define RLX_AGENT __ATOMIC_RELAXED, __HIP_MEMORY_SCOPE_AGENT
#define LDS_WAIT() asm volatile("s_waitcnt lgkmcnt(0)" ::: "memory")
#define VM_WAIT() asm volatile("s_waitcnt vmcnt(0)" ::: "memory")
__device__ __forceinline__ unsigned f2bf(float f) { unsigned u = __builtin_bit_cast(unsigned, f); return (u + 0x7fffu + ((u >> 16) & 1u)) >> 16; }
__device__ __forceinline__ unsigned pk2(float lo, float hi) { return pg8::cvt_pk_bf16(lo, hi); }
__device__ __forceinline__ float bf_lo(unsigned w) { return __builtin_bit_cast(float, w << 16); }
__device__ __forceinline__ float bf_hi(unsigned w) { return __builtin_bit_cast(float, w & 0xffff0000u); }
__device__ __forceinline__ int crow(int r, int hi) { return (r & 3) + 8 * (r >> 2) + 4 * hi; }
#define XB_TMO      128
#define XB_XCNT(j)  (256  + 64 * (j))
#define XB_XSUB(j)  (1280 + 64 * (j))
#define XB_XGEN(j)  (2304 + 64 * (j))
#define XB_TOP      3328
#define XB_TOPGEN   3392
#define XCD_BAR_WORDS 3456
#define XB_SPIN_CAP (1u << 18)

__device__ __forceinline__ unsigned xb_ld(unsigned* p)              { return __hip_atomic_load(p, __ATOMIC_RELAXED, __HIP_MEMORY_SCOPE_AGENT); }
__device__ __forceinline__ unsigned xb_add(unsigned* p, unsigned v) { return __hip_atomic_fetch_add(p, v, __ATOMIC_RELAXED, __HIP_MEMORY_SCOPE_AGENT); }
__device__ __forceinline__ unsigned xb_xcc_id() { return (unsigned)__builtin_amdgcn_s_getreg((3 << 11) | 20) & 0xFu; }
#define XB_SPIN(cond, bar) do { unsigned _sp = 0; while (cond) { __builtin_amdgcn_s_sleep(1); \
    if ((++_sp & 255u) == 0u) { if (xb_ld(&(bar)[XB_TMO])) break; if (_sp > XB_SPIN_CAP) { atomicAdd(&(bar)[XB_TMO], 1u); break; } } } } while (0)

struct XcdBarrier {
    unsigned* bar; unsigned x;
    volatile LAS unsigned* st;
};

__device__ __forceinline__ XcdBarrier xcd_barrier_post(unsigned* bar, volatile LAS unsigned* st) {
    XcdBarrier b; b.bar = bar; b.x = xb_xcc_id(); b.st = st;
    if (threadIdx.x == 0) (void)xb_add(&bar[XB_XCNT(b.x)], 1u);
    return b;
}
__device__ __forceinline__ void xcd_barrier_complete(unsigned* bar, unsigned x, unsigned& nloc, unsigned& nx) {
    const unsigned G = gridDim.x * gridDim.y * gridDim.z;
    unsigned sum, cnt, mine, sp = 0u;
    for (;;) {
        sum = 0u; cnt = 0u; mine = 0u;
#pragma unroll
        for (unsigned j = 0; j < 16; ++j) { const unsigned c = xb_ld(&bar[XB_XCNT(j)]); sum += c; cnt += (c > 0u) ? 1u : 0u; mine = (j == x) ? c : mine; }
        if (sum == G) break;
        __builtin_amdgcn_s_sleep(1);
        if ((++sp & 255u) == 0u) { if (xb_ld(&bar[XB_TMO])) break; if (sp > XB_SPIN_CAP) { atomicAdd(&bar[XB_TMO], 1u); break; } }
    }
    nloc = mine > 0u ? mine : 1u; nx = cnt > 0u ? cnt : 1u;
}

__device__ __forceinline__ void xcd_barrier(const XcdBarrier& b) {
    asm volatile("s_waitcnt vmcnt(0)" ::: "memory");
    __syncthreads();
    if (threadIdx.x == 0) {
        unsigned* bar = b.bar;
        __builtin_amdgcn_s_waitcnt(0);
        unsigned nloc = b.st[0], nx = b.st[1];
        if (nloc == 0u) { xcd_barrier_complete(bar, b.x, nloc, nx); b.st[0] = nloc; b.st[1] = nx; }
        const unsigned old = xb_add(&bar[XB_XSUB(b.x)], 1u);
        const unsigned gen = old / nloc;
        if (old + 1u == (gen + 1u) * nloc) {
            __builtin_amdgcn_fence(__ATOMIC_RELEASE, "agent");
            asm volatile("s_waitcnt vmcnt(0)" ::: "memory");
            const unsigned og = xb_add(&bar[XB_TOP], 1u);
            const unsigned tg = og / nx;
            if (og + 1u == (tg + 1u) * nx) xb_add(&bar[XB_TOPGEN], 1u);
            else XB_SPIN(xb_ld(&bar[XB_TOPGEN]) == tg, bar);
            __builtin_amdgcn_fence(__ATOMIC_ACQUIRE, "agent");
            xb_add(&bar[XB_XGEN(b.x)], 1u);
            asm volatile("s_waitcnt vmcnt(0)" ::: "memory");
        } else {
            XB_SPIN(xb_ld(&bar[XB_XGEN(b.x)]) == gen, bar);
            __builtin_amdgcn_fence(__ATOMIC_ACQUIRE, "agent");
            asm volatile("s_waitcnt vmcnt(0)" ::: "memory");
        }
    }
    __syncthreads();
}

struct Frame {
    LAS unsigned char* lds;
    volatile LAS unsigned* MISC;
    gu32* ctl;
    int tid, lane, wave;
    int vcu, G;
    unsigned char* ws;
    const float *x, *norm1_g, *w_in, *q_norm_g, *k_norm_g, *sgu_norm_g, *sgu_w, *sgu_b, *attn_out_g, *sgu_out_g, *w_out, *norm2_g, *w_query, *sub_keys, *expert_u, *expert_v;
    float* out;
    bf16 *Win_t, *Wout_t, *Wq_t, *SK, *SGUW, *XB, *Q, *QP, *MIX;
    float *RSTD1, *SSQA, *SSQS, *SSQ2P, *GATE, *HS, *CS, *MAXP, *HINV;
    signed char *U8, *H8, *V8; int* PA; unsigned* CQ;
    unsigned short* EIDX;
};

__device__ __forceinline__ float wave_sum(float v) {
#pragma unroll
    for (int o = 1; o < 64; o <<= 1) v += __shfl_xor(v, o);
    return v;
}

__device__ __forceinline__ void p0_transpose_item(const float* W, int K, int N, bf16* WT, const float* gain_a, const float* gain_b, int gsplit, LAS float* scr, int item, int lane, bool permute) {
    const int nblk = N / 32, kb = item / nblk, nb = item % nblk, k0 = 64 * kb, n0 = 32 * nb;
#pragma unroll 8
    for (int i = 0; i < 32; ++i) { const int kk = 2 * i + (lane >> 5); const int k = k0 + kk; const float gv = (k < gsplit) ? gain_a[k] : gain_b[k - gsplit];
        scr[kk * 33 + (lane & 31)] = __builtin_nontemporal_load((const GAS float*)(W + (size_t)k * N + n0 + (lane & 31))) * gv; }
    LDS_WAIT(); asm volatile("" ::: "memory");
    int orow0 = n0;
    if (permute) { const int l = n0 & 255; orow0 = (n0 & ~255) + 128 * ((l >> 5) & 1) + 32 * (l >> 6); }
    const int c = lane & 7;
#pragma unroll
    for (int j = 0; j < 4; ++j) { const int n = (lane >> 3) + 8 * j; const LAS float* s = scr + (8 * c) * 33 + n;
        v4u o; o.x = pk2(s[0 * 33], s[1 * 33]); o.y = pk2(s[2 * 33], s[3 * 33]); o.z = pk2(s[4 * 33], s[5 * 33]); o.w = pk2(s[6 * 33], s[7 * 33]);
        *(GAS v4u*)(WT + (size_t)(orow0 + n) * K + k0 + 8 * c) = o; }
    LDS_WAIT(); asm volatile("" ::: "memory");
}

__device__ __forceinline__ float row_to_bf16(const float* src, bf16* dst, const float* gain, int lane) {
    float ss = 0.f;
    f32x4 v[4];
#pragma unroll
    for (int j = 0; j < 4; ++j) v[j] = __builtin_nontemporal_load((const GAS f32x4*)(src + 4 * lane + 256 * j));
#pragma unroll
    for (int j = 0; j < 4; ++j) {
        f32x4 a = v[j];
        ss += (a[0] * a[0] + a[1] * a[1]) + (a[2] * a[2] + a[3] * a[3]);
        if (gain) a = a * *(const GAS f32x4*)(gain + 4 * lane + 256 * j);
        v2u o; o.x = pk2(a[0], a[1]); o.y = pk2(a[2], a[3]);
        *(GAS v2u*)(dst + 4 * lane + 256 * j) = o;
    }
    return ss;
}

__device__ __forceinline__ void p0_prologue(Frame& F) {
    LAS float* scr = (LAS float*)(F.lds + RING_OFF + F.wave * 16384);
    const int gw = F.vcu * NWAVES + F.wave, NGW = F.G * NWAVES;
    constexpr int I_IN = (DM / 64) * (INW / 32), I_OUT = (DM / 64) * (DM / 32), I_Q = (DM / 64) * (QPW / 32);
    for (int it = gw; it < I_IN + I_OUT + I_Q; it += NGW) {
        int r = it;
        if (r < I_IN) { p0_transpose_item(F.w_in, DM, INW, F.Win_t, F.norm1_g, F.norm1_g, DM, scr, r, F.lane, true); continue; } r -= I_IN;
        if (r < I_OUT) { p0_transpose_item(F.w_out, DM, DM, F.Wout_t, F.attn_out_g, F.sgu_out_g, AW, scr, r, F.lane, false); continue; } r -= I_OUT;
        p0_transpose_item(F.w_query, DM, QPW, F.Wq_t, F.norm2_g, F.norm2_g, DM, scr, r, F.lane, false);
    }
    for (int m = 2 * gw; m < TOK; m += 2 * NGW) {
        const float s0 = row_to_bf16(F.x + (size_t)m * DM, F.XB + (size_t)m * DM, nullptr, F.lane);
        const float s1 = row_to_bf16(F.x + (size_t)(m + 1) * DM, F.XB + (size_t)(m + 1) * DM, nullptr, F.lane);
        const float ss0 = wave_sum(s0), ss1 = wave_sum(s1);
        if (F.lane == 0) { F.RSTD1[m] = 1.0f / sqrtf(ss0 * (1.0f / DM) + pg8::EPS_F); F.RSTD1[m + 1] = 1.0f / sqrtf(ss1 * (1.0f / DM) + pg8::EPS_F); }
    }
    for (int e0 = 2 * gw; e0 < 2 * NEXP; e0 += 2 * NGW) {
        const bool isu = e0 < NEXP; const int r0 = isu ? e0 : e0 - NEXP;
        f32x4 v[2][4]; float mx[2] = {0.f, 0.f};
#pragma unroll
        for (int b = 0; b < 2; ++b) {
            const float* src = (isu ? F.expert_u : F.expert_v) + (size_t)(r0 + b) * DM + 4 * F.lane;
#pragma unroll
            for (int q = 0; q < 4; ++q) v[b][q] = __builtin_nontemporal_load((const GAS f32x4*)(src + 256 * q));
        }
#pragma unroll
        for (int b = 0; b < 2; ++b) {
#pragma unroll
            for (int q = 0; q < 4; ++q) { if (isu) v[b][q] = v[b][q] * *(const GAS f32x4*)(F.norm2_g + 4 * F.lane + 256 * q);
                mx[b] = fmaxf(mx[b], fmaxf(fmaxf(fabsf(v[b][q][0]), fabsf(v[b][q][1])), fmaxf(fabsf(v[b][q][2]), fabsf(v[b][q][3])))); }
#pragma unroll
            for (int o = 1; o < 64; o <<= 1) mx[b] = fmaxf(mx[b], __shfl_xor(mx[b], o));
            const float sc = fmaxf(mx[b], 1e-30f) * (1.0f / 127.0f), inv = 1.0f / sc; const int r = r0 + b;
            signed char* tab = isu ? F.U8 : F.V8;
#pragma unroll
            for (int q = 0; q < 4; ++q) { const int b0 = (int)rintf(v[b][q][0] * inv), b1 = (int)rintf(v[b][q][1] * inv), b2 = (int)rintf(v[b][q][2] * inv), b3 = (int)rintf(v[b][q][3] * inv);
                const unsigned o = (unsigned)(b0 & 0xff) | ((unsigned)(b1 & 0xff) << 8) | ((unsigned)(b2 & 0xff) << 16) | ((unsigned)(b3 & 0xff) << 24);
                *(GAS unsigned*)(tab + ((size_t)(2 * q + (F.lane >> 5)) * NEXP + r) * 128 + 4 * (F.lane & 31)) = o; }
            if (F.lane == 0) { float* scp = (float*)(F.ws + (isu ? WS_SCU : WS_SCV)); scp[r] = sc; }
        }
    }
    const int gt = F.vcu * NWAVES * 64 + F.tid, NGT = F.G * NWAVES * 64;
    for (int i = gt; i < 8 * 128 * 128; i += NGT) { const int g = i >> 14, t = (i >> 7) & 127, s = i & 127;
        const int o = ((((g * 4 + (t >> 5)) * 8 + (s >> 4)) * 64) + 32 * ((s >> 3) & 1) + (t & 31)) * 8 + (s & 7);
        F.SGUW[o] = (bf16)f2bf(s <= t ? F.sgu_w[i] : 0.f); }
    for (int i = gt; i < 2 * 128 * 128; i += NGT) F.SK[i] = (bf16)f2bf(F.sub_keys[i]);
}

constexpr int AT_OPITCH = 136;
constexpr int AT_OACC = 0, AT_LACC = 512 * AT_OPITCH, AT_VS = AT_LACC + 2048, AT_VPITCH = 192, AT_VS_WAVE = 32 * AT_VPITCH;
constexpr int AT_KS = AT_VS + NWAVES * AT_VS_WAVE, AT_KS_WAVE = 32 * 128;
static_assert(AT_KS + NWAVES * AT_KS_WAVE <= LDSCTL_OFF, "attention LDS");
__device__ __forceinline__ int at_rowmap(int p) { return (p & ~15) | ((p ^ (p >> 4)) & 15); }
__device__ __forceinline__ s16x4 vtr(const LAS unsigned char* p) { typedef short v4i16_t __attribute__((ext_vector_type(4))); return __builtin_bit_cast(s16x4, __builtin_amdgcn_ds_read_tr16_b64_v4i16((LAS v4i16_t*)p)); }

struct AtDesc { int b, h, span, dil, res, a; };
struct AtPre { v4u q[4], k[4], v[4]; };
__device__ __forceinline__ AtDesc at_desc(int u, int stage, int tsk) {
    AtDesc d; const int bh = u >> 3; d.b = bh >> 3; d.h = bh & 7; d.span = u & 7;
    if (stage == 0) { d.dil = 16; d.res = tsk; d.a = d.span; }
    else if (stage == 1) { d.dil = 4; d.res = tsk & 3; d.a = 4 * d.span + (tsk >> 2); }
    else { d.dil = 1; d.res = 0; d.a = 16 * d.span + tsk; }
    return d;
}
__device__ __forceinline__ void at_prefetch(Frame& F, const AtDesc& d, AtPre& p) {
    const int lane = F.lane;
    const int c0 = (d.a >= 4) ? 0 : 4 - d.a;
    const size_t colo = (size_t)d.h * 64 + (lane & 7) * 8, rstep = (size_t)d.dil * 8 * 512;
    const size_t qrow = (size_t)d.b * SEQ + d.res + (size_t)d.dil * (32 * d.a + (lane >> 3));
    const size_t krow = (size_t)d.b * SEQ + d.res + (size_t)d.dil * (32 * (d.a - 4 + c0) + (lane >> 3));
    const bf16* qp = F.Q + qrow * 512 + colo; const bf16* kp = F.Q + WS_TYPE_STRIDE / 2 + krow * 512 + colo; const bf16* vp = F.Q + 2 * (WS_TYPE_STRIDE / 2) + krow * 512 + colo;
#pragma unroll
    for (int it = 0; it < 4; ++it) p.q[it] = *(const GAS v4u*)(qp + it * rstep);
#pragma unroll
    for (int it = 0; it < 4; ++it) p.k[it] = *(const GAS v4u*)(kp + it * rstep);
#pragma unroll
    for (int it = 0; it < 4; ++it) p.v[it] = *(const GAS v4u*)(vp + it * rstep);
}

template <int STAGE>
__device__ __forceinline__ void attn_task(Frame& F, const AtDesc& d, float sl, float mlog2, AtPre& pre, const AtDesc& nd) {
    const int lane = F.lane, r32 = lane & 31, hi = lane >> 5;
    const int b = d.b, h = d.h, span = d.span, dil = d.dil, res = d.res, a = d.a;
    const size_t tokbase = (size_t)b * SEQ;
    const bf16* Kp = F.Q + WS_TYPE_STRIDE / 2; const bf16* Vp = F.Q + 2 * (WS_TYPE_STRIDE / 2);
    LAS unsigned char* vs = F.lds + AT_VS + F.wave * AT_VS_WAVE;
    const int posq = res + dil * (32 * a + r32);
    LAS unsigned char* ks = F.lds + AT_KS + F.wave * AT_KS_WAVE;
    bf16x8 qf[4];
    {
#pragma unroll
        for (int it = 0; it < 4; ++it) { const int row = (lane >> 3) + 8 * it; *(LAS v4u*)(ks + row * 128 + (((lane & 7) ^ (row & 7)) << 4)) = pre.q[it]; }
        LDS_WAIT(); asm volatile("" ::: "memory");
#pragma unroll
        for (int d0 = 0; d0 < 4; ++d0) qf[d0] = *(const LAS bf16x8*)(ks + r32 * 128 + (((2 * d0 + hi) ^ (r32 & 7)) << 4));
        LDS_WAIT(); asm volatile("" ::: "memory");
    }
    f32x16 o[2]; o[0] = f32x16{}; o[1] = f32x16{};
    float lsum = 0.f;
    const float base_i = -sl * (float)(128 + r32) - mlog2 + sl * (float)(4 * hi);
    const int G = lane >> 4, gi = lane & 15, gq4 = gi >> 2, gp = gi & 3;
    const int c0 = (a >= 4) ? 0 : 4 - a;
    v4u kA[4], kB[4]; v4u vA[4], vB[4];
#pragma unroll
    for (int it = 0; it < 4; ++it) { kA[it] = pre.k[it]; vA[it] = pre.v[it]; }
    const size_t cstride = (size_t)dil * 32 * 512 * 2;
    const char* kptr = (const char*)(Kp + (tokbase + res + (size_t)dil * (32 * (a - 3 + c0) + (lane >> 3))) * 512 + h * 64 + (lane & 7) * 8);
    const char* vptr = (const char*)(Vp + (tokbase + res + (size_t)dil * (32 * (a - 3 + c0) + (lane >> 3))) * 512 + h * 64 + (lane & 7) * 8);
    const size_t vrow8 = (size_t)dil * 8 * 512 * 2;
#define AT_LOAD(kd, vd) do { \
        _Pragma("unroll") for (int it = 0; it < 4; ++it) kd[it] = *(const GAS v4u*)(kptr + it * vrow8); \
        _Pragma("unroll") for (int it = 0; it < 4; ++it) vd[it] = *(const GAS v4u*)(vptr + it * vrow8); \
        kptr += cstride; vptr += cstride; } while (0)
#define AT_CHUNK(c, kc, vc) do { \
        f32x16 s; \
        const float bc = base_i + sl * (float)(32 * (c)); \
        _Pragma("unroll") for (int r = 0; r < 16; ++r) s[r] = bc + sl * (float)((r & 3) + 8 * (r >> 2)); \
        _Pragma("unroll") for (int it = 0; it < 4; ++it) { const int kv = (lane >> 3) + 8 * it; *(LAS v4u*)(ks + kv * 128 + (((lane & 7) ^ (kv & 7)) << 4)) = kc[it]; *(LAS v4u*)(vs + kv * AT_VPITCH + (lane & 7) * 16) = vc[it]; } \
        _Pragma("unroll") for (int d0 = 0; d0 < 4; ++d0) { const bf16x8 kf = *(const LAS bf16x8*)(ks + r32 * 128 + (((2 * d0 + hi) ^ (r32 & 7)) << 4)); s = __builtin_amdgcn_mfma_f32_32x32x16_bf16(kf, qf[d0], s, 0, 0, 0); } \
          \
        const int dbase = 128 - 32 * (c) + r32 - 4 * hi; \
        if (((c) == 0) || ((c) == 4)) { \
            _Pragma("unroll") for (int r = 0; r < 16; ++r) { float p = __builtin_amdgcn_exp2f(s[r]); p = ((unsigned)(dbase - ((r & 3) + 8 * (r >> 2))) <= 128u) ? p : 0.f; s[r] = p; lsum += p; } \
        } else { \
            _Pragma("unroll") for (int r = 0; r < 16; ++r) { const float p = __builtin_amdgcn_exp2f(s[r]); s[r] = p; lsum += p; } \
        } \
        bf16x8 pb[2]; \
        _Pragma("unroll") for (int ks_ = 0; ks_ < 2; ++ks_) { v4u w; w.x = pk2(s[8 * ks_ + 0], s[8 * ks_ + 1]); w.y = pk2(s[8 * ks_ + 2], s[8 * ks_ + 3]); w.z = pk2(s[8 * ks_ + 4], s[8 * ks_ + 5]); w.w = pk2(s[8 * ks_ + 6], s[8 * ks_ + 7]); pb[ks_] = __builtin_bit_cast(bf16x8, w); } \
          \
        _Pragma("unroll") for (int d0 = 0; d0 < 2; ++d0) \
            _Pragma("unroll") for (int ks_ = 0; ks_ < 2; ++ks_) { \
                const LAS unsigned char* pa = vs + (16 * ks_ + 4 * (G >> 1) + gq4) * AT_VPITCH + (32 * d0 + 16 * (G & 1) + 4 * gp) * 2; \
                const s16x4 lo = vtr(pa), hi4 = vtr(pa + 8 * AT_VPITCH); \
                const bf16x8 va = (bf16x8){lo[0], lo[1], lo[2], lo[3], hi4[0], hi4[1], hi4[2], hi4[3]}; \
                o[d0] = __builtin_amdgcn_mfma_f32_32x32x16_bf16(va, pb[ks_], o[d0], 0, 0, 0); \
            } \
    } while (0)
#pragma unroll 1
    for (int c = c0; c < 4; ++c) {
        AT_LOAD(kB, vB);
        AT_CHUNK(c, kA, vA);
#pragma unroll
        for (int d0 = 0; d0 < 4; ++d0) { kA[d0] = kB[d0]; vA[d0] = vB[d0]; }
    }
    at_prefetch(F, nd, pre);
    AT_CHUNK(4, kA, vA);
#undef AT_CHUNK
#undef AT_LOAD
    lsum += __shfl_xor(lsum, 32);
    const int pl = posq - span * 512;
    LAS unsigned char* orow = F.lds + AT_OACC + at_rowmap(pl) * AT_OPITCH;
    LAS float* lacc = (LAS float*)(F.lds + AT_LACC);
    if (STAGE > 0) {
        lsum += lacc[pl];
#pragma unroll
        for (int d0 = 0; d0 < 2; ++d0)
#pragma unroll
            for (int g4 = 0; g4 < 4; ++g4) { const v2u w = *(LAS v2u*)(orow + (32 * d0 + 8 * g4 + 4 * hi) * 2);
                o[d0][4 * g4 + 0] += bf_lo(w.x); o[d0][4 * g4 + 1] += bf_hi(w.x); o[d0][4 * g4 + 2] += bf_lo(w.y); o[d0][4 * g4 + 3] += bf_hi(w.y); }
    }
    if (STAGE < 2) {
        if (hi == 0) lacc[pl] = lsum;
#pragma unroll
        for (int d0 = 0; d0 < 2; ++d0)
#pragma unroll
            for (int g4 = 0; g4 < 4; ++g4) { v2u w; w.x = pk2(o[d0][4 * g4 + 0], o[d0][4 * g4 + 1]); w.y = pk2(o[d0][4 * g4 + 2], o[d0][4 * g4 + 3]);
                *(LAS v2u*)(orow + (32 * d0 + 8 * g4 + 4 * hi) * 2) = w; }
    } else {
        const float inv = 1.0f / lsum;
        float ss = 0.f;
#pragma unroll
        for (int d0 = 0; d0 < 2; ++d0)
#pragma unroll
            for (int g4 = 0; g4 < 4; ++g4) { const float a0 = o[d0][4 * g4 + 0] * inv, a1 = o[d0][4 * g4 + 1] * inv, a2 = o[d0][4 * g4 + 2] * inv, a3 = o[d0][4 * g4 + 3] * inv;
                ss += (a0 * a0 + a1 * a1) + (a2 * a2 + a3 * a3);
                v2u w; w.x = pk2(a0, a1); w.y = pk2(a2, a3);
                *(LAS v2u*)(ks + r32 * 128 + (((4 * d0 + g4) ^ (r32 & 7)) << 4) + 8 * hi) = w; }
        ss += __shfl_xor(ss, 32);
        if (hi == 0) F.SSQA[(tokbase + posq) * 8 + h] = ss;
        LDS_WAIT(); asm volatile("" ::: "memory");
#pragma unroll
        for (int it = 0; it < 4; ++it) { const int row = (lane >> 3) + 8 * it; const v4u ov = *(const LAS v4u*)(ks + row * 128 + (((lane & 7) ^ (row & 7)) << 4));
            *(GAS v4u*)(F.MIX + (tokbase + res + (size_t)dil * (32 * a + row)) * 1024 + h * 64 + (lane & 7) * 8) = ov; }
        LDS_WAIT(); asm volatile("" ::: "memory");
    }
}

__device__ __forceinline__ void attn_unit(Frame& F, int u, int un, float mlog2, AtPre& pre) {
    const int h = (u >> 3) & 7;
    const float slope = __builtin_amdgcn_exp2f(-(float)(h + 1)) * 1.4426950408889634f;
    const int w = F.wave;
#pragma unroll 1
    for (int k = 0; k < 2; ++k) attn_task<0>(F, at_desc(u, 0, 2 * w + k), slope * 16.f, mlog2, pre, at_desc(u, k, k ? 2 * w : 2 * w + 1));
    LDS_WAIT(); __syncthreads();
#pragma unroll 1
    for (int k = 0; k < 2; ++k) attn_task<1>(F, at_desc(u, 1, 2 * w + k), slope * 4.f, mlog2, pre, at_desc(u, 1 + k, k ? 2 * w : 2 * w + 1));
    LDS_WAIT(); __syncthreads();
#pragma unroll 1
    for (int k = 0; k < 2; ++k) attn_task<2>(F, at_desc(u, 2, 2 * w + k), slope, mlog2, pre, k ? at_desc(un, 0, 2 * w) : at_desc(u, 2, 2 * w + 1));
    LDS_WAIT(); __syncthreads();
}

constexpr int SG_PITCH = 192, SG_TILE = 128 * SG_PITCH;
static_assert(4 * SG_TILE <= RING_BYTES, "SGU LDS");
struct SguPre { v4u tile[4]; bf16x8 wb[8]; v4u sul[4]; float bias; };
constexpr int SG_SU_OFF = 4 * SG_TILE, SG_SU_WAVE = 32 * 144;
static_assert(SG_SU_OFF + NWAVES * SG_SU_WAVE <= LDSCTL_OFF, "SGU LDS");
__device__ __forceinline__ void sgu_load(Frame& F, int u, SguPre& p) {
    const int gp = u & 3, ch = (u >> 2) & 31, b = u >> 7;
    const int lane = F.lane, r32 = lane & 31, hi = lane >> 5, w = F.wave, gsel = w >> 2, tb = w & 3, g = 2 * gp + gsel, t = 32 * tb + r32;
    const size_t tok0 = (size_t)b * SEQ + (size_t)ch * 128;
    const bf16* SVN = F.Q + 4 * (WS_TYPE_STRIDE / 2); const bf16* SU = F.Q + 3 * (WS_TYPE_STRIDE / 2);
#pragma unroll
    for (int gg = 0; gg < 2; ++gg)
#pragma unroll
        for (int it = 0; it < 2; ++it) { const int idx = F.tid + 512 * it, s_ = idx >> 3, c8 = idx & 7;
            p.tile[2 * gg + it] = __builtin_nontemporal_load((const GAS v4u*)(SVN + (tok0 + s_) * 512 + (2 * gp + gg) * 64 + c8 * 8)); }
    const bf16* Wg = F.SGUW + ((size_t)(g * 4 + tb) * 8 * 64 + lane) * 8;
#pragma unroll
    for (int ks = 0; ks < 8; ++ks) p.wb[ks] = *(const GAS bf16x8*)(Wg + ks * 512);
    p.bias = F.sgu_b[g * 128 + t];
#pragma unroll
    for (int i = 0; i < 4; ++i) p.sul[i] = __builtin_nontemporal_load((const GAS v4u*)(SU + (tok0 + 32 * tb + (lane >> 3) + 8 * i) * 512 + g * 64 + (lane & 7) * 8));
}
__device__ __forceinline__ void sgu_phase(Frame& F) {
    const int lane = F.lane, r32 = lane & 31, hi = lane >> 5, w = F.wave, gsel = w >> 2, tb = w & 3, t = 32 * tb + r32;
    const int G = lane >> 4, gi = lane & 15, gq4 = gi >> 2, gpp = gi & 3;
    constexpr int NU = BATCH * 32 * 4;
    int u = F.vcu; if (u >= NU) return;
    SguPre pre; sgu_load(F, u, pre);
    for (int it_ = 0; u < NU; u += F.G, ++it_) {
        LAS unsigned char* buf = F.lds + (it_ & 1) * (2 * SG_TILE);
#pragma unroll
        for (int gg = 0; gg < 2; ++gg)
#pragma unroll
            for (int it = 0; it < 2; ++it) { const int idx = F.tid + 512 * it, s_ = idx >> 3, c8 = idx & 7; *(LAS v4u*)(buf + gg * SG_TILE + s_ * SG_PITCH + c8 * 16) = pre.tile[2 * gg + it]; }
        bf16x8 wb[8]; const float bias = pre.bias;
#pragma unroll
        for (int i = 0; i < 8; ++i) wb[i] = pre.wb[i];
        LAS unsigned char* sus = F.lds + SG_SU_OFF + w * SG_SU_WAVE;
#pragma unroll
        for (int i = 0; i < 4; ++i) *(LAS v4u*)(sus + ((lane >> 3) + 8 * i) * 144 + (lane & 7) * 16) = pre.sul[i];
        LDS_WAIT(); __syncthreads();
        const int un = (u + F.G < NU) ? u + F.G : u;
        sgu_load(F, un, pre);
        const int gp = u & 3, ch = (u >> 2) & 31, b = u >> 7, g = 2 * gp + gsel;
        const size_t tok0 = (size_t)b * SEQ + (size_t)ch * 128;
        const LAS unsigned char* ts = buf + gsel * SG_TILE;
        f32x16 acc[2]; acc[0] = f32x16{}; acc[1] = f32x16{};
#pragma unroll
        for (int ks = 0; ks < 8; ++ks) {
#pragma unroll
            for (int eb = 0; eb < 2; ++eb) {
                const LAS unsigned char* pa = ts + (16 * ks + 8 * (G >> 1) + gq4) * SG_PITCH + (32 * eb + 16 * (G & 1) + 4 * gpp) * 2;
                const s16x4 lo = vtr(pa), hi4 = vtr(pa + 4 * SG_PITCH);
                const bf16x8 va = (bf16x8){lo[0], lo[1], lo[2], lo[3], hi4[0], hi4[1], hi4[2], hi4[3]};
                acc[eb] = __builtin_amdgcn_mfma_f32_32x32x16_bf16(va, wb[ks], acc[eb], 0, 0, 0);
            }
        }
        float ss = 0.f;
#pragma unroll
        for (int eb = 0; eb < 2; ++eb)
#pragma unroll
            for (int g4 = 0; g4 < 4; ++g4) { const int e = 32 * eb + 8 * g4 + 4 * hi;
                const v2u sw = *(const LAS v2u*)(sus + r32 * 144 + e * 2);
                const float a0 = bf_lo(sw.x) * (acc[eb][4 * g4 + 0] + bias), a1 = bf_hi(sw.x) * (acc[eb][4 * g4 + 1] + bias), a2 = bf_lo(sw.y) * (acc[eb][4 * g4 + 2] + bias), a3 = bf_hi(sw.y) * (acc[eb][4 * g4 + 3] + bias);
                ss += (a0 * a0 + a1 * a1) + (a2 * a2 + a3 * a3);
                v2u wv; wv.x = pk2(a0, a1); wv.y = pk2(a2, a3); *(LAS v2u*)(sus + r32 * 144 + e * 2) = wv; }
        ss += __shfl_xor(ss, 32);
        if (hi == 0) F.SSQS[(tok0 + t) * 8 + g] = ss;
        LDS_WAIT(); asm volatile("" ::: "memory");
#pragma unroll
        for (int i = 0; i < 4; ++i) { const int row = (lane >> 3) + 8 * i; const v4u ov = *(const LAS v4u*)(sus + row * 144 + (lane & 7) * 16);
            *(GAS v4u*)(F.MIX + (tok0 + 32 * tb + row) * 1024 + 512 + g * 64 + (lane & 7) * 8) = ov; }
        LDS_WAIT(); asm volatile("" ::: "memory");
    }
    LDS_WAIT(); __syncthreads();
}

#ifndef P2_VARIANT
#define P2_VARIANT 0
#endif
__device__ __forceinline__ void p2_mixers(Frame& F) {
    float mq = fabsf(F.q_norm_g[F.lane]), mk = fabsf(F.k_norm_g[F.lane]);
#pragma unroll
    for (int o = 1; o < 64; o <<= 1) { mq = fmaxf(mq, __shfl_xor(mq, o)); mk = fmaxf(mk, __shfl_xor(mk, o)); }
    const float mlog2 = 8.0f * mq * mk * 1.4426950408889634f;
    {
        constexpr int NU = BATCH * 8 * 8;
        AtPre pre;
        if (F.vcu < NU) at_prefetch(F, at_desc(F.vcu, 0, 2 * F.wave), pre);
#pragma unroll 1
        for (int u = F.vcu; u < NU; u += F.G) attn_unit(F, u, (u + F.G < NU) ? u + F.G : u, mlog2, pre);
    }
#pragma unroll 1
    for (int rep = 0; rep < (P2_VARIANT == 2 ? 2 : 1); ++rep)
    sgu_phase(F);
}

__device__ __forceinline__ unsigned f2ord(float f) { const unsigned u = __builtin_bit_cast(unsigned, f); return u ^ ((unsigned)((int)u >> 31) | 0x80000000u); }
__device__ __forceinline__ float ord2f(unsigned k) { const unsigned u = (k & 0x80000000u) ? (k ^ 0x80000000u) : ~k; return __builtin_bit_cast(float, u); }
#define CE_DESC(a, b) do { const unsigned _mx = max((a), (b)), _mn = min((a), (b)); (a) = _mx; (b) = _mn; } while (0)
__device__ __forceinline__ void sort16(unsigned (&k)[16]) {
#pragma unroll
    for (int k2 = 2; k2 <= 16; k2 <<= 1)
#pragma unroll
        for (int j = k2 >> 1; j > 0; j >>= 1)
#pragma unroll
            for (int i = 0; i < 16; ++i) { const int l = i ^ j; if (l > i) { if ((i & k2) == 0) CE_DESC(k[i], k[l]); else CE_DESC(k[l], k[i]); } }
}
__device__ __forceinline__ void merge16(unsigned (&a)[16], const unsigned (&b)[16]) {
#pragma unroll
    for (int i = 0; i < 16; ++i) a[i] = max(a[i], b[15 - i]);
#pragma unroll
    for (int j = 8; j > 0; j >>= 1)
#pragma unroll
        for (int i = 0; i < 16; ++i) { const int l = i ^ j; if (l > i) CE_DESC(a[i], a[l]); }
}
__device__ __forceinline__ void swap16(const unsigned (&x)[16], const unsigned (&y)[16], unsigned (&xo)[16], unsigned (&yo)[16]) {
#pragma unroll
    for (int i = 0; i < 16; ++i) { auto rr = __builtin_amdgcn_permlane32_swap(x[i], y[i], false, false); xo[i] = rr[0]; yo[i] = rr[1]; }
}

__host__ __device__ constexpr int cand0(int q) { return q < 16 ? q : q < 21 ? 0x20 + (q - 16) : q < 24 ? 0x40 + (q - 21) : q < 26 ? 0x60 + (q - 24) : q == 26 ? 0x80 : q == 27 ? 0xa0 : q == 28 ? 0xc0 : q == 29 ? 0xe0 : 0xff; }
__host__ __device__ constexpr int cand1(int q) { return q < 8 ? 0x10 + q : q < 12 ? 0x30 + (q - 8) : q < 14 ? 0x50 + (q - 12) : q < 16 ? 0x70 + (q - 14) : q == 16 ? 0x90 : q == 17 ? 0xb0 : q == 18 ? 0xd0 : q == 19 ? 0xf0 : 0xff; }

constexpr int TK_SK_BYTES = 2 * 128 * 256;
constexpr int TK_LDS_WAVE = 32 * 32 * 4, TK_SCR_OFF = TK_SK_BYTES;
static_assert(TK_SCR_OFF + NWAVES * TK_LDS_WAVE <= RING_BYTES, "top-k LDS");
__device__ __forceinline__ void tk_load_q(Frame& F, size_t t0, int hd, int half, int r32, int hi, bf16x8 (&qf)[8]) {
#pragma unroll
    for (int i = 0; i < 8; ++i) qf[i] = __builtin_nontemporal_load((const GAS bf16x8*)(F.QP + ((((t0 >> 5) * 8 + hd) * 2 + half) * 8 + i) * 512 + (size_t)(32 * hi + r32) * 8));
}
template <int HALF_> __device__ __forceinline__ void half_top16(Frame& F, const bf16x8 (&qf)[8], int r32, int hi, unsigned (&best)[16]) {
#pragma unroll
    for (int nb = 0; nb < 4; ++nb) {
        f32x16 acc;
#pragma unroll
        for (int r = 0; r < 16; ++r) acc[r] = 64.0f;
        const int row = HALF_ * 128 + 32 * nb + r32;
#pragma unroll
        for (int ks = 0; ks < 8; ++ks) { const bf16x8 a = *(const LAS bf16x8*)(F.lds + row * 256 + (((2 * ks + hi) ^ (row & 15)) << 4));
            acc = __builtin_amdgcn_mfma_f32_32x32x16_bf16(a, qf[ks], acc, 0, 0, 0); }
        unsigned k[16];
#pragma unroll
        for (int r = 0; r < 16; ++r) { const int n = 32 * nb + (r & 3) + 8 * (r >> 2) + 4 * hi; k[r] = (__builtin_bit_cast(unsigned, __builtin_amdgcn_fmed3f(acc[r], 4.0f, 124.0f)) & ~127u) | (unsigned)(127 - n); }
        sort16(k);
        if (nb == 0) {
#pragma unroll
            for (int i = 0; i < 16; ++i) best[i] = k[i];
        } else merge16(best, k);
    }
}

__device__ __forceinline__ void topk_task(Frame& F, int tb, int hd, bf16x8 (&qa)[8], bool has_next, int tb_next, int hd_next) {
    const int lane = F.lane, r32 = lane & 31, hi = lane >> 5;
    const size_t t0 = (size_t)tb * 32;
    unsigned bk[2][16];
    bf16x8 qb[8];
    tk_load_q(F, t0, hd, 1, r32, hi, qb);
    half_top16<0>(F, qa, r32, hi, bk[0]);
    if (has_next) tk_load_q(F, (size_t)tb_next * 32, hd_next, 0, r32, hi, qa);
    half_top16<1>(F, qb, r32, hi, bk[1]);
    unsigned xa[16], ya[16];
    swap16(bk[0], bk[1], xa, ya);
    merge16(xa, ya);
    unsigned A[16], B[16];
    swap16(xa, xa, A, B);
    LAS unsigned* tk = (LAS unsigned*)(F.lds + TK_SCR_OFF + F.wave * TK_LDS_WAVE) + r32 * 32;
#pragma unroll
    for (int i = 0; i < 16; ++i) tk[16 * hi + i] = hi ? B[i] : A[i];
    float v1[16], v2[16];
#pragma unroll
    for (int i = 0; i < 16; ++i) { v1[i] = __builtin_bit_cast(float, A[i] & ~127u); v2[i] = __builtin_bit_cast(float, B[i] & ~127u); }
    unsigned c0[16], c1[16];
#pragma unroll
    for (int q = 0; q < 32; ++q) {
        const int ij0 = cand0(q), ij1 = cand1(q);
        const float s0 = (ij0 == 0xff) ? 0.0f : v1[ij0 >> 4] + v2[ij0 & 15];
        const float s1 = (ij1 == 0xff) ? 0.0f : v1[ij1 >> 4] + v2[ij1 & 15];
        const unsigned k0 = (__builtin_bit_cast(unsigned, s0) & ~255u) | (unsigned)(ij0 & 255), k1 = (__builtin_bit_cast(unsigned, s1) & ~255u) | (unsigned)(ij1 & 255);
        const unsigned kk = hi ? k1 : k0;
        if (q < 16) c0[q] = kk; else c1[q - 16] = kk;
    }
    sort16(c0); sort16(c1); merge16(c0, c1);
    unsigned L0[16], L1[16];
    swap16(c0, c0, L0, L1);
    merge16(L0, L1);
    const float mx = __builtin_bit_cast(float, L0[0] & ~255u);
    float ex[16], den = 0.f;
#pragma unroll
    for (int i = 0; i < 16; ++i) { ex[i] = __expf(__builtin_bit_cast(float, L0[i] & ~255u) - mx); den += ex[i]; }
    const float rden = 1.0f / den;
    LDS_WAIT(); asm volatile("" ::: "memory");
    int ei[8]; float gt[8];
#pragma unroll
    for (int kk = 0; kk < 8; ++kk) {
        const unsigned key = hi ? L0[8 + kk] : L0[kk]; const float e = hi ? ex[8 + kk] : ex[kk];
        const int i = (key >> 4) & 15, j = key & 15;
        const int i1 = 127 - (int)(tk[i] & 127u), i2 = 127 - (int)(tk[16 + j] & 127u);
        ei[kk] = i1 * 128 + i2; gt[kk] = e * rden;
    }
    unsigned short* ep = F.EIDX + (t0 + r32) * 128 + hd * 16 + 8 * hi; float* gp = F.GATE + (t0 + r32) * 128 + hd * 16 + 8 * hi;
    *(GAS v4u*)ep = (v4u){(unsigned)ei[0] | ((unsigned)ei[1] << 16), (unsigned)ei[2] | ((unsigned)ei[3] << 16), (unsigned)ei[4] | ((unsigned)ei[5] << 16), (unsigned)ei[6] | ((unsigned)ei[7] << 16)};
    *(GAS f32x4*)gp = (f32x4){gt[0], gt[1], gt[2], gt[3]}; *(GAS f32x4*)(gp + 4) = (f32x4){gt[4], gt[5], gt[6], gt[7]};
    LDS_WAIT(); asm volatile("" ::: "memory");
}

__device__ __forceinline__ void p5_topk(Frame& F) {
    for (int i = F.tid; i < 2 * 128 * 16; i += NWAVES * 64) { const int row = i >> 4, ch = i & 15;
        *(LAS v4u*)(F.lds + row * 256 + ((ch ^ (row & 15)) << 4)) = *(const GAS v4u*)(F.SK + (size_t)row * 128 + ch * 8); }
    LDS_WAIT(); __syncthreads();
    pg8::StaticOrder S; S.init(TOK, QPW, F.G, (int)blockIdx.x);
    pg8::Unit u, un;
    bf16x8 qf[8];
    bool have = S.next(0, u);
    if (have) tk_load_q(F, (size_t)(u.pm * 8 + F.wave) * 32, u.pn, 0, F.lane & 31, F.lane >> 5, qf);
#pragma unroll 1
    for (int i = 0; have; ++i) {
        const bool hn = S.next(i + 1, un);
        topk_task(F, u.pm * 8 + F.wave, u.pn, qf, hn, un.pm * 8 + F.wave, un.pn);
        u = un; have = hn;
    }
    LDS_WAIT(); __syncthreads();
}

constexpr int PE_TPI = 16, PE_NITEM = TOK / PE_TPI;
constexpr int CW_QA = 8192, CW_QB = 8192 + 8 * 64;

template <int CTRL> __device__ __forceinline__ int dpp_i(int v) { return __builtin_amdgcn_update_dpp(0, v, CTRL, 0xf, 0xf, true); }
template <int CTRL> __device__ __forceinline__ float dpp_f(float v) { return __builtin_bit_cast(float, __builtin_amdgcn_update_dpp(0, __builtin_bit_cast(int, v), CTRL, 0xf, 0xf, true)); }
constexpr int DPP_XOR1 = 0xB1, DPP_XOR2 = 0x4E, DPP_HMIRROR = 0x141, DPP_ROR8 = 0x128;

__device__ __forceinline__ void pe_load_ix(Frame& F, int t, v4u (&ix)[2]) {
    const int gl = F.lane >> 3;
#pragma unroll
    for (int q = 0; q < 2; ++q) ix[q] = *(const GAS v4u*)(F.EIDX + (size_t)t * 128 + gl * 16 + 8 * q);
}
__device__ __forceinline__ void pe_load_rows(const void* TAB, const v4u (&ix)[2], int coloff, v4u (&w)[16]) {
#pragma unroll
    for (int i = 0; i < 16; ++i) { const unsigned pr = ix[i >> 3][(i >> 1) & 3]; const unsigned e = (i & 1) ? (pr >> 16) : (pr & 0xffffu);
        w[i] = *(const GAS v4u*)((const char*)TAB + (size_t)e * 128 + coloff); }
}
__device__ __forceinline__ v4u pe_quant16(const v4u& lo, const v4u& hi, float inv) {
    v4u o;
#pragma unroll
    for (int q = 0; q < 4; ++q) { const unsigned w0 = (q < 2) ? lo[2 * q] : hi[2 * q - 4], w1 = (q < 2) ? lo[2 * q + 1] : hi[2 * q - 3];
        const int b0 = (int)rintf(bf_lo(w0) * inv), b1 = (int)rintf(bf_hi(w0) * inv), b2 = (int)rintf(bf_lo(w1) * inv), b3 = (int)rintf(bf_hi(w1) * inv);
        o[q] = (unsigned)(b0 & 0xff) | ((unsigned)(b1 & 0xff) << 8) | ((unsigned)(b2 & 0xff) << 16) | ((unsigned)(b3 & 0xff) << 24); }
    return o;
}
__device__ __forceinline__ void peA_compute(Frame& F, int* PA, int j, int t, const v4u& hq, const v4u (&w)[16]) {
    const int gl = F.lane >> 3, sub = F.lane & 7;
    int r0 = 0, r1 = 0;
#pragma unroll
    for (int i = 0; i < 16; ++i) {
        int p = __builtin_amdgcn_sdot4((int)w[i].x, (int)hq.x, 0, false);
        p = __builtin_amdgcn_sdot4((int)w[i].y, (int)hq.y, p, false); p = __builtin_amdgcn_sdot4((int)w[i].z, (int)hq.z, p, false); p = __builtin_amdgcn_sdot4((int)w[i].w, (int)hq.w, p, false);
        p += dpp_i<DPP_XOR1>(p); p += dpp_i<DPP_XOR2>(p); p += dpp_i<DPP_HMIRROR>(p);
        if (i < 8) r0 = (sub == i) ? p : r0; else r1 = (sub == i - 8) ? p : r1;
    }
    const unsigned pk = ((unsigned)((r0 + 32) >> 6) & 0xffffu) | ((unsigned)((r1 + 32) >> 6) << 16);
    ((unsigned*)PA)[((size_t)j * TOK + t) * 64 + gl * 8 + sub] = pk;
}
__device__ __forceinline__ void peB_compute(Frame& F, int j, int t, const v4u& cq, float cs, const v4u (&w)[16]) {
    const int lane = F.lane, gl = lane >> 3, sub = lane & 7;
    typedef float f32x2_t __attribute__((ext_vector_type(2)));
    const int mycol = 128 * j + 2 * lane;
    const unsigned xw = *(const GAS unsigned*)(F.XB + (size_t)t * DM + mycol);
    f32x2_t xin; xin.x = bf_lo(xw); xin.y = bf_hi(xw);
    int acc[16];
#pragma unroll
    for (int c = 0; c < 16; ++c) acc[c] = 0;
#pragma unroll
    for (int m = 0; m < 4; ++m)
#pragma unroll
        for (int q = 0; q < 4; ++q) {
            const unsigned a0 = w[4 * m + 0][q], a1 = w[4 * m + 1][q], a2 = w[4 * m + 2][q], a3 = w[4 * m + 3][q];
            const unsigned t0 = __builtin_amdgcn_perm(a1, a0, 0x05010400u), t1 = __builtin_amdgcn_perm(a1, a0, 0x07030602u);
            const unsigned t2 = __builtin_amdgcn_perm(a3, a2, 0x05010400u), t3 = __builtin_amdgcn_perm(a3, a2, 0x07030602u);
            const unsigned o0 = __builtin_amdgcn_perm(t2, t0, 0x05040100u), o1 = __builtin_amdgcn_perm(t2, t0, 0x07060302u);
            const unsigned o2 = __builtin_amdgcn_perm(t3, t1, 0x05040100u), o3 = __builtin_amdgcn_perm(t3, t1, 0x07060302u);
            acc[4 * q + 0] = __builtin_amdgcn_sdot4((int)o0, (int)cq[m], acc[4 * q + 0], false); acc[4 * q + 1] = __builtin_amdgcn_sdot4((int)o1, (int)cq[m], acc[4 * q + 1], false);
            acc[4 * q + 2] = __builtin_amdgcn_sdot4((int)o2, (int)cq[m], acc[4 * q + 2], false); acc[4 * q + 3] = __builtin_amdgcn_sdot4((int)o3, (int)cq[m], acc[4 * q + 3], false);
        }
    int h8v[8];
#pragma unroll
    for (int c = 0; c < 8; ++c) { auto rr = __builtin_amdgcn_permlane32_swap((unsigned)acc[c], (unsigned)acc[c + 8], false, false);
        unsigned r0 = rr[0], r1 = rr[1]; asm volatile("" : "+v"(r0), "+v"(r1));
        h8v[c] = (int)r0 + (int)r1; }
    const bool b4 = (lane >> 4) & 1, b3 = (lane >> 3) & 1;
    int h4[4];
#pragma unroll
    for (int c = 0; c < 4; ++c) { const int keep = b4 ? h8v[c + 4] : h8v[c], give = b4 ? h8v[c] : h8v[c + 4]; h4[c] = keep + __builtin_amdgcn_ds_swizzle(give, 0x401F); }
    int h2[2];
#pragma unroll
    for (int c = 0; c < 2; ++c) { const int keep = b3 ? h4[c + 2] : h4[c], give = b3 ? h4[c] : h4[c + 2]; h2[c] = keep + dpp_i<DPP_ROR8>(give); }
    const int srcl = ((lane >> 3) + 8 * (lane & 1) + 16 * ((lane >> 1) & 1) + 32 * ((lane >> 2) & 1)) * 4;
    const int q0 = __builtin_amdgcn_ds_bpermute(srcl, h2[0]), q1 = __builtin_amdgcn_ds_bpermute(srcl, h2[1]);
    f32x2_t o; o.x = xin.x + cs * (float)q0; o.y = xin.y + cs * (float)q1;
    __builtin_nontemporal_store(o, (GAS f32x2_t*)(F.out + (size_t)t * DM + mycol));
}

template <bool PHASE_B> __device__ __forceinline__ void pe_item(Frame& F, int j, int t0) {
    const int sub = F.lane & 7, gl = F.lane >> 3, coloff = 128 * j + 16 * sub;
    const void* TAB = (const char*)(PHASE_B ? (const void*)F.V8 : (const void*)F.U8) + (size_t)j * NEXP * 128;
    const int rowoff = 16 * sub;
    v4u ixA[2], ixB[2], wA[16], wB[16], auxA, auxB, aux2A = {}, aux2B = {}; float csA = 0.f, csB = 0.f;
#define PE_AUX(t, aux, aux2, cs) do { if (PHASE_B) { aux = *(const GAS v4u*)(F.CQ + (size_t)(t) * 32 + gl * 4); cs = F.CS[t]; } \
        else { aux = *(const GAS v4u*)(F.XB + (size_t)(t) * DM + coloff); aux2 = *(const GAS v4u*)(F.XB + (size_t)(t) * DM + coloff + 8); cs = F.HINV[t]; } } while (0)
#define PE_COMPUTE(t, aux, aux2, cs, w) do { if (PHASE_B) peB_compute(F, j, (t), aux, cs, w); else peA_compute(F, F.PA, j, (t), pe_quant16(aux, aux2, cs), w); } while (0)
    pe_load_ix(F, t0, ixA); pe_load_rows(TAB, ixA, rowoff, wA); PE_AUX(t0, auxA, aux2A, csA); pe_load_ix(F, t0 + 1, ixB);
#pragma unroll 1
    for (int k = 0; k < PE_TPI - 2; k += 2) {
        pe_load_rows(TAB, ixB, rowoff, wB); PE_AUX(t0 + k + 1, auxB, aux2B, csB);
        pe_load_ix(F, t0 + k + 2, ixA);
        PE_COMPUTE(t0 + k, auxA, aux2A, csA, wA);
        pe_load_rows(TAB, ixA, rowoff, wA); PE_AUX(t0 + k + 2, auxA, aux2A, csA); pe_load_ix(F, t0 + k + 3, ixB);
        PE_COMPUTE(t0 + k + 1, auxB, aux2B, csB, wB);
    }
    pe_load_rows(TAB, ixB, rowoff, wB); PE_AUX(t0 + PE_TPI - 1, auxB, aux2B, csB);
    PE_COMPUTE(t0 + PE_TPI - 2, auxA, aux2A, csA, wA);
    PE_COMPUTE(t0 + PE_TPI - 1, auxB, aux2B, csB, wB);
#undef PE_AUX
#undef PE_COMPUTE
}

template <bool PHASE_B> __device__ __forceinline__ void p6_sliced(Frame& F) {
    const unsigned x = xb_xcc_id() & 7u;
    gu32* Q = F.ctl + (PHASE_B ? CW_QB : CW_QA);
    for (unsigned s = 0; s < 8; ++s) {
        const int j = (int)((x + s) & 7u);
        for (;;) {
            unsigned c = 0;
            if (F.lane == 0) c = __hip_atomic_fetch_add((unsigned*)(Q + 64 * j), 1u, __ATOMIC_RELAXED, __HIP_MEMORY_SCOPE_AGENT);
            c = (unsigned)__builtin_amdgcn_readfirstlane((int)c);
            if (c >= (unsigned)PE_NITEM) break;
            pe_item<PHASE_B>(F, j, (int)c * PE_TPI);
        }
    }
}

__device__ __forceinline__ void p6_reduce(Frame& F) {
    const int gw = F.vcu * NWAVES + F.wave, NGW = F.G * NWAVES, lane = F.lane;
    const int p0 = 16 * (lane >> 3) + (lane & 7);
    constexpr int NB = 4;
    for (int tb = gw * NB; tb < TOK; tb += NGW * NB) {
        int s[NB][2], e[NB][2]; float gt[NB][2], hs[NB];
#pragma unroll
        for (int b = 0; b < NB; ++b) {
            const int t = tb + b; hs[b] = F.HS[t];
            int a0 = 0, a1 = 0;
#pragma unroll
            for (int j = 0; j < 8; ++j) { const unsigned w = __builtin_nontemporal_load((const GAS unsigned*)F.PA + ((size_t)j * TOK + t) * 64 + lane); a0 += (int)(short)(w & 0xffffu); a1 += (int)w >> 16; }
            s[b][0] = a0; s[b][1] = a1;
#pragma unroll
            for (int hh = 0; hh < 2; ++hh) { const int p = p0 + 8 * hh; e[b][hh] = (int)F.EIDX[(size_t)t * 128 + p]; gt[b][hh] = F.GATE[(size_t)t * 128 + p]; }
        }
        float su[NB][2], sv[NB][2];
#pragma unroll
        for (int b = 0; b < NB; ++b)
#pragma unroll
            for (int hh = 0; hh < 2; ++hh) { su[b][hh] = ((const float*)(F.ws + WS_SCU))[e[b][hh]]; sv[b][hh] = ((const float*)(F.ws + WS_SCV))[e[b][hh]]; }
#pragma unroll
        for (int b = 0; b < NB; ++b) {
            const int t = tb + b;
            float cf[2]; float mx = 0.f;
#pragma unroll
            for (int hh = 0; hh < 2; ++hh) { const float a = hs[b] * su[b][hh] * (64.0f * (float)s[b][hh]);
                cf[hh] = gt[b][hh] * 0.5f * a * (1.0f + erff(a * 0.70710678118654752f)) * sv[b][hh]; mx = fmaxf(mx, fabsf(cf[hh])); }
#pragma unroll
            for (int o = 1; o < 64; o <<= 1) mx = fmaxf(mx, __shfl_xor(mx, o));
            const float sc = fmaxf(mx, 1e-30f) * (1.0f / 127.0f), inv = 1.0f / sc;
#pragma unroll
            for (int hh = 0; hh < 2; ++hh) {
                int v = ((int)rintf(cf[hh] * inv) & 0xff) << (8 * (lane & 3));
                v |= dpp_i<DPP_XOR1>(v); v |= dpp_i<DPP_XOR2>(v);
                if ((lane & 3) == 0) F.CQ[(size_t)t * 32 + ((p0 + 8 * hh) >> 2)] = (unsigned)v;
            }
            if (lane == 0) F.CS[t] = sc;
        }
    }
}

__device__ __forceinline__ void p5_scales(Frame& F) {
    const int gt = F.vcu * NWAVES * 64 + F.tid, NGT = F.G * NWAVES * 64;
    for (int t = gt; t < TOK; t += NGT) {
        float mx = 0.f, ss = 0.f;
#pragma unroll
        for (int q = 0; q < 4; ++q) { const f32x4 m = *(const GAS f32x4*)(F.MAXP + (size_t)t * 16 + 4 * q), p = *(const GAS f32x4*)(F.SSQ2P + (size_t)t * 16 + 4 * q);
            mx = fmaxf(mx, fmaxf(fmaxf(m[0], m[1]), fmaxf(m[2], m[3]))); ss += (p[0] + p[1]) + (p[2] + p[3]); }
        const float rstd2 = 1.0f / sqrtf(ss * (1.0f / DM) + pg8::EPS_F), sc = fmaxf(mx, 1e-20f) * (1.0f / 127.0f);
        F.HINV[t] = 1.0f / sc; F.HS[t] = sc * rstd2;
    }
}

#ifndef PROBE_REPEAT
#define PROBE_REPEAT -1
#endif
struct Args { const float* in[16]; float* out; unsigned char* ws; int ph_lo, ph_hi; };

template <class Sched> __device__ __forceinline__ void prep_tab_outproj(Frame& F, const Sched& S) {
    LAS float* tab = (LAS float*)(F.lds + TAB_OFF);
    pg8::Unit u;
    for (int i = 0; S.next(i, u) && i < 4; ++i) {
        if (F.tid < 256) {
            const int row = u.pm * 256 + F.tid;
            const f32x4 a0 = *(const GAS f32x4*)(F.SSQA + (size_t)row * 8), a1 = *(const GAS f32x4*)(F.SSQA + (size_t)row * 8 + 4);
            const f32x4 s0 = *(const GAS f32x4*)(F.SSQS + (size_t)row * 8), s1 = *(const GAS f32x4*)(F.SSQS + (size_t)row * 8 + 4);
            const float sa = ((a0[0] + a0[1]) + (a0[2] + a0[3])) + ((a1[0] + a1[1]) + (a1[2] + a1[3]));
            const float ss = ((s0[0] + s0[1]) + (s0[2] + s0[3])) + ((s1[0] + s1[1]) + (s1[2] + s1[3]));
            const float ra = 1.0f / sqrtf(sa * (1.0f / 512.0f) + pg8::EPS_F), rs = 1.0f / sqrtf(ss * (1.0f / 512.0f) + pg8::EPS_F);
            tab[(i * 256 + F.tid) * 2] = ra / rs; tab[(i * 256 + F.tid) * 2 + 1] = rs;
        }
    }
    LDS_WAIT(); __syncthreads();
}
template <class Sched> __device__ __forceinline__ void prep_tab_query(Frame& F, const Sched& S) {
    LAS float* tab = (LAS float*)(F.lds + TAB_OFF);
    pg8::Unit u;
    for (int i = 0; S.next(i, u) && i < 8; ++i) {
        if (F.tid < 256) {
            const int row = u.pm * 256 + F.tid; float s = 0.f;
#pragma unroll
            for (int j = 0; j < 4; ++j) { const f32x4 p = *(const GAS f32x4*)(F.SSQ2P + (size_t)row * 16 + 4 * j); s += (p[0] + p[1]) + (p[2] + p[3]); }
            tab[i * 256 + F.tid] = 1.0f / sqrtf(s * (1.0f / DM) + pg8::EPS_F);
        }
    }
    LDS_WAIT(); __syncthreads();
}

__device__ __forceinline__ void run_p1(Frame& F) {
    pg8::Gemm g{F.XB, F.Win_t, TOK, INW, DM}; pg8::StaticOrder S; S.init(TOK, INW, F.G, (int)blockIdx.x);
    pg8::EpiInProj E{F.RSTD1, F.q_norm_g, F.k_norm_g, F.sgu_norm_g, F.Q, WS_TYPE_STRIDE / 2};
    pg8::gemm_phase<pg8::EpiInProj, pg8::StaticOrder, true, true>(F.lds + RING_OFF, g, S, E);
}
__device__ __forceinline__ void run_p3(Frame& F) {
    pg8::Gemm g{F.MIX, F.Wout_t, TOK, DM, DM}; pg8::StaticOrder S; S.init(TOK, DM, F.G, (int)blockIdx.x);
    prep_tab_outproj(F, S);
    pg8::EpiOutProj E{F.x, F.out, F.XB, F.SSQ2P, F.MAXP, (const LAS float*)(F.lds + TAB_OFF)};
    pg8::gemm_phase<pg8::EpiOutProj, pg8::StaticOrder, true, true>(F.lds + RING_OFF, g, S, E);
}
__device__ __forceinline__ void run_p4(Frame& F) {
    pg8::Gemm g{F.XB, F.Wq_t, TOK, QPW, DM}; pg8::StaticOrder S; S.init(TOK, QPW, F.G, (int)blockIdx.x);
    prep_tab_query(F, S);
    pg8::EpiQuery E{F.QP, (const LAS float*)(F.lds + TAB_OFF)};
    pg8::gemm_phase<pg8::EpiQuery, pg8::StaticOrder, true, true>(F.lds + RING_OFF, g, S, E);
}

__global__ void __launch_bounds__(NWAVES * 64, 2) hyb_fwd(Args args) {
    extern __shared__ __attribute__((aligned(16))) unsigned char lds[];
    Frame F;
    F.lds = (LAS unsigned char*)lds;
    F.MISC = (volatile LAS unsigned*)(F.lds + MISC_OFF);
    F.tid = threadIdx.x; F.lane = F.tid & 63; F.wave = __builtin_amdgcn_readfirstlane(F.tid >> 6);
    F.G = gridDim.x; { const int bx = blockIdx.x; F.vcu = (F.G % 8 == 0) ? (bx % 8) * (F.G / 8) + bx / 8 : bx; }
    unsigned char* ws = args.ws;
    F.ctl = (gu32*)(ws + WS_CTL);
    F.x = args.in[0]; F.norm1_g = args.in[1]; F.w_in = args.in[2]; F.q_norm_g = args.in[3]; F.k_norm_g = args.in[4]; F.sgu_norm_g = args.in[5]; F.sgu_w = args.in[6]; F.sgu_b = args.in[7];
    F.attn_out_g = args.in[8]; F.sgu_out_g = args.in[9]; F.w_out = args.in[10]; F.norm2_g = args.in[11]; F.w_query = args.in[12]; F.sub_keys = args.in[13]; F.expert_u = args.in[14]; F.expert_v = args.in[15];
    F.out = args.out;
    F.Win_t = (bf16*)(ws + WS_WIN); F.Wout_t = (bf16*)(ws + WS_WOUT); F.Wq_t = (bf16*)(ws + WS_WQ); F.SK = (bf16*)(ws + WS_SK); F.SGUW = (bf16*)(ws + WS_SGUW);
    F.U8 = (signed char*)(ws + WS_UB); F.V8 = (signed char*)(ws + WS_VB); F.ws = ws;
    F.H8 = (signed char*)(ws + WS_H8); F.MAXP = (float*)(ws + WS_MAXP); F.HINV = (float*)(ws + WS_HINV); F.HS = (float*)(ws + WS_HS); F.PA = (int*)(ws + WS_PA); F.CQ = (unsigned*)(ws + WS_COEF); F.CS = (float*)(ws + WS_COEF0);
    F.XB = (bf16*)(ws + WS_XB); F.Q = (bf16*)(ws + WS_Q); F.QP = (bf16*)(ws + WS_QP); F.MIX = (bf16*)(ws + WS_MIX);
    F.RSTD1 = (float*)(ws + WS_RSTD1); F.SSQA = (float*)(ws + WS_SSQA); F.SSQS = (float*)(ws + WS_SSQS); F.SSQ2P = (float*)(ws + WS_SSQ2P); F.GATE = (float*)(ws + WS_GATE); F.EIDX = (unsigned short*)(ws + WS_EIDX);
    for (int u = F.tid; u < (LDS_BYTES - LDSCTL_OFF) / 4; u += NWAVES * 64) ((LAS unsigned*)(F.lds + LDSCTL_OFF))[u] = 0u;
    __syncthreads();
    XcdBarrier bar; bar.bar = (unsigned*)(F.ctl + CW_BAR); bar.x = 0; bar.st = nullptr;
    const int lo = args.ph_lo, hi = args.ph_hi;
    if (hi - lo > 1) bar = xcd_barrier_post((unsigned*)(F.ctl + CW_BAR), F.MISC + 8);
#define IN(k) (lo <= (k) && (k) < hi)

#define SEAM(k) do { if (IN(k) && IN((k) + 1)) { xcd_barrier(bar); if (PROBE_REPEAT == 100 + (k)) { xcd_barrier(bar); xcd_barrier(bar); xcd_barrier(bar); xcd_barrier(bar); } } } while (0)

    if (IN(0)) { p0_prologue(F); if (PROBE_REPEAT == 0) { xcd_barrier(bar); p0_prologue(F); } } SEAM(0);
    if (IN(1)) { run_p1(F); if (PROBE_REPEAT == 1) { xcd_barrier(bar); run_p1(F); } } SEAM(1);
    if (IN(2)) { p2_mixers(F); if (PROBE_REPEAT == 2) { xcd_barrier(bar); p2_mixers(F); } } SEAM(2);
    if (IN(3)) { run_p3(F); if (PROBE_REPEAT == 3) { xcd_barrier(bar); run_p3(F); } } SEAM(3);
    if (IN(4)) { run_p4(F); if (PROBE_REPEAT == 4) { xcd_barrier(bar); run_p4(F); } }
    if (!(IN(4) && IN(5))) {   } else { asm volatile("s_waitcnt vmcnt(0)" ::: "memory"); __syncthreads(); }
    if (IN(5)) {
#pragma unroll 1
        for (int rep = 0; rep < (PROBE_REPEAT == 5 ? 2 : 1); ++rep) p5_topk(F);
#pragma unroll 1
        for (int rep = 0; rep < (PROBE_REPEAT == 15 ? 2 : 1); ++rep) p5_scales(F);
    } SEAM(5);
    if (IN(6)) {
#pragma unroll 1
        for (int rep = 0; rep < (PROBE_REPEAT == 6 ? 2 : 1); ++rep) {
            if (rep) { xcd_barrier(bar); if (blockIdx.x == 0 && F.tid < 8) __hip_atomic_store((unsigned*)(F.ctl + CW_QA + 64 * F.tid), 0u, __ATOMIC_RELAXED, __HIP_MEMORY_SCOPE_AGENT); xcd_barrier(bar); }
            p6_sliced<false>(F);
        }
        if (hi - lo > 1) xcd_barrier(bar);
#pragma unroll 1
        for (int rep = 0; rep < (PROBE_REPEAT == 7 ? 2 : 1); ++rep) p6_reduce(F);
        if (hi - lo > 1) xcd_barrier(bar);
#pragma unroll 1
        for (int rep = 0; rep < (PROBE_REPEAT == 8 ? 2 : 1); ++rep) {
            if (rep) { xcd_barrier(bar); if (blockIdx.x == 0 && F.tid < 8) __hip_atomic_store((unsigned*)(F.ctl + CW_QB + 64 * F.tid), 0u, __ATOMIC_RELAXED, __HIP_MEMORY_SCOPE_AGENT); xcd_barrier(bar); }
            p6_sliced<true>(F);
        }
    }
#undef IN
#undef SEAM
}

extern "C" void kernel_launch(void* const* d_in, const int* in_sizes, int n_in, void* d_out, int out_size, void* d_ws, size_t ws_size, hipStream_t stream) {
    static int grid = 0;
    if (grid == 0) {
        if (n_in != 16 || in_sizes[0] != TOK * DM || out_size != TOK * DM || ws_size < WS_END) { fprintf(stderr, "kernel_launch: unexpected shapes (n_in %d, in0 %d, out %d, ws %zu)\n", n_in, n_in > 0 ? in_sizes[0] : -1, out_size, ws_size); grid = -1; return; }
        int dev = 0, cus = 0, per_cu = 0;
        if (hipGetDevice(&dev) != hipSuccess || hipDeviceGetAttribute(&cus, hipDeviceAttributeMultiprocessorCount, dev) != hipSuccess) { fprintf(stderr, "kernel_launch: device query failed\n"); grid = -1; return; }
        if (hipFuncSetAttribute((const void*)hyb_fwd, hipFuncAttributeMaxDynamicSharedMemorySize, LDS_BYTES) != hipSuccess) { fprintf(stderr, "kernel_launch: hipFuncSetAttribute failed\n"); grid = -1; return; }
        if (hipOccupancyMaxActiveBlocksPerMultiprocessor(&per_cu, (const void*)hyb_fwd, NWAVES * 64, LDS_BYTES) != hipSuccess || per_cu < 1) { fprintf(stderr, "kernel_launch: occupancy query reports %d blocks per CU\n", per_cu); per_cu = 1; }
        (void)hipGetLastError();
        grid = cus;
        if (grid % 8 != 0) grid -= grid % 8;
    }
    if (grid < 0) return;
    (void)hipMemsetAsync((char*)d_ws + WS_CTL, 0, CTL_ZERO_BYTES, stream);
    Args a{};
    for (int i = 0; i < 16; ++i) a.in[i] = (const float*)d_in[i];
    a.out = (float*)d_out; a.ws = (unsigned char*)d_ws;
    if (N_LAUNCHES == 1) { a.ph_lo = 0; a.ph_hi = NPHASE; hipLaunchKernelGGL(hyb_fwd, dim3(grid), dim3(NWAVES * 64), LDS_BYTES, stream, a); }
    else for (int li = 0; li < NPHASE; ++li) { a.ph_lo = li; a.ph_hi = li + 1; hipLaunchKernelGGL(hyb_fwd, dim3(grid), dim3(NWAVES * 64), LDS_BYTES, stream, a); }
}
```

```cpp
#include <hip/hip_runtime.h>
#include <cstdio>
#include <cstdint>
#include <cmath>
namespace pg8 {
#define PG8_LAS __attribute__((address_space(3)))
typedef unsigned short bf16_t;
typedef short bf16x8 __attribute__((ext_vector_type(8)));
typedef float f32x4 __attribute__((ext_vector_type(4)));
typedef unsigned u32x4 __attribute__((ext_vector_type(4)));
constexpr int BM = 256, BK = 64, HALF = 128, HTB = HALF * BK * 2  , STAGE_BYTES = 8 * HTB, NXCD = 8, WGM = 8;

__host__ __device__ __forceinline__ int lds_byte(int r, int c) { const int st = (r >> 4) * 2 + (c >> 5), rr = r & 15, cc = c & 31, ob = rr * 64 + cc * 2; return st * 1024 + (ob ^ (((ob >> 9) & 1) << 5)); }
__host__ __device__ __forceinline__ void stage_rc(int b, int& R, int& C) { const int st = b / 1024, sb = b % 1024, swz = sb ^ (((sb >> 9) & 1) << 5); R = (st >> 1) * 16 + swz / 64; C = (st & 1) * 32 + (swz % 64) / 2; }
__host__ __device__ __forceinline__ int perm32(int rho) { const int n = rho >> 4, i = rho & 15; return 8 * (i >> 2) + 4 * n + (i & 3); }

struct Unit { int pm, pn; };
struct Gemm { const bf16_t* A; const bf16_t* Bt; int M, N, K; };

struct StaticOrder {
    int nM, nN, nwg, G, c;
    __host__ __device__ void init(int M, int N, int G_, int c_) { nM = M / BM; nN = N / BM; nwg = nM * nN; G = G_; c = c_; }
    __host__ __device__ bool next(int i, Unit& u) const {
        const long L = (long)i * G + c; if (L >= nwg) return false;
        int wgid = (int)L; { const int q = nwg / NXCD, r = nwg % NXCD, xcd = wgid % NXCD, off = wgid / NXCD; wgid = (xcd < r ? xcd * (q + 1) : r * (q + 1) + (xcd - r) * q) + off; }
        const int nig = WGM * nN, gid = wgid / nig, fm = gid * WGM, gsz = (nM - fm) < WGM ? (nM - fm) : WGM;
        u.pm = fm + ((wgid % nig) % gsz); u.pn = (wgid % nig) / gsz; return true;
    }
    __device__ __forceinline__ void a_ready(const Unit&) const {}
    __device__ __forceinline__ void done(const Unit&) const {}
};


__device__ __forceinline__ unsigned cvt_pk_bf16(float lo, float hi) { unsigned r; asm volatile("v_cvt_pk_bf16_f32 %0, %1, %2" : "=v"(r) : "v"(lo), "v"(hi)); return r; }

constexpr float EPS_F = 1e-6f;
constexpr float QSCALE = 0.125f * 1.4426950408889634f;

struct EpiInProj {
    static constexpr bool PERM = true; static constexpr int MID_T = 0;
    const float* rstd1; const float* gq; const float* gk; const float* gsgu; bf16_t* out0; size_t type_stride;
    __device__ __forceinline__ void operator()(const f32x4 (&acc)[2][2][4][2], const Unit& u, int, int wr, int wc, int fr, int fq) const {
        const int type = u.pn >> 1, half = u.pn & 1;
        bf16_t* base = out0 + (size_t)type * type_stride;
        const int colb = 256 * half + 64 * wc + 8 * fq;
        const bool normed = (type == 0) || (type == 1) || (type == 4);
        float g[2][8];
#pragma unroll
        for (int bj = 0; bj < 2; ++bj)
#pragma unroll
            for (int e = 0; e < 8; ++e) {
                float gv = 1.f;
                if (type == 0) gv = gq[32 * bj + 8 * fq + e] * QSCALE;
                else if (type == 1) gv = gk[32 * bj + 8 * fq + e];
                else if (type == 4) gv = gsgu[colb + 32 * bj + e];
                g[bj][e] = gv;
            }
        float rsv[2][4];
#pragma unroll
        for (int ai = 0; ai < 2; ++ai)
#pragma unroll
            for (int m = 0; m < 4; ++m) rsv[ai][m] = rstd1[u.pm * BM + ai * HALF + wr * 64 + m * 16 + fr];
#pragma unroll
        for (int ai = 0; ai < 2; ++ai)
#pragma unroll
            for (int m = 0; m < 4; ++m) {
                const int row = u.pm * BM + ai * HALF + wr * 64 + m * 16 + fr;
                const float rs = rsv[ai][m];
                f32x4 v[2][2];
                float ss = 0.f;
#pragma unroll
                for (int bj = 0; bj < 2; ++bj)
#pragma unroll
                    for (int n = 0; n < 2; ++n) { v[bj][n] = acc[ai][bj][m][n] * rs; const f32x4 x = v[bj][n]; ss += (x[0] * x[0] + x[1] * x[1]) + (x[2] * x[2] + x[3] * x[3]); }
                float r = 1.f;
                if (normed) { ss += __shfl_xor(ss, 16); ss += __shfl_xor(ss, 32); r = 1.0f / sqrtf(ss * (1.0f / 64.0f) + EPS_F); }
                bf16_t* rowp = base + (size_t)row * 512 + colb;
#pragma unroll
                for (int bj = 0; bj < 2; ++bj) {
                    const f32x4 a = v[bj][0], b = v[bj][1];
                    u32x4 w;
                    w.x = cvt_pk_bf16(a[0] * r * g[bj][0], a[1] * r * g[bj][1]); w.y = cvt_pk_bf16(a[2] * r * g[bj][2], a[3] * r * g[bj][3]);
                    w.z = cvt_pk_bf16(b[0] * r * g[bj][4], b[1] * r * g[bj][5]); w.w = cvt_pk_bf16(b[2] * r * g[bj][6], b[3] * r * g[bj][7]);
                    *(u32x4*)(rowp + 32 * bj) = w;
                }
            }
    }
};

struct EpiOutProj {
    static constexpr bool PERM = true; static constexpr int MID_T = 8;
    const float* x; float* x1; bf16_t* x1b; float* ssq2p; float* maxp; const PG8_LAS float* tab;
    __device__ __forceinline__ void mid(f32x4 (&acc)[2][2][4][2], const Unit&, int ui, int wr, int, int fr, int) const {
#pragma unroll
        for (int ai = 0; ai < 2; ++ai)
#pragma unroll
            for (int m = 0; m < 4; ++m) {
                const float rt = tab[(ui * 256 + ai * HALF + wr * 64 + m * 16 + fr) * 2];
#pragma unroll
                for (int bj = 0; bj < 2; ++bj)
#pragma unroll
                    for (int n = 0; n < 2; ++n) acc[ai][bj][m][n] *= rt;
            }
    }
    __device__ __forceinline__ void operator()(const f32x4 (&acc)[2][2][4][2], const Unit& u, int ui, int wr, int wc, int fr, int fq) const {
        const size_t cbase = (size_t)u.pn * BM + wc * 32 + 8 * fq;
        u32x4 xn[2];
#define OP_LOADX(it_) do { const int r_ = u.pm * BM + ((it_) >> 2) * HALF + wr * 64 + ((it_) & 3) * 16 + fr; \
            _Pragma("unroll") for (int bj = 0; bj < 2; ++bj) xn[bj] = *(const u32x4*)(x1b + (size_t)r_ * 1024 + cbase + bj * HALF); } while (0)
        OP_LOADX(0);
#pragma unroll
        for (int it = 0; it < 8; ++it) {
            const int ai = it >> 2, m = it & 3;
            const int lr = ai * HALF + wr * 64 + m * 16 + fr, row = u.pm * BM + lr;
            const float rs = tab[(ui * 256 + lr) * 2 + 1];
            u32x4 xc[2];
#pragma unroll
            for (int bj = 0; bj < 2; ++bj) xc[bj] = xn[bj];
            if (it + 1 < 8) OP_LOADX(it + 1);
            float ss = 0.f, mx = 0.f;
#pragma unroll
            for (int bj = 0; bj < 2; ++bj) {
                const size_t off = (size_t)row * 1024 + cbase + bj * HALF;
                f32x4 xa, xb_; xa[0] = __builtin_bit_cast(float, xc[bj].x << 16); xa[1] = __builtin_bit_cast(float, xc[bj].x & 0xffff0000u); xa[2] = __builtin_bit_cast(float, xc[bj].y << 16); xa[3] = __builtin_bit_cast(float, xc[bj].y & 0xffff0000u);
                xb_[0] = __builtin_bit_cast(float, xc[bj].z << 16); xb_[1] = __builtin_bit_cast(float, xc[bj].z & 0xffff0000u); xb_[2] = __builtin_bit_cast(float, xc[bj].w << 16); xb_[3] = __builtin_bit_cast(float, xc[bj].w & 0xffff0000u);
                const f32x4 a = xa + acc[ai][bj][m][0] * rs, b = xb_ + acc[ai][bj][m][1] * rs;
                ss += (a[0] * a[0] + a[1] * a[1]) + (a[2] * a[2] + a[3] * a[3]) + (b[0] * b[0] + b[1] * b[1]) + (b[2] * b[2] + b[3] * b[3]);
                mx = fmaxf(mx, fmaxf(fmaxf(fmaxf(fabsf(a[0]), fabsf(a[1])), fmaxf(fabsf(a[2]), fabsf(a[3]))), fmaxf(fmaxf(fabsf(b[0]), fabsf(b[1])), fmaxf(fabsf(b[2]), fabsf(b[3])))));
                u32x4 w; w.x = cvt_pk_bf16(a[0], a[1]); w.y = cvt_pk_bf16(a[2], a[3]); w.z = cvt_pk_bf16(b[0], b[1]); w.w = cvt_pk_bf16(b[2], b[3]);
                *(u32x4*)(x1b + off) = w;
            }
            ss += __shfl_xor(ss, 16); ss += __shfl_xor(ss, 32); mx = fmaxf(mx, __shfl_xor(mx, 16)); mx = fmaxf(mx, __shfl_xor(mx, 32));
            if (fq == 0) { ssq2p[(size_t)row * 16 + u.pn * 4 + wc] = ss; maxp[(size_t)row * 16 + u.pn * 4 + wc] = mx; }
        }
#undef OP_LOADX
    }
};

struct EpiQuery {
    static constexpr bool PERM = true; static constexpr int MID_T = 0;
    bf16_t* qp; const PG8_LAS float* tab;
    __device__ __forceinline__ void operator()(const f32x4 (&acc)[2][2][4][2], const Unit& u, int ui, int wr, int wc, int fr, int fq) const {
#pragma unroll
        for (int ai = 0; ai < 2; ++ai)
#pragma unroll
            for (int m = 0; m < 4; ++m) {
                const int lr = ai * HALF + wr * 64 + m * 16 + fr, row = u.pm * BM + lr;
                const float rs = tab[ui * 256 + lr];
#pragma unroll
                for (int bj = 0; bj < 2; ++bj) {
                    const size_t off = ((((size_t)(row >> 5) * 8 + u.pn) * 2 + bj) * 8 + 2 * wc + (fq >> 1)) * 512 + (size_t)(32 * (fq & 1) + (row & 31)) * 8;
                    const f32x4 a = acc[ai][bj][m][0] * rs, b = acc[ai][bj][m][1] * rs;
                    u32x4 w; w.x = cvt_pk_bf16(a[0], a[1]); w.y = cvt_pk_bf16(a[2], a[3]); w.z = cvt_pk_bf16(b[0], b[1]); w.w = cvt_pk_bf16(b[2], b[3]);
                    *(u32x4*)(qp + off) = w;
                }
            }
    }
};

template <class Epi, class Sched, bool ALIGN_EPI = false, bool SP2 = false>
__device__ __forceinline__ void gemm_phase(PG8_LAS unsigned char* lds, const Gemm g, const Sched& S, const Epi& E) {
    const int tid = threadIdx.x, wid = __builtin_amdgcn_readfirstlane(tid >> 6), lane = tid & 63, wr = wid >> 2, wc = wid & 3, fr = lane & 15, fq = lane >> 4;
    const int K = g.K, nt = K / BK;
    unsigned voffA[2], voffB[2];
#pragma unroll
    for (int i = 0; i < 2; ++i) { int R, C; stage_rc(tid * 16 + i * 8192, R, C); const int Rb = Epi::PERM ? ((R & ~31) + perm32(R & 31)) : R;
        voffA[i] = (unsigned)(R * K + C) * 2u; voffB[i] = (unsigned)(Rb * K + C) * 2u; }
    const size_t kstep = (size_t)(BK * 2);
    const size_t hstep = (size_t)HALF * K * 2;
    const size_t tstep = 2 * hstep;
    const unsigned ldsw = (unsigned)wid * 1024u;
    const int aoff = lds_byte(wr * 64 + fr, fq * 8), boff = lds_byte(wc * 32 + fr, fq * 8);
#define PG8_SA(b, h) (((b) * 2 + (h)) * HTB)
#define PG8_SB(b, h) ((4 + (b) * 2 + (h)) * HTB)
#define PG8_STAGE(bufoff, gbase, voff) do { _Pragma("unroll") for (int _i = 0; _i < 2; ++_i) \
        __builtin_amdgcn_global_load_lds((const unsigned*)((const char*)(gbase) + (voff)[_i]), (PG8_LAS unsigned*)(lds + (bufoff) + ldsw + _i * 8192), 16, 0, 0); } while (0)
#define PG8_LDA(dst, b, h) do { _Pragma("unroll") for (int m = 0; m < 4; ++m) _Pragma("unroll") for (int k = 0; k < 2; ++k) dst[m][k] = *(const PG8_LAS bf16x8*)(lds + PG8_SA(b, h) + aoff + m * 2048 + k * 1024); } while (0)
#define PG8_LDB(dst, b, h) do { _Pragma("unroll") for (int n = 0; n < 2; ++n) _Pragma("unroll") for (int k = 0; k < 2; ++k) dst[n][k] = *(const PG8_LAS bf16x8*)(lds + PG8_SB(b, h) + boff + n * 2048 + k * 1024); } while (0)
#define PG8_MMA(ai, bj, At, Bt) do { __builtin_amdgcn_s_setprio(1); _Pragma("unroll") for (int m = 0; m < 4; ++m) _Pragma("unroll") for (int n = 0; n < 2; ++n) _Pragma("unroll") for (int k = 0; k < 2; ++k) \
        acc[ai][bj][m][n] = __builtin_amdgcn_mfma_f32_16x16x32_bf16(Bt[n][k], At[m][k], acc[ai][bj][m][n], 0, 0, 0); __builtin_amdgcn_s_setprio(0); } while (0)
#define PG8_WAIT_V(n) asm volatile("s_waitcnt vmcnt(" #n ")" ::: "memory")
#define PG8_WAIT_L(n) asm volatile("s_waitcnt lgkmcnt(" #n ")" ::: "memory")
#define PG8_BAR __builtin_amdgcn_s_barrier()
#define PG8_SCHED __builtin_amdgcn_sched_barrier(0)
    Unit cur, nxt; int ui = 0;
    if (!S.next(0, cur)) return;
    f32x4 acc[2][2][4][2];
#pragma unroll
    for (int a = 0; a < 2; ++a)
#pragma unroll
        for (int b = 0; b < 2; ++b)
#pragma unroll
            for (int m = 0; m < 4; ++m)
#pragma unroll
                for (int n = 0; n < 2; ++n) acc[a][b][m][n] = (f32x4){0.f, 0.f, 0.f, 0.f};
    bf16x8 At[4][2], B0[2][2], B1[2][2];
    const char* cA = (const char*)g.A + (size_t)cur.pm * tstep; const char* cB = (const char*)g.Bt + (size_t)cur.pn * tstep;
    S.a_ready(cur);
    if constexpr (SP2) {
        PG8_STAGE(PG8_SB(0, 0), cB, voffB); PG8_STAGE(PG8_SB(0, 1), cB + hstep, voffB); PG8_STAGE(PG8_SA(0, 0), cA, voffA); PG8_STAGE(PG8_SA(0, 1), cA + hstep, voffA);
        if (wr == 1) PG8_BAR;
        PG8_WAIT_V(2); PG8_BAR;
        PG8_STAGE(PG8_SB(1, 0), cB + kstep, voffB); PG8_STAGE(PG8_SA(1, 0), cA + kstep, voffA); PG8_STAGE(PG8_SB(1, 1), cB + hstep + kstep, voffB);
        PG8_WAIT_V(6); PG8_BAR;
    } else {
        PG8_STAGE(PG8_SB(0, 0), cB, voffB); PG8_STAGE(PG8_SA(0, 0), cA, voffA); PG8_STAGE(PG8_SB(0, 1), cB + hstep, voffB); PG8_STAGE(PG8_SA(0, 1), cA + hstep, voffA);
        if (wr == 1) PG8_BAR;
        PG8_WAIT_V(4); PG8_BAR;
        PG8_STAGE(PG8_SB(1, 0), cB + kstep, voffB); PG8_STAGE(PG8_SA(1, 0), cA + kstep, voffA); PG8_STAGE(PG8_SB(1, 1), cB + hstep + kstep, voffB);
        PG8_WAIT_V(6); PG8_BAR;
    }
    for (;;) {
        const bool has_next = S.next(ui + 1, nxt);
        const char* nA = has_next ? (const char*)g.A + (size_t)nxt.pm * tstep : cA; const char* nB = has_next ? (const char*)g.Bt + (size_t)nxt.pn * tstep : cB;
        for (int t = 0; t < nt; t += 2) {
            if constexpr (Epi::MID_T > 0) { if (t == Epi::MID_T) E.mid(acc, cur, ui, wr, wc, fr, fq); }
            const bool last = (t == nt - 2);
            const char* a1 = cA + (size_t)(t + 1) * kstep;
            const char* a2 = last ? nA : cA + (size_t)(t + 2) * kstep; const char* b2 = last ? nB : cB + (size_t)(t + 2) * kstep;
            const char* a3 = a2 + kstep; const char* b3 = b2 + kstep;
            if (last && has_next) S.a_ready(nxt);
            if constexpr (SP2) {
            PG8_LDB(B0, 0, 0); PG8_LDB(B1, 0, 1); PG8_SCHED; PG8_LDA(At, 0, 0); PG8_STAGE(PG8_SA(1, 1), a1 + hstep, voffA);
            PG8_WAIT_V(8); PG8_WAIT_L(0); PG8_BAR; PG8_MMA(0, 0, At, B0); PG8_MMA(0, 1, At, B1); PG8_BAR; PG8_SCHED;
            PG8_LDA(At, 0, 1); PG8_STAGE(PG8_SB(0, 0), b2, voffB); PG8_STAGE(PG8_SB(0, 1), b2 + hstep, voffB); PG8_STAGE(PG8_SA(0, 0), a2, voffA);
            PG8_WAIT_V(8); PG8_WAIT_L(0); PG8_BAR; PG8_MMA(1, 0, At, B0); PG8_MMA(1, 1, At, B1); PG8_BAR; PG8_SCHED;
            PG8_LDB(B0, 1, 0); PG8_LDB(B1, 1, 1); PG8_SCHED; PG8_LDA(At, 1, 0); PG8_STAGE(PG8_SA(0, 1), a2 + hstep, voffA);
            PG8_WAIT_V(8); PG8_WAIT_L(0); PG8_BAR; PG8_MMA(0, 0, At, B0); PG8_MMA(0, 1, At, B1); PG8_BAR; PG8_SCHED;
            PG8_LDA(At, 1, 1); PG8_STAGE(PG8_SB(1, 0), b3, voffB); PG8_STAGE(PG8_SB(1, 1), b3 + hstep, voffB); PG8_STAGE(PG8_SA(1, 0), a3, voffA);
            PG8_WAIT_V(8); PG8_WAIT_L(0); PG8_BAR; PG8_MMA(1, 0, At, B0); PG8_MMA(1, 1, At, B1); PG8_BAR; PG8_SCHED;
            } else {
            PG8_LDB(B0, 0, 0); PG8_SCHED; PG8_LDA(At, 0, 0); PG8_STAGE(PG8_SA(1, 1), a1 + hstep, voffA);
            PG8_WAIT_L(8); PG8_BAR; PG8_WAIT_L(0); PG8_MMA(0, 0, At, B0); PG8_BAR; PG8_SCHED;
            PG8_LDB(B1, 0, 1); PG8_STAGE(PG8_SB(0, 0), b2, voffB);
            PG8_BAR; PG8_WAIT_L(0); PG8_MMA(0, 1, At, B1); PG8_BAR;
            PG8_LDA(At, 0, 1); PG8_STAGE(PG8_SA(0, 0), a2, voffA);
            PG8_BAR; PG8_WAIT_L(0); PG8_MMA(1, 0, At, B0); PG8_BAR; PG8_SCHED;
            PG8_STAGE(PG8_SB(0, 1), b2 + hstep, voffB);
            PG8_WAIT_V(6); PG8_BAR; PG8_MMA(1, 1, At, B1); PG8_BAR;
            PG8_LDB(B0, 1, 0); PG8_SCHED; PG8_LDA(At, 1, 0); PG8_STAGE(PG8_SA(0, 1), a2 + hstep, voffA);
            PG8_WAIT_L(8); PG8_BAR; PG8_WAIT_L(0); PG8_MMA(0, 0, At, B0); PG8_BAR; PG8_SCHED;
            PG8_LDB(B1, 1, 1); PG8_STAGE(PG8_SB(1, 0), b3, voffB);
            PG8_BAR; PG8_WAIT_L(0); PG8_MMA(0, 1, At, B1); PG8_BAR;
            PG8_LDA(At, 1, 1); PG8_STAGE(PG8_SA(1, 0), a3, voffA);
            PG8_BAR; PG8_WAIT_L(0); PG8_MMA(1, 0, At, B0); PG8_BAR; PG8_SCHED;
            PG8_STAGE(PG8_SB(1, 1), b3 + hstep, voffB);
            PG8_WAIT_V(6); PG8_BAR; PG8_MMA(1, 1, At, B1); PG8_BAR;
            }
        }
        if constexpr (ALIGN_EPI) { if (wr == 0) PG8_BAR; }
        E(acc, cur, ui, wr, wc, fr, fq); S.done(cur);
        if (!has_next) break;
#pragma unroll
        for (int a = 0; a < 2; ++a)
#pragma unroll
            for (int b = 0; b < 2; ++b)
#pragma unroll
                for (int m = 0; m < 4; ++m)
#pragma unroll
                    for (int n = 0; n < 2; ++n) acc[a][b][m][n] = (f32x4){0.f, 0.f, 0.f, 0.f};
        cur = nxt; cA = nA; cB = nB; ++ui;
        if constexpr (ALIGN_EPI) { if (wr == 1) PG8_BAR; }
    }
    PG8_WAIT_V(0);
    if constexpr (!ALIGN_EPI) { if (wr == 0) PG8_BAR; }
    PG8_BAR;
#undef PG8_SA
#undef PG8_SB
#undef PG8_STAGE
#undef PG8_LDA
#undef PG8_LDB
#undef PG8_MMA
#undef PG8_WAIT_V
#undef PG8_WAIT_L
#undef PG8_BAR
#undef PG8_SCHED
}
}

constexpr int NWAVES = 8;
constexpr int DM = 1024, BATCH = 8, SEQ = 4096, TOK = BATCH * SEQ;
constexpr int AW = 512, INW = 2560, QPW = 2048, NEXP = 16384;
constexpr int NPHASE = 7;
#ifndef MK_N_LAUNCHES
#define MK_N_LAUNCHES 1
#endif
constexpr int N_LAUNCHES = MK_N_LAUNCHES;

constexpr size_t MiB = 1u << 20;
constexpr size_t WS_CTL = 0, CTL_ZERO_BYTES = 64 * 1024;
constexpr size_t WS_WIN = 2 * MiB, WS_WOUT = 8 * MiB, WS_WQ = 10 * MiB, WS_SK = 14 * MiB, WS_SGUW = 14 * MiB + 512 * 1024, WS_RSTD1 = 15 * MiB;
constexpr size_t WS_SCU = 15 * MiB + 256 * 1024, WS_SCV = 15 * MiB + 512 * 1024;
constexpr size_t WS_UB = 16 * MiB, WS_VB = 48 * MiB;
constexpr size_t WS_XB = 80 * MiB;
constexpr size_t WS_Q = 144 * MiB, WS_TYPE_STRIDE = 32 * MiB;
constexpr size_t WS_QP = 144 * MiB;
constexpr size_t WS_MIX = 304 * MiB;
constexpr size_t WS_SSQA = 368 * MiB, WS_SSQS = 369 * MiB, WS_SSQ2P = 370 * MiB, WS_MAXP = 372 * MiB, WS_HINV = 374 * MiB;
constexpr size_t WS_PA = 144 * MiB;
constexpr size_t WS_COEF = 304 * MiB, WS_COEF0 = 320 * MiB, WS_H8 = 324 * MiB, WS_HS = 356 * MiB;
constexpr size_t WS_EIDX = 376 * MiB, WS_GATE = 392 * MiB, WS_END = 408 * MiB;
constexpr int CW_BAR = 1024;

constexpr int RING_OFF = 0, RING_BYTES = 131072;
constexpr int TAB_OFF = RING_BYTES, TAB_BYTES = 8192;
constexpr int LDSCTL_OFF = 153600, MISC_OFF = LDSCTL_OFF + 64;
constexpr int LDS_BYTES = 155648;
static_assert(MISC_OFF + 128 <= LDS_BYTES, "LDS map");

#define GAS __attribute__((address_space(1)))
#define LAS __attribute__((address_space(3)))
typedef unsigned short bf16;
typedef unsigned v4u __attribute__((ext_vector_type(4)));
typedef unsigned v2u __attribute__((ext_vector_type(2)));
typedef float f32x4 __attribute__((ext_vector_type(4)));
typedef float f32x16 __attribute__((ext_vector_type(16)));
typedef short bf16x8 __attribute__((ext_vector_type(8)));
typedef short s16x4 __attribute__((ext_vector_type(4)));
typedef __bf16 bf16x2_t __attribute__((ext_vector_type(2)));
typedef GAS unsigned gu32;
#define RLX_AGENT __ATOMIC_RELAXED, __HIP_MEMORY_SCOPE_AGENT
#define LDS_WAIT() asm volatile("s_waitcnt lgkmcnt(0)" ::: "memory")
#define VM_WAIT() asm volatile("s_waitcnt vmcnt(0)" ::: "memory")
__device__ __forceinline__ unsigned f2bf(float f) { unsigned u = __builtin_bit_cast(unsigned, f); return (u + 0x7fffu + ((u >> 16) & 1u)) >> 16; }
__device__ __forceinline__ unsigned pk2(float lo, float hi) { return pg8::cvt_pk_bf16(lo, hi); }
__device__ __forceinline__ float bf_lo(unsigned w) { return __builtin_bit_cast(float, w << 16); }
__device__ __forceinline__ float bf_hi(unsigned w) { return __builtin_bit_cast(float, w & 0xffff0000u); }
__device__ __forceinline__ int crow(int r, int hi) { return (r & 3) + 8 * (r >> 2) + 4 * hi; }
#define XB_TMO      128
#define XB_XCNT(j)  (256  + 64 * (j))
#define XB_XSUB(j)  (1280 + 64 * (j))
#define XB_XGEN(j)  (2304 + 64 * (j))
#define XB_TOP      3328
#define XB_TOPGEN   3392
#define XCD_BAR_WORDS 3456
#define XB_SPIN_CAP (1u << 18)

__device__ __forceinline__ unsigned xb_ld(unsigned* p)              { return __hip_atomic_load(p, __ATOMIC_RELAXED, __HIP_MEMORY_SCOPE_AGENT); }
__device__ __forceinline__ unsigned xb_add(unsigned* p, unsigned v) { return __hip_atomic_fetch_add(p, v, __ATOMIC_RELAXED, __HIP_MEMORY_SCOPE_AGENT); }
__device__ __forceinline__ unsigned xb_xcc_id() { return (unsigned)__builtin_amdgcn_s_getreg((3 << 11) | 20) & 0xFu; }
#define XB_SPIN(cond, bar) do { unsigned _sp = 0; while (cond) { __builtin_amdgcn_s_sleep(1); \
    if ((++_sp & 255u) == 0u) { if (xb_ld(&(bar)[XB_TMO])) break; if (_sp > XB_SPIN_CAP) { atomicAdd(&(bar)[XB_TMO], 1u); break; } } } } while (0)

struct XcdBarrier {
    unsigned* bar; unsigned x;
    volatile LAS unsigned* st;
};

__device__ __forceinline__ XcdBarrier xcd_barrier_post(unsigned* bar, volatile LAS unsigned* st) {
    XcdBarrier b; b.bar = bar; b.x = xb_xcc_id(); b.st = st;
    if (threadIdx.x == 0) (void)xb_add(&bar[XB_XCNT(b.x)], 1u);
    return b;
}
__device__ __forceinline__ void xcd_barrier_complete(unsigned* bar, unsigned x, unsigned& nloc, unsigned& nx) {
    const unsigned G = gridDim.x * gridDim.y * gridDim.z;
    unsigned sum, cnt, mine, sp = 0u;
    for (;;) {
        sum = 0u; cnt = 0u; mine = 0u;
#pragma unroll
        for (unsigned j = 0; j < 16; ++j) { const unsigned c = xb_ld(&bar[XB_XCNT(j)]); sum += c; cnt += (c > 0u) ? 1u : 0u; mine = (j == x) ? c : mine; }
        if (sum == G) break;
        __builtin_amdgcn_s_sleep(1);
        if ((++sp & 255u) == 0u) { if (xb_ld(&bar[XB_TMO])) break; if (sp > XB_SPIN_CAP) { atomicAdd(&bar[XB_TMO], 1u); break; } }
    }
    nloc = mine > 0u ? mine : 1u; nx = cnt > 0u ? cnt : 1u;
}

__device__ __forceinline__ void xcd_barrier(const XcdBarrier& b) {
    asm volatile("s_waitcnt vmcnt(0)" ::: "memory");
    __syncthreads();
    if (threadIdx.x == 0) {
        unsigned* bar = b.bar;
        __builtin_amdgcn_s_waitcnt(0);
        unsigned nloc = b.st[0], nx = b.st[1];
        if (nloc == 0u) { xcd_barrier_complete(bar, b.x, nloc, nx); b.st[0] = nloc; b.st[1] = nx; }
        const unsigned old = xb_add(&bar[XB_XSUB(b.x)], 1u);
        const unsigned gen = old / nloc;
        if (old + 1u == (gen + 1u) * nloc) {
            __builtin_amdgcn_fence(__ATOMIC_RELEASE, "agent");
            asm volatile("s_waitcnt vmcnt(0)" ::: "memory");
            const unsigned og = xb_add(&bar[XB_TOP], 1u);
            const unsigned tg = og / nx;
            if (og + 1u == (tg + 1u) * nx) xb_add(&bar[XB_TOPGEN], 1u);
            else XB_SPIN(xb_ld(&bar[XB_TOPGEN]) == tg, bar);
            __builtin_amdgcn_fence(__ATOMIC_ACQUIRE, "agent");
            xb_add(&bar[XB_XGEN(b.x)], 1u);
            asm volatile("s_waitcnt vmcnt(0)" ::: "memory");
        } else {
            XB_SPIN(xb_ld(&bar[XB_XGEN(b.x)]) == gen, bar);
            __builtin_amdgcn_fence(__ATOMIC_ACQUIRE, "agent");
            asm volatile("s_waitcnt vmcnt(0)" ::: "memory");
        }
    }
    __syncthreads();
}

struct Frame {
    LAS unsigned char* lds;
    volatile LAS unsigned* MISC;
    gu32* ctl;
    int tid, lane, wave;
    int vcu, G;
    unsigned char* ws;
    const float *x, *norm1_g, *w_in, *q_norm_g, *k_norm_g, *sgu_norm_g, *sgu_w, *sgu_b, *attn_out_g, *sgu_out_g, *w_out, *norm2_g, *w_query, *sub_keys, *expert_u, *expert_v;
    float* out;
    bf16 *Win_t, *Wout_t, *Wq_t, *SK, *SGUW, *XB, *Q, *QP, *MIX;
    float *RSTD1, *SSQA, *SSQS, *SSQ2P, *GATE, *HS, *CS, *MAXP, *HINV;
    signed char *U8, *H8, *V8; int* PA; unsigned* CQ;
    unsigned short* EIDX;
};

__device__ __forceinline__ float wave_sum(float v) {
#pragma unroll
    for (int o = 1; o < 64; o <<= 1) v += __shfl_xor(v, o);
    return v;
}

__device__ __forceinline__ void p0_transpose_item(const float* W, int K, int N, bf16* WT, const float* gain_a, const float* gain_b, int gsplit, LAS float* scr, int item, int lane, bool permute) {
    const int nblk = N / 32, kb = item / nblk, nb = item % nblk, k0 = 64 * kb, n0 = 32 * nb;
#pragma unroll 8
    for (int i = 0; i < 32; ++i) { const int kk = 2 * i + (lane >> 5); const int k = k0 + kk; const float gv = (k < gsplit) ? gain_a[k] : gain_b[k - gsplit];
        scr[kk * 33 + (lane & 31)] = __builtin_nontemporal_load((const GAS float*)(W + (size_t)k * N + n0 + (lane & 31))) * gv; }
    LDS_WAIT(); asm volatile("" ::: "memory");
    int orow0 = n0;
    if (permute) { const int l = n0 & 255; orow0 = (n0 & ~255) + 128 * ((l >> 5) & 1) + 32 * (l >> 6); }
    const int c = lane & 7;
#pragma unroll
    for (int j = 0; j < 4; ++j) { const int n = (lane >> 3) + 8 * j; const LAS float* s = scr + (8 * c) * 33 + n;
        v4u o; o.x = pk2(s[0 * 33], s[1 * 33]); o.y = pk2(s[2 * 33], s[3 * 33]); o.z = pk2(s[4 * 33], s[5 * 33]); o.w = pk2(s[6 * 33], s[7 * 33]);
        *(GAS v4u*)(WT + (size_t)(orow0 + n) * K + k0 + 8 * c) = o; }
    LDS_WAIT(); asm volatile("" ::: "memory");
}

__device__ __forceinline__ float row_to_bf16(const float* src, bf16* dst, const float* gain, int lane) {
    float ss = 0.f;
    f32x4 v[4];
#pragma unroll
    for (int j = 0; j < 4; ++j) v[j] = __builtin_nontemporal_load((const GAS f32x4*)(src + 4 * lane + 256 * j));
#pragma unroll
    for (int j = 0; j < 4; ++j) {
        f32x4 a = v[j];
        ss += (a[0] * a[0] + a[1] * a[1]) + (a[2] * a[2] + a[3] * a[3]);
        if (gain) a = a * *(const GAS f32x4*)(gain + 4 * lane + 256 * j);
        v2u o; o.x = pk2(a[0], a[1]); o.y = pk2(a[2], a[3]);
        *(GAS v2u*)(dst + 4 * lane + 256 * j) = o;
    }
    return ss;
}

__device__ __forceinline__ void p0_prologue(Frame& F) {
    LAS float* scr = (LAS float*)(F.lds + RING_OFF + F.wave * 16384);
    const int gw = F.vcu * NWAVES + F.wave, NGW = F.G * NWAVES;
    constexpr int I_IN = (DM / 64) * (INW / 32), I_OUT = (DM / 64) * (DM / 32), I_Q = (DM / 64) * (QPW / 32);
    for (int it = gw; it < I_IN + I_OUT + I_Q; it += NGW) {
        int r = it;
        if (r < I_IN) { p0_transpose_item(F.w_in, DM, INW, F.Win_t, F.norm1_g, F.norm1_g, DM, scr, r, F.lane, true); continue; } r -= I_IN;
        if (r < I_OUT) { p0_transpose_item(F.w_out, DM, DM, F.Wout_t, F.attn_out_g, F.sgu_out_g, AW, scr, r, F.lane, false); continue; } r -= I_OUT;
        p0_transpose_item(F.w_query, DM, QPW, F.Wq_t, F.norm2_g, F.norm2_g, DM, scr, r, F.lane, false);
    }
    for (int m = 2 * gw; m < TOK; m += 2 * NGW) {
        const float s0 = row_to_bf16(F.x + (size_t)m * DM, F.XB + (size_t)m * DM, nullptr, F.lane);
        const float s1 = row_to_bf16(F.x + (size_t)(m + 1) * DM, F.XB + (size_t)(m + 1) * DM, nullptr, F.lane);
        const float ss0 = wave_sum(s0), ss1 = wave_sum(s1);
        if (F.lane == 0) { F.RSTD1[m] = 1.0f / sqrtf(ss0 * (1.0f / DM) + pg8::EPS_F); F.RSTD1[m + 1] = 1.0f / sqrtf(ss1 * (1.0f / DM) + pg8::EPS_F); }
    }
    for (int e0 = 2 * gw; e0 < 2 * NEXP; e0 += 2 * NGW) {
        const bool isu = e0 < NEXP; const int r0 = isu ? e0 : e0 - NEXP;
        f32x4 v[2][4]; float mx[2] = {0.f, 0.f};
#pragma unroll
        for (int b = 0; b < 2; ++b) {
            const float* src = (isu ? F.expert_u : F.expert_v) + (size_t)(r0 + b) * DM + 4 * F.lane;
#pragma unroll
            for (int q = 0; q < 4; ++q) v[b][q] = __builtin_nontemporal_load((const GAS f32x4*)(src + 256 * q));
        }
#pragma unroll
        for (int b = 0; b < 2; ++b) {
#pragma unroll
            for (int q = 0; q < 4; ++q) { if (isu) v[b][q] = v[b][q] * *(const GAS f32x4*)(F.norm2_g + 4 * F.lane + 256 * q);
                mx[b] = fmaxf(mx[b], fmaxf(fmaxf(fabsf(v[b][q][0]), fabsf(v[b][q][1])), fmaxf(fabsf(v[b][q][2]), fabsf(v[b][q][3])))); }
#pragma unroll
            for (int o = 1; o < 64; o <<= 1) mx[b] = fmaxf(mx[b], __shfl_xor(mx[b], o));
            const float sc = fmaxf(mx[b], 1e-30f) * (1.0f / 127.0f), inv = 1.0f / sc; const int r = r0 + b;
            signed char* tab = isu ? F.U8 : F.V8;
#pragma unroll
            for (int q = 0; q < 4; ++q) { const int b0 = (int)rintf(v[b][q][0] * inv), b1 = (int)rintf(v[b][q][1] * inv), b2 = (int)rintf(v[b][q][2] * inv), b3 = (int)rintf(v[b][q][3] * inv);
                const unsigned o = (unsigned)(b0 & 0xff) | ((unsigned)(b1 & 0xff) << 8) | ((unsigned)(b2 & 0xff) << 16) | ((unsigned)(b3 & 0xff) << 24);
                *(GAS unsigned*)(tab + ((size_t)(2 * q + (F.lane >> 5)) * NEXP + r) * 128 + 4 * (F.lane & 31)) = o; }
            if (F.lane == 0) { float* scp = (float*)(F.ws + (isu ? WS_SCU : WS_SCV)); scp[r] = sc; }
        }
    }
    const int gt = F.vcu * NWAVES * 64 + F.tid, NGT = F.G * NWAVES * 64;
    for (int i = gt; i < 8 * 128 * 128; i += NGT) { const int g = i >> 14, t = (i >> 7) & 127, s = i & 127;
        const int o = ((((g * 4 + (t >> 5)) * 8 + (s >> 4)) * 64) + 32 * ((s >> 3) & 1) + (t & 31)) * 8 + (s & 7);
        F.SGUW[o] = (bf16)f2bf(s <= t ? F.sgu_w[i] : 0.f); }
    for (int i = gt; i < 2 * 128 * 128; i += NGT) F.SK[i] = (bf16)f2bf(F.sub_keys[i]);
}

constexpr int AT_OPITCH = 136;
constexpr int AT_OACC = 0, AT_LACC = 512 * AT_OPITCH, AT_VS = AT_LACC + 2048, AT_VS_WAVE = 32 * 128;
constexpr int AT_KS = AT_VS + NWAVES * AT_VS_WAVE, AT_KS_WAVE = 32 * 128;
static_assert(AT_KS + NWAVES * AT_KS_WAVE <= LDSCTL_OFF, "attention LDS");
__device__ __forceinline__ int at_rowmap(int p) { return (p & ~15) | ((p ^ (p >> 4)) & 15); }
__device__ __forceinline__ s16x4 vtr(const LAS unsigned char* p) { typedef short v4i16_t __attribute__((ext_vector_type(4))); return __builtin_bit_cast(s16x4, __builtin_amdgcn_ds_read_tr16_b64_v4i16((LAS v4i16_t*)p)); }

struct AtDesc { int b, h, span, dil, res, a; };
__device__ __forceinline__ AtDesc at_desc(int u, int stage, int tsk) {
    AtDesc d; const int bh = u >> 3; d.b = bh >> 3; d.h = bh & 7; d.span = u & 7;
    if (stage == 0) { d.dil = 16; d.res = tsk; d.a = d.span; }
    else if (stage == 1) { d.dil = 4; d.res = tsk & 3; d.a = 4 * d.span + (tsk >> 2); }
    else { d.dil = 1; d.res = 0; d.a = 16 * d.span + tsk; }
    return d;
}
__device__ __forceinline__ void at_dma(LAS unsigned char* ks, LAS unsigned char* vs, const char* kptr, const char* vptr, size_t vrow8) {
#pragma unroll
    for (int it = 0; it < 4; ++it) __builtin_amdgcn_global_load_lds((const unsigned*)(kptr + it * vrow8), (LAS unsigned*)(ks + it * 1024), 16, 0, 0);
#pragma unroll
    for (int it = 0; it < 4; ++it) __builtin_amdgcn_global_load_lds((const unsigned*)(vptr + it * vrow8), (LAS unsigned*)(vs + it * 1024), 16, 0, 0);
}
__device__ __forceinline__ size_t at_koff(int lane, int h) { return (size_t)h * 128 + (size_t)((((lane & 7) ^ (lane >> 3)) & 7) << 4); }
__device__ __forceinline__ size_t at_voff(int lane, int h) { return (size_t)h * 128 + (size_t)(((lane & 7) ^ (((lane >> 4) & 1) << 2)) << 4); }
__device__ __forceinline__ void at_start(Frame& F, const AtDesc& d, bf16x8 (&qn)[4]) {
    const int lane = F.lane, r32 = lane & 31, hi = lane >> 5;
    const int c0 = (d.a >= 4) ? 0 : 4 - d.a;
    const size_t krow = (size_t)d.b * SEQ + d.res + (size_t)d.dil * (32 * (d.a - 4 + c0) + (lane >> 3));
    const char* kp = (const char*)(F.Q + WS_TYPE_STRIDE / 2) + krow * 1024; const char* vp = (const char*)(F.Q + 2 * (WS_TYPE_STRIDE / 2)) + krow * 1024;
    at_dma(F.lds + AT_KS + F.wave * AT_KS_WAVE, F.lds + AT_VS + F.wave * AT_VS_WAVE, kp + at_koff(lane, d.h), vp + at_voff(lane, d.h), (size_t)d.dil * 8 * 1024);
    const size_t qrow = (size_t)d.b * SEQ + d.res + (size_t)d.dil * (32 * d.a + r32);
    const bf16* qp = F.Q + qrow * 512 + d.h * 64 + hi * 8;
#pragma unroll
    for (int d0 = 0; d0 < 4; ++d0) qn[d0] = *(const GAS bf16x8*)(qp + 16 * d0);
}

template <int STAGE>
__device__ __forceinline__ void attn_task(Frame& F, const AtDesc& d, float sl, float mlog2, bf16x8 (&qn)[4], const AtDesc& nd) {
    const int lane = F.lane, r32 = lane & 31, hi = lane >> 5;
    const int b = d.b, h = d.h, span = d.span, dil = d.dil, res = d.res, a = d.a;
    const size_t tokbase = (size_t)b * SEQ;
    LAS unsigned char* vs = F.lds + AT_VS + F.wave * AT_VS_WAVE;
    LAS unsigned char* ks = F.lds + AT_KS + F.wave * AT_KS_WAVE;
    const int posq = res + dil * (32 * a + r32);
    bf16x8 qf[4];
#pragma unroll
    for (int d0 = 0; d0 < 4; ++d0) qf[d0] = qn[d0];
    f32x16 o[2]; o[0] = f32x16{}; o[1] = f32x16{};
    float lsum = 0.f;
    const float base_i = -sl * (float)(128 + r32) - mlog2 + sl * (float)(4 * hi);
    const int G = lane >> 4, gi = lane & 15, gq4 = gi >> 2, gp = gi & 3;
    const int c0 = (a >= 4) ? 0 : 4 - a;
    const size_t cstride = (size_t)dil * 32 * 1024, vrow8 = (size_t)dil * 8 * 1024;
    const size_t krow1 = tokbase + res + (size_t)dil * (32 * (a - 3 + c0) + (lane >> 3));
    const char* kptr = (const char*)(F.Q + WS_TYPE_STRIDE / 2) + krow1 * 1024 + at_koff(lane, h);
    const char* vptr = (const char*)(F.Q + 2 * (WS_TYPE_STRIDE / 2)) + krow1 * 1024 + at_voff(lane, h);
    bf16x8 kf[4], va[2][2];
#define AT_TOP() do { \
        asm volatile("s_waitcnt vmcnt(0)" ::: "memory"); \
        _Pragma("unroll") for (int d0 = 0; d0 < 4; ++d0) kf[d0] = *(const LAS bf16x8*)(ks + r32 * 128 + (((2 * d0 + hi) ^ (r32 & 7)) << 4)); \
          \
        _Pragma("unroll") for (int d0 = 0; d0 < 2; ++d0) \
            _Pragma("unroll") for (int ks_ = 0; ks_ < 2; ++ks_) { \
                const LAS unsigned char* pa = vs + (16 * ks_ + 4 * (G >> 1) + gq4) * 128 + ((64 * d0 + 32 * (G & 1) + 8 * gp) ^ (((gq4 >> 1) & 1) << 6)); \
                const s16x4 lo = vtr(pa), hi4 = vtr(pa + 8 * 128); \
                va[d0][ks_] = (bf16x8){lo[0], lo[1], lo[2], lo[3], hi4[0], hi4[1], hi4[2], hi4[3]}; } \
        LDS_WAIT(); } while (0)
#define AT_MATH(c) do { \
        f32x16 s; \
        const float bc = base_i + sl * (float)(32 * (c)); \
        _Pragma("unroll") for (int r = 0; r < 16; ++r) s[r] = bc + sl * (float)((r & 3) + 8 * (r >> 2)); \
        _Pragma("unroll") for (int d0 = 0; d0 < 4; ++d0) s = __builtin_amdgcn_mfma_f32_32x32x16_bf16(kf[d0], qf[d0], s, 0, 0, 0); \
          \
        const int dbase = 128 - 32 * (c) + r32 - 4 * hi; \
        if (((c) == 0) || ((c) == 4)) { \
            _Pragma("unroll") for (int r = 0; r < 16; ++r) { float p = __builtin_amdgcn_exp2f(s[r]); p = ((unsigned)(dbase - ((r & 3) + 8 * (r >> 2))) <= 128u) ? p : 0.f; s[r] = p; lsum += p; } \
        } else { \
            _Pragma("unroll") for (int r = 0; r < 16; ++r) { const float p = __builtin_amdgcn_exp2f(s[r]); s[r] = p; lsum += p; } \
        } \
        bf16x8 pb[2]; \
        _Pragma("unroll") for (int ks_ = 0; ks_ < 2; ++ks_) { v4u w; w.x = pk2(s[8 * ks_ + 0], s[8 * ks_ + 1]); w.y = pk2(s[8 * ks_ + 2], s[8 * ks_ + 3]); w.z = pk2(s[8 * ks_ + 4], s[8 * ks_ + 5]); w.w = pk2(s[8 * ks_ + 6], s[8 * ks_ + 7]); pb[ks_] = __builtin_bit_cast(bf16x8, w); } \
          \
        _Pragma("unroll") for (int d0 = 0; d0 < 2; ++d0) \
            _Pragma("unroll") for (int ks_ = 0; ks_ < 2; ++ks_) o[d0] = __builtin_amdgcn_mfma_f32_32x32x16_bf16(va[d0][ks_], pb[ks_], o[d0], 0, 0, 0); \
    } while (0)
#pragma unroll 1
    for (int c = c0; c < 4; ++c) {
        AT_TOP();
        at_dma(ks, vs, kptr, vptr, vrow8); kptr += cstride; vptr += cstride;
        AT_MATH(c);
    }
    AT_TOP();
    at_start(F, nd, qn);
    AT_MATH(4);
#undef AT_MATH
#undef AT_TOP
    lsum += __shfl_xor(lsum, 32);
    const int pl = posq - span * 512;
    LAS unsigned char* orow = F.lds + AT_OACC + at_rowmap(pl) * AT_OPITCH;
    LAS float* lacc = (LAS float*)(F.lds + AT_LACC);
    if (STAGE > 0) {
        lsum += lacc[pl];
#pragma unroll
        for (int d0 = 0; d0 < 2; ++d0)
#pragma unroll
            for (int g4 = 0; g4 < 4; ++g4) { const v2u w = *(LAS v2u*)(orow + (32 * d0 + 8 * g4 + 4 * hi) * 2);
                o[d0][4 * g4 + 0] += bf_lo(w.x); o[d0][4 * g4 + 1] += bf_hi(w.x); o[d0][4 * g4 + 2] += bf_lo(w.y); o[d0][4 * g4 + 3] += bf_hi(w.y); }
    }
    if (STAGE < 2) {
        if (hi == 0) lacc[pl] = lsum;
#pragma unroll
        for (int d0 = 0; d0 < 2; ++d0)
#pragma unroll
            for (int g4 = 0; g4 < 4; ++g4) { v2u w; w.x = pk2(o[d0][4 * g4 + 0], o[d0][4 * g4 + 1]); w.y = pk2(o[d0][4 * g4 + 2], o[d0][4 * g4 + 3]);
                *(LAS v2u*)(orow + (32 * d0 + 8 * g4 + 4 * hi) * 2) = w; }
    } else {
        const float inv = 1.0f / lsum;
        float ss = 0.f;
#pragma unroll
        for (int d0 = 0; d0 < 2; ++d0)
#pragma unroll
            for (int g4 = 0; g4 < 4; ++g4) { const float a0 = o[d0][4 * g4 + 0] * inv, a1 = o[d0][4 * g4 + 1] * inv, a2 = o[d0][4 * g4 + 2] * inv, a3 = o[d0][4 * g4 + 3] * inv;
                ss += (a0 * a0 + a1 * a1) + (a2 * a2 + a3 * a3);
                v2u w; w.x = pk2(a0, a1); w.y = pk2(a2, a3);
                *(LAS v2u*)(orow + (32 * d0 + 8 * g4 + 4 * hi) * 2) = w; }
        ss += __shfl_xor(ss, 32);
        if (hi == 0) F.SSQA[(tokbase + posq) * 8 + h] = ss;
        LDS_WAIT(); asm volatile("" ::: "memory");
#pragma unroll
        for (int it = 0; it < 4; ++it) { const int row = (lane >> 3) + 8 * it;
            const LAS unsigned char* src = F.lds + AT_OACC + at_rowmap(res + dil * (32 * a + row) - span * 512) * AT_OPITCH + (lane & 7) * 16;
            const v2u lo = *(const LAS v2u*)src, hi2 = *(const LAS v2u*)(src + 8);
            v4u ov; ov.x = lo.x; ov.y = lo.y; ov.z = hi2.x; ov.w = hi2.y;
            *(GAS v4u*)(F.MIX + (tokbase + res + (size_t)dil * (32 * a + row)) * 1024 + h * 64 + (lane & 7) * 8) = ov; }
        LDS_WAIT(); asm volatile("" ::: "memory");
    }
}

__device__ __forceinline__ void attn_unit(Frame& F, int u, int un, float mlog2, bf16x8 (&qn)[4]) {
    const int h = (u >> 3) & 7;
    const float slope = __builtin_amdgcn_exp2f(-(float)(h + 1)) * 1.4426950408889634f;
    const int w = F.wave;
#pragma unroll 1
    for (int k = 0; k < 2; ++k) attn_task<0>(F, at_desc(u, 0, 2 * w + k), slope * 16.f, mlog2, qn, at_desc(u, k, k ? 2 * w : 2 * w + 1));
    LDS_WAIT(); __syncthreads();
#pragma unroll 1
    for (int k = 0; k < 2; ++k) attn_task<1>(F, at_desc(u, 1, 2 * w + k), slope * 4.f, mlog2, qn, at_desc(u, 1 + k, k ? 2 * w : 2 * w + 1));
    LDS_WAIT(); __syncthreads();
#pragma unroll 1
    for (int k = 0; k < 2; ++k) attn_task<2>(F, at_desc(u, 2, 2 * w + k), slope, mlog2, qn, k ? at_desc(un, 0, 2 * w) : at_desc(u, 2, 2 * w + 1));
    LDS_WAIT(); __syncthreads();
}

constexpr int SG_PITCH = 192, SG_TILE = 128 * SG_PITCH;
static_assert(4 * SG_TILE <= RING_BYTES, "SGU LDS");
struct SguPre { v4u tile[4]; bf16x8 wb[8]; v4u sul[4]; float bias; };
constexpr int SG_SU_OFF = 4 * SG_TILE, SG_SU_WAVE = 32 * 144;
static_assert(SG_SU_OFF + NWAVES * SG_SU_WAVE <= LDSCTL_OFF, "SGU LDS");
__device__ __forceinline__ void sgu_load(Frame& F, int u, SguPre& p) {
    const int gp = u & 3, ch = (u >> 2) & 31, b = u >> 7;
    const int lane = F.lane, r32 = lane & 31, hi = lane >> 5, w = F.wave, gsel = w >> 2, tb = w & 3, g = 2 * gp + gsel, t = 32 * tb + r32;
    const size_t tok0 = (size_t)b * SEQ + (size_t)ch * 128;
    const bf16* SVN = F.Q + 4 * (WS_TYPE_STRIDE / 2); const bf16* SU = F.Q + 3 * (WS_TYPE_STRIDE / 2);
#pragma unroll
    for (int gg = 0; gg < 2; ++gg)
#pragma unroll
        for (int it = 0; it < 2; ++it) { const int idx = F.tid + 512 * it, s_ = idx >> 3, c8 = idx & 7;
            p.tile[2 * gg + it] = __builtin_nontemporal_load((const GAS v4u*)(SVN + (tok0 + s_) * 512 + (2 * gp + gg) * 64 + c8 * 8)); }
    const bf16* Wg = F.SGUW + ((size_t)(g * 4 + tb) * 8 * 64 + lane) * 8;
#pragma unroll
    for (int ks = 0; ks < 8; ++ks) p.wb[ks] = *(const GAS bf16x8*)(Wg + ks * 512);
    p.bias = F.sgu_b[g * 128 + t];
#pragma unroll
    for (int i = 0; i < 4; ++i) p.sul[i] = __builtin_nontemporal_load((const GAS v4u*)(SU + (tok0 + 32 * tb + (lane >> 3) + 8 * i) * 512 + g * 64 + (lane & 7) * 8));
}
__device__ __forceinline__ void sgu_phase(Frame& F) {
    const int lane = F.lane, r32 = lane & 31, hi = lane >> 5, w = F.wave, gsel = w >> 2, tb = w & 3, t = 32 * tb + r32;
    const int G = lane >> 4, gi = lane & 15, gq4 = gi >> 2, gpp = gi & 3;
    constexpr int NU = BATCH * 32 * 4;
    int u = F.vcu; if (u >= NU) return;
    SguPre pre; sgu_load(F, u, pre);
    for (int it_ = 0; u < NU; u += F.G, ++it_) {
        LAS unsigned char* buf = F.lds + (it_ & 1) * (2 * SG_TILE);
#pragma unroll
        for (int gg = 0; gg < 2; ++gg)
#pragma unroll
            for (int it = 0; it < 2; ++it) { const int idx = F.tid + 512 * it, s_ = idx >> 3, c8 = idx & 7; *(LAS v4u*)(buf + gg * SG_TILE + s_ * SG_PITCH + c8 * 16) = pre.tile[2 * gg + it]; }
        bf16x8 wb[8]; const float bias = pre.bias;
#pragma unroll
        for (int i = 0; i < 8; ++i) wb[i] = pre.wb[i];
        LAS unsigned char* sus = F.lds + SG_SU_OFF + w * SG_SU_WAVE;
#pragma unroll
        for (int i = 0; i < 4; ++i) *(LAS v4u*)(sus + ((lane >> 3) + 8 * i) * 144 + (lane & 7) * 16) = pre.sul[i];
        LDS_WAIT(); __syncthreads();
        const int un = (u + F.G < NU) ? u + F.G : u;
        sgu_load(F, un, pre);
        const int gp = u & 3, ch = (u >> 2) & 31, b = u >> 7, g = 2 * gp + gsel;
        const size_t tok0 = (size_t)b * SEQ + (size_t)ch * 128;
        const LAS unsigned char* ts = buf + gsel * SG_TILE;
        f32x16 acc[2]; acc[0] = f32x16{}; acc[1] = f32x16{};
#pragma unroll
        for (int ks = 0; ks < 8; ++ks) {
#pragma unroll
            for (int eb = 0; eb < 2; ++eb) {
                const LAS unsigned char* pa = ts + (16 * ks + 8 * (G >> 1) + gq4) * SG_PITCH + (32 * eb + 16 * (G & 1) + 4 * gpp) * 2;
                const s16x4 lo = vtr(pa), hi4 = vtr(pa + 4 * SG_PITCH);
                const bf16x8 va = (bf16x8){lo[0], lo[1], lo[2], lo[3], hi4[0], hi4[1], hi4[2], hi4[3]};
                acc[eb] = __builtin_amdgcn_mfma_f32_32x32x16_bf16(va, wb[ks], acc[eb], 0, 0, 0);
            }
        }
        float ss = 0.f;
#pragma unroll
        for (int eb = 0; eb < 2; ++eb)
#pragma unroll
            for (int g4 = 0; g4 < 4; ++g4) { const int e = 32 * eb + 8 * g4 + 4 * hi;
                const v2u sw = *(const LAS v2u*)(sus + r32 * 144 + e * 2);
                const float a0 = bf_lo(sw.x) * (acc[eb][4 * g4 + 0] + bias), a1 = bf_hi(sw.x) * (acc[eb][4 * g4 + 1] + bias), a2 = bf_lo(sw.y) * (acc[eb][4 * g4 + 2] + bias), a3 = bf_hi(sw.y) * (acc[eb][4 * g4 + 3] + bias);
                ss += (a0 * a0 + a1 * a1) + (a2 * a2 + a3 * a3);
                v2u wv; wv.x = pk2(a0, a1); wv.y = pk2(a2, a3); *(LAS v2u*)(sus + r32 * 144 + e * 2) = wv; }
        ss += __shfl_xor(ss, 32);
        if (hi == 0) F.SSQS[(tok0 + t) * 8 + g] = ss;
        LDS_WAIT(); asm volatile("" ::: "memory");
#pragma unroll
        for (int i = 0; i < 4; ++i) { const int row = (lane >> 3) + 8 * i; const v4u ov = *(const LAS v4u*)(sus + row * 144 + (lane & 7) * 16);
            *(GAS v4u*)(F.MIX + (tok0 + 32 * tb + row) * 1024 + 512 + g * 64 + (lane & 7) * 8) = ov; }
        LDS_WAIT(); asm volatile("" ::: "memory");
    }
    LDS_WAIT(); __syncthreads();
}

#ifndef P2_VARIANT
#define P2_VARIANT 0
#endif
__device__ __forceinline__ void p2_mixers(Frame& F) {
    float mq = fabsf(F.q_norm_g[F.lane]), mk = fabsf(F.k_norm_g[F.lane]);
#pragma unroll
    for (int o = 1; o < 64; o <<= 1) { mq = fmaxf(mq, __shfl_xor(mq, o)); mk = fmaxf(mk, __shfl_xor(mk, o)); }
    const float mlog2 = 8.0f * mq * mk * 1.4426950408889634f;
    {
        constexpr int NU = BATCH * 8 * 8;
        bf16x8 qn[4];
        if (F.vcu < NU) at_start(F, at_desc(F.vcu, 0, 2 * F.wave), qn);
#pragma unroll 1
        for (int u = F.vcu; u < NU; u += F.G) attn_unit(F, u, (u + F.G < NU) ? u + F.G : u, mlog2, qn);
        asm volatile("s_waitcnt vmcnt(0)" ::: "memory"); __syncthreads();
    }
#pragma unroll 1
    for (int rep = 0; rep < (P2_VARIANT == 2 ? 2 : 1); ++rep)
    sgu_phase(F);
}

__device__ __forceinline__ unsigned f2ord(float f) { const unsigned u = __builtin_bit_cast(unsigned, f); return u ^ ((unsigned)((int)u >> 31) | 0x80000000u); }
__device__ __forceinline__ float ord2f(unsigned k) { const unsigned u = (k & 0x80000000u) ? (k ^ 0x80000000u) : ~k; return __builtin_bit_cast(float, u); }
#define CE_DESC(a, b) do { const unsigned _mx = max((a), (b)), _mn = min((a), (b)); (a) = _mx; (b) = _mn; } while (0)
__device__ __forceinline__ void sort16(unsigned (&k)[16]) {
#pragma unroll
    for (int k2 = 2; k2 <= 16; k2 <<= 1)
#pragma unroll
        for (int j = k2 >> 1; j > 0; j >>= 1)
#pragma unroll
            for (int i = 0; i < 16; ++i) { const int l = i ^ j; if (l > i) { if ((i & k2) == 0) CE_DESC(k[i], k[l]); else CE_DESC(k[l], k[i]); } }
}
__device__ __forceinline__ void merge16(unsigned (&a)[16], const unsigned (&b)[16]) {
#pragma unroll
    for (int i = 0; i < 16; ++i) a[i] = max(a[i], b[15 - i]);
#pragma unroll
    for (int j = 8; j > 0; j >>= 1)
#pragma unroll
        for (int i = 0; i < 16; ++i) { const int l = i ^ j; if (l > i) CE_DESC(a[i], a[l]); }
}
__device__ __forceinline__ void swap16(const unsigned (&x)[16], const unsigned (&y)[16], unsigned (&xo)[16], unsigned (&yo)[16]) {
#pragma unroll
    for (int i = 0; i < 16; ++i) { auto rr = __builtin_amdgcn_permlane32_swap(x[i], y[i], false, false); xo[i] = rr[0]; yo[i] = rr[1]; }
}

__host__ __device__ constexpr int cand0(int q) { return q < 16 ? q : q < 21 ? 0x20 + (q - 16) : q < 24 ? 0x40 + (q - 21) : q < 26 ? 0x60 + (q - 24) : q == 26 ? 0x80 : q == 27 ? 0xa0 : q == 28 ? 0xc0 : q == 29 ? 0xe0 : 0xff; }
__host__ __device__ constexpr int cand1(int q) { return q < 8 ? 0x10 + q : q < 12 ? 0x30 + (q - 8) : q < 14 ? 0x50 + (q - 12) : q < 16 ? 0x70 + (q - 14) : q == 16 ? 0x90 : q == 17 ? 0xb0 : q == 18 ? 0xd0 : q == 19 ? 0xf0 : 0xff; }

constexpr int TK_SK_BYTES = 2 * 128 * 256;
constexpr int TK_LDS_WAVE = 32 * 32 * 4, TK_SCR_OFF = TK_SK_BYTES;
static_assert(TK_SCR_OFF + NWAVES * TK_LDS_WAVE <= RING_BYTES, "top-k LDS");
__device__ __forceinline__ void tk_load_q(Frame& F, size_t t0, int hd, int half, int r32, int hi, bf16x8 (&qf)[8]) {
#pragma unroll
    for (int i = 0; i < 8; ++i) qf[i] = __builtin_nontemporal_load((const GAS bf16x8*)(F.QP + ((((t0 >> 5) * 8 + hd) * 2 + half) * 8 + i) * 512 + (size_t)(32 * hi + r32) * 8));
}
template <int HALF_> __device__ __forceinline__ void half_top16(Frame& F, const bf16x8 (&qf)[8], int r32, int hi, unsigned (&best)[16]) {
#pragma unroll
    for (int nb = 0; nb < 4; ++nb) {
        f32x16 acc;
#pragma unroll
        for (int r = 0; r < 16; ++r) acc[r] = 64.0f;
        const int row = HALF_ * 128 + 32 * nb + r32;
#pragma unroll
        for (int ks = 0; ks < 8; ++ks) { const bf16x8 a = *(const LAS bf16x8*)(F.lds + row * 256 + (((2 * ks + hi) ^ (row & 15)) << 4));
            acc = __builtin_amdgcn_mfma_f32_32x32x16_bf16(a, qf[ks], acc, 0, 0, 0); }
        unsigned k[16];
#pragma unroll
        for (int r = 0; r < 16; ++r) { const int n = 32 * nb + (r & 3) + 8 * (r >> 2) + 4 * hi; k[r] = (__builtin_bit_cast(unsigned, __builtin_amdgcn_fmed3f(acc[r], 4.0f, 124.0f)) & ~127u) | (unsigned)(127 - n); }
        sort16(k);
        if (nb == 0) {
#pragma unroll
            for (int i = 0; i < 16; ++i) best[i] = k[i];
        } else merge16(best, k);
    }
}

__device__ __forceinline__ void topk_task(Frame& F, int tb, int hd, bf16x8 (&qa)[8], bool has_next, int tb_next, int hd_next) {
    const int lane = F.lane, r32 = lane & 31, hi = lane >> 5;
    const size_t t0 = (size_t)tb * 32;
    unsigned bk[2][16];
    bf16x8 qb[8];
    tk_load_q(F, t0, hd, 1, r32, hi, qb);
    half_top16<0>(F, qa, r32, hi, bk[0]);
    if (has_next) tk_load_q(F, (size_t)tb_next * 32, hd_next, 0, r32, hi, qa);
    half_top16<1>(F, qb, r32, hi, bk[1]);
    unsigned xa[16], ya[16];
    swap16(bk[0], bk[1], xa, ya);
    merge16(xa, ya);
    unsigned A[16], B[16];
    swap16(xa, xa, A, B);
    LAS unsigned* tk = (LAS unsigned*)(F.lds + TK_SCR_OFF + F.wave * TK_LDS_WAVE) + r32 * 32;
#pragma unroll
    for (int i = 0; i < 16; ++i) tk[16 * hi + i] = hi ? B[i] : A[i];
    float v1[16], v2[16];
#pragma unroll
    for (int i = 0; i < 16; ++i) { v1[i] = __builtin_bit_cast(float, A[i] & ~127u); v2[i] = __builtin_bit_cast(float, B[i] & ~127u); }
    unsigned c0[16], c1[16];
#pragma unroll
    for (int q = 0; q < 32; ++q) {
        const int ij0 = cand0(q), ij1 = cand1(q);
        const float s0 = (ij0 == 0xff) ? 0.0f : v1[ij0 >> 4] + v2[ij0 & 15];
        const float s1 = (ij1 == 0xff) ? 0.0f : v1[ij1 >> 4] + v2[ij1 & 15];
        const unsigned k0 = (__builtin_bit_cast(unsigned, s0) & ~255u) | (unsigned)(ij0 & 255), k1 = (__builtin_bit_cast(unsigned, s1) & ~255u) | (unsigned)(ij1 & 255);
        const unsigned kk = hi ? k1 : k0;
        if (q < 16) c0[q] = kk; else c1[q - 16] = kk;
    }
    sort16(c0); sort16(c1); merge16(c0, c1);
    unsigned L0[16], L1[16];
    swap16(c0, c0, L0, L1);
    merge16(L0, L1);
    const float mx = __builtin_bit_cast(float, L0[0] & ~255u);
    float ex[16], den = 0.f;
#pragma unroll
    for (int i = 0; i < 16; ++i) { ex[i] = __expf(__builtin_bit_cast(float, L0[i] & ~255u) - mx); den += ex[i]; }
    const float rden = 1.0f / den;
    LDS_WAIT(); asm volatile("" ::: "memory");
    int ei[8]; float gt[8];
#pragma unroll
    for (int kk = 0; kk < 8; ++kk) {
        const unsigned key = hi ? L0[8 + kk] : L0[kk]; const float e = hi ? ex[8 + kk] : ex[kk];
        const int i = (key >> 4) & 15, j = key & 15;
        const int i1 = 127 - (int)(tk[i] & 127u), i2 = 127 - (int)(tk[16 + j] & 127u);
        ei[kk] = i1 * 128 + i2; gt[kk] = e * rden;
    }
    unsigned short* ep = F.EIDX + (t0 + r32) * 128 + hd * 16 + 8 * hi; float* gp = F.GATE + (t0 + r32) * 128 + hd * 16 + 8 * hi;
    *(GAS v4u*)ep = (v4u){(unsigned)ei[0] | ((unsigned)ei[1] << 16), (unsigned)ei[2] | ((unsigned)ei[3] << 16), (unsigned)ei[4] | ((unsigned)ei[5] << 16), (unsigned)ei[6] | ((unsigned)ei[7] << 16)};
    *(GAS f32x4*)gp = (f32x4){gt[0], gt[1], gt[2], gt[3]}; *(GAS f32x4*)(gp + 4) = (f32x4){gt[4], gt[5], gt[6], gt[7]};
    LDS_WAIT(); asm volatile("" ::: "memory");
}

__device__ __forceinline__ void p5_topk(Frame& F) {
    for (int i = F.tid; i < 2 * 128 * 16; i += NWAVES * 64) { const int row = i >> 4, ch = i & 15;
        *(LAS v4u*)(F.lds + row * 256 + ((ch ^ (row & 15)) << 4)) = *(const GAS v4u*)(F.SK + (size_t)row * 128 + ch * 8); }
    LDS_WAIT(); __syncthreads();
    pg8::StaticOrder S; S.init(TOK, QPW, F.G, (int)blockIdx.x);
    pg8::Unit u, un;
    bf16x8 qf[8];
    bool have = S.next(0, u);
    if (have) tk_load_q(F, (size_t)(u.pm * 8 + F.wave) * 32, u.pn, 0, F.lane & 31, F.lane >> 5, qf);
#pragma unroll 1
    for (int i = 0; have; ++i) {
        const bool hn = S.next(i + 1, un);
        topk_task(F, u.pm * 8 + F.wave, u.pn, qf, hn, un.pm * 8 + F.wave, un.pn);
        u = un; have = hn;
    }
    LDS_WAIT(); __syncthreads();
}

constexpr int PE_TPI = 16, PE_NITEM = TOK / PE_TPI;
constexpr int CW_QA = 8192, CW_QB = 8192 + 8 * 64;

template <int CTRL> __device__ __forceinline__ int dpp_i(int v) { return __builtin_amdgcn_update_dpp(0, v, CTRL, 0xf, 0xf, true); }
template <int CTRL> __device__ __forceinline__ float dpp_f(float v) { return __builtin_bit_cast(float, __builtin_amdgcn_update_dpp(0, __builtin_bit_cast(int, v), CTRL, 0xf, 0xf, true)); }
constexpr int DPP_XOR1 = 0xB1, DPP_XOR2 = 0x4E, DPP_HMIRROR = 0x141, DPP_ROR8 = 0x128;

__device__ __forceinline__ void pe_load_ix(Frame& F, int t, v4u (&ix)[2]) {
    const int gl = F.lane >> 3;
#pragma unroll
    for (int q = 0; q < 2; ++q) ix[q] = *(const GAS v4u*)(F.EIDX + (size_t)t * 128 + gl * 16 + 8 * q);
}
__device__ __forceinline__ void pe_load_rows(const void* TAB, const v4u (&ix)[2], int coloff, v4u (&w)[16]) {
#pragma unroll
    for (int i = 0; i < 16; ++i) { const unsigned pr = ix[i >> 3][(i >> 1) & 3]; const unsigned e = (i & 1) ? (pr >> 16) : (pr & 0xffffu);
        w[i] = *(const GAS v4u*)((const char*)TAB + (size_t)e * 128 + coloff); }
}
__device__ __forceinline__ v4u pe_quant16(const v4u& lo, const v4u& hi, float inv) {
    v4u o;
#pragma unroll
    for (int q = 0; q < 4; ++q) { const unsigned w0 = (q < 2) ? lo[2 * q] : hi[2 * q - 4], w1 = (q < 2) ? lo[2 * q + 1] : hi[2 * q - 3];
        const int b0 = (int)rintf(bf_lo(w0) * inv), b1 = (int)rintf(bf_hi(w0) * inv), b2 = (int)rintf(bf_lo(w1) * inv), b3 = (int)rintf(bf_hi(w1) * inv);
        o[q] = (unsigned)(b0 & 0xff) | ((unsigned)(b1 & 0xff) << 8) | ((unsigned)(b2 & 0xff) << 16) | ((unsigned)(b3 & 0xff) << 24); }
    return o;
}
__device__ __forceinline__ void peA_compute(Frame& F, int* PA, int j, int t, const v4u& hq, const v4u (&w)[16]) {
    const int gl = F.lane >> 3, sub = F.lane & 7;
    int r0 = 0, r1 = 0;
#pragma unroll
    for (int i = 0; i < 16; ++i) {
        int p = __builtin_amdgcn_sdot4((int)w[i].x, (int)hq.x, 0, false);
        p = __builtin_amdgcn_sdot4((int)w[i].y, (int)hq.y, p, false); p = __builtin_amdgcn_sdot4((int)w[i].z, (int)hq.z, p, false); p = __builtin_amdgcn_sdot4((int)w[i].w, (int)hq.w, p, false);
        p += dpp_i<DPP_XOR1>(p); p += dpp_i<DPP_XOR2>(p); p += dpp_i<DPP_HMIRROR>(p);
        if (i < 8) r0 = (sub == i) ? p : r0; else r1 = (sub == i - 8) ? p : r1;
    }
    const unsigned pk = ((unsigned)((r0 + 32) >> 6) & 0xffffu) | ((unsigned)((r1 + 32) >> 6) << 16);
    ((unsigned*)PA)[((size_t)j * TOK + t) * 64 + gl * 8 + sub] = pk;
}
__device__ __forceinline__ void peB_compute(Frame& F, int j, int t, const v4u& cq, float cs, const v4u (&w)[16]) {
    const int lane = F.lane, gl = lane >> 3, sub = lane & 7;
    typedef float f32x2_t __attribute__((ext_vector_type(2)));
    const int mycol = 128 * j + 2 * lane;
    const unsigned xw = *(const GAS unsigned*)(F.XB + (size_t)t * DM + mycol);
    f32x2_t xin; xin.x = bf_lo(xw); xin.y = bf_hi(xw);
    int acc[16];
#pragma unroll
    for (int c = 0; c < 16; ++c) acc[c] = 0;
#pragma unroll
    for (int m = 0; m < 4; ++m)
#pragma unroll
        for (int q = 0; q < 4; ++q) {
            const unsigned a0 = w[4 * m + 0][q], a1 = w[4 * m + 1][q], a2 = w[4 * m + 2][q], a3 = w[4 * m + 3][q];
            const unsigned t0 = __builtin_amdgcn_perm(a1, a0, 0x05010400u), t1 = __builtin_amdgcn_perm(a1, a0, 0x07030602u);
            const unsigned t2 = __builtin_amdgcn_perm(a3, a2, 0x05010400u), t3 = __builtin_amdgcn_perm(a3, a2, 0x07030602u);
            const unsigned o0 = __builtin_amdgcn_perm(t2, t0, 0x05040100u), o1 = __builtin_amdgcn_perm(t2, t0, 0x07060302u);
            const unsigned o2 = __builtin_amdgcn_perm(t3, t1, 0x05040100u), o3 = __builtin_amdgcn_perm(t3, t1, 0x07060302u);
            acc[4 * q + 0] = __builtin_amdgcn_sdot4((int)o0, (int)cq[m], acc[4 * q + 0], false); acc[4 * q + 1] = __builtin_amdgcn_sdot4((int)o1, (int)cq[m], acc[4 * q + 1], false);
            acc[4 * q + 2] = __builtin_amdgcn_sdot4((int)o2, (int)cq[m], acc[4 * q + 2], false); acc[4 * q + 3] = __builtin_amdgcn_sdot4((int)o3, (int)cq[m], acc[4 * q + 3], false);
        }
    int h8v[8];
#pragma unroll
    for (int c = 0; c < 8; ++c) { auto rr = __builtin_amdgcn_permlane32_swap((unsigned)acc[c], (unsigned)acc[c + 8], false, false);
        unsigned r0 = rr[0], r1 = rr[1]; asm volatile("" : "+v"(r0), "+v"(r1));
        h8v[c] = (int)r0 + (int)r1; }
    const bool b4 = (lane >> 4) & 1, b3 = (lane >> 3) & 1;
    int h4[4];
#pragma unroll
    for (int c = 0; c < 4; ++c) { const int keep = b4 ? h8v[c + 4] : h8v[c], give = b4 ? h8v[c] : h8v[c + 4]; h4[c] = keep + __builtin_amdgcn_ds_swizzle(give, 0x401F); }
    int h2[2];
#pragma unroll
    for (int c = 0; c < 2; ++c) { const int keep = b3 ? h4[c + 2] : h4[c], give = b3 ? h4[c] : h4[c + 2]; h2[c] = keep + dpp_i<DPP_ROR8>(give); }
    const int srcl = ((lane >> 3) + 8 * (lane & 1) + 16 * ((lane >> 1) & 1) + 32 * ((lane >> 2) & 1)) * 4;
    const int q0 = __builtin_amdgcn_ds_bpermute(srcl, h2[0]), q1 = __builtin_amdgcn_ds_bpermute(srcl, h2[1]);
    f32x2_t o; o.x = xin.x + cs * (float)q0; o.y = xin.y + cs * (float)q1;
    __builtin_nontemporal_store(o, (GAS f32x2_t*)(F.out + (size_t)t * DM + mycol));
}

template <bool PHASE_B> __device__ __forceinline__ void pe_item(Frame& F, int j, int t0) {
    const int sub = F.lane & 7, gl = F.lane >> 3, coloff = 128 * j + 16 * sub;
    const void* TAB = (const char*)(PHASE_B ? (const void*)F.V8 : (const void*)F.U8) + (size_t)j * NEXP * 128;
    const int rowoff = 16 * sub;
    v4u ixA[2], ixB[2], wA[16], wB[16], auxA, auxB, aux2A = {}, aux2B = {}; float csA = 0.f, csB = 0.f;
#define PE_AUX(t, aux, aux2, cs) do { if (PHASE_B) { aux = *(const GAS v4u*)(F.CQ + (size_t)(t) * 32 + gl * 4); cs = F.CS[t]; } \
        else { aux = *(const GAS v4u*)(F.XB + (size_t)(t) * DM + coloff); aux2 = *(const GAS v4u*)(F.XB + (size_t)(t) * DM + coloff + 8); cs = F.HINV[t]; } } while (0)
#define PE_COMPUTE(t, aux, aux2, cs, w) do { if (PHASE_B) peB_compute(F, j, (t), aux, cs, w); else peA_compute(F, F.PA, j, (t), pe_quant16(aux, aux2, cs), w); } while (0)
    pe_load_ix(F, t0, ixA); pe_load_rows(TAB, ixA, rowoff, wA); PE_AUX(t0, auxA, aux2A, csA); pe_load_ix(F, t0 + 1, ixB);
#pragma unroll 1
    for (int k = 0; k < PE_TPI - 2; k += 2) {
        pe_load_rows(TAB, ixB, rowoff, wB); PE_AUX(t0 + k + 1, auxB, aux2B, csB);
        pe_load_ix(F, t0 + k + 2, ixA);
        PE_COMPUTE(t0 + k, auxA, aux2A, csA, wA);
        pe_load_rows(TAB, ixA, rowoff, wA); PE_AUX(t0 + k + 2, auxA, aux2A, csA); pe_load_ix(F, t0 + k + 3, ixB);
        PE_COMPUTE(t0 + k + 1, auxB, aux2B, csB, wB);
    }
    pe_load_rows(TAB, ixB, rowoff, wB); PE_AUX(t0 + PE_TPI - 1, auxB, aux2B, csB);
    PE_COMPUTE(t0 + PE_TPI - 2, auxA, aux2A, csA, wA);
    PE_COMPUTE(t0 + PE_TPI - 1, auxB, aux2B, csB, wB);
#undef PE_AUX
#undef PE_COMPUTE
}

template <bool PHASE_B> __device__ __forceinline__ void p6_sliced(Frame& F) {
    const unsigned x = xb_xcc_id() & 7u;
    gu32* Q = F.ctl + (PHASE_B ? CW_QB : CW_QA);
    for (unsigned s = 0; s < 8; ++s) {
        const int j = (int)((x + s) & 7u);
        for (;;) {
            unsigned c = 0;
            if (F.lane == 0) c = __hip_atomic_fetch_add((unsigned*)(Q + 64 * j), 1u, __ATOMIC_RELAXED, __HIP_MEMORY_SCOPE_AGENT);
            c = (unsigned)__builtin_amdgcn_readfirstlane((int)c);
            if (c >= (unsigned)PE_NITEM) break;
            pe_item<PHASE_B>(F, j, (int)c * PE_TPI);
        }
    }
}

__device__ __forceinline__ void p6_reduce(Frame& F) {
    const int gw = F.vcu * NWAVES + F.wave, NGW = F.G * NWAVES, lane = F.lane;
    const int p0 = 16 * (lane >> 3) + (lane & 7);
    constexpr int NB = 4;
    for (int tb = gw * NB; tb < TOK; tb += NGW * NB) {
        int s[NB][2], e[NB][2]; float gt[NB][2], hs[NB];
#pragma unroll
        for (int b = 0; b < NB; ++b) {
            const int t = tb + b; hs[b] = F.HS[t];
            int a0 = 0, a1 = 0;
#pragma unroll
            for (int j = 0; j < 8; ++j) { const unsigned w = __builtin_nontemporal_load((const GAS unsigned*)F.PA + ((size_t)j * TOK + t) * 64 + lane); a0 += (int)(short)(w & 0xffffu); a1 += (int)w >> 16; }
            s[b][0] = a0; s[b][1] = a1;
#pragma unroll
            for (int hh = 0; hh < 2; ++hh) { const int p = p0 + 8 * hh; e[b][hh] = (int)F.EIDX[(size_t)t * 128 + p]; gt[b][hh] = F.GATE[(size_t)t * 128 + p]; }
        }
        float su[NB][2], sv[NB][2];
#pragma unroll
        for (int b = 0; b < NB; ++b)
#pragma unroll
            for (int hh = 0; hh < 2; ++hh) { su[b][hh] = ((const float*)(F.ws + WS_SCU))[e[b][hh]]; sv[b][hh] = ((const float*)(F.ws + WS_SCV))[e[b][hh]]; }
#pragma unroll
        for (int b = 0; b < NB; ++b) {
            const int t = tb + b;
            float cf[2]; float mx = 0.f;
#pragma unroll
            for (int hh = 0; hh < 2; ++hh) { const float a = hs[b] * su[b][hh] * (64.0f * (float)s[b][hh]);
                cf[hh] = gt[b][hh] * 0.5f * a * (1.0f + erff(a * 0.70710678118654752f)) * sv[b][hh]; mx = fmaxf(mx, fabsf(cf[hh])); }
#pragma unroll
            for (int o = 1; o < 64; o <<= 1) mx = fmaxf(mx, __shfl_xor(mx, o));
            const float sc = fmaxf(mx, 1e-30f) * (1.0f / 127.0f), inv = 1.0f / sc;
#pragma unroll
            for (int hh = 0; hh < 2; ++hh) {
                int v = ((int)rintf(cf[hh] * inv) & 0xff) << (8 * (lane & 3));
                v |= dpp_i<DPP_XOR1>(v); v |= dpp_i<DPP_XOR2>(v);
                if ((lane & 3) == 0) F.CQ[(size_t)t * 32 + ((p0 + 8 * hh) >> 2)] = (unsigned)v;
            }
            if (lane == 0) F.CS[t] = sc;
        }
    }
}

__device__ __forceinline__ void p5_scales(Frame& F) {
    const int gt = F.vcu * NWAVES * 64 + F.tid, NGT = F.G * NWAVES * 64;
    for (int t = gt; t < TOK; t += NGT) {
        float mx = 0.f, ss = 0.f;
#pragma unroll
        for (int q = 0; q < 4; ++q) { const f32x4 m = *(const GAS f32x4*)(F.MAXP + (size_t)t * 16 + 4 * q), p = *(const GAS f32x4*)(F.SSQ2P + (size_t)t * 16 + 4 * q);
            mx = fmaxf(mx, fmaxf(fmaxf(m[0], m[1]), fmaxf(m[2], m[3]))); ss += (p[0] + p[1]) + (p[2] + p[3]); }
        const float rstd2 = 1.0f / sqrtf(ss * (1.0f / DM) + pg8::EPS_F), sc = fmaxf(mx, 1e-20f) * (1.0f / 127.0f);
        F.HINV[t] = 1.0f / sc; F.HS[t] = sc * rstd2;
    }
}

#ifndef PROBE_REPEAT
#define PROBE_REPEAT -1
#endif
struct Args { const float* in[16]; float* out; unsigned char* ws; int ph_lo, ph_hi; };

template <class Sched> __device__ __forceinline__ void prep_tab_outproj(Frame& F, const Sched& S) {
    LAS float* tab = (LAS float*)(F.lds + TAB_OFF);
    pg8::Unit u;
    for (int i = 0; S.next(i, u) && i < 4; ++i) {
        if (F.tid < 256) {
            const int row = u.pm * 256 + F.tid;
            const f32x4 a0 = *(const GAS f32x4*)(F.SSQA + (size_t)row * 8), a1 = *(const GAS f32x4*)(F.SSQA + (size_t)row * 8 + 4);
            const f32x4 s0 = *(const GAS f32x4*)(F.SSQS + (size_t)row * 8), s1 = *(const GAS f32x4*)(F.SSQS + (size_t)row * 8 + 4);
            const float sa = ((a0[0] + a0[1]) + (a0[2] + a0[3])) + ((a1[0] + a1[1]) + (a1[2] + a1[3]));
            const float ss = ((s0[0] + s0[1]) + (s0[2] + s0[3])) + ((s1[0] + s1[1]) + (s1[2] + s1[3]));
            const float ra = 1.0f / sqrtf(sa * (1.0f / 512.0f) + pg8::EPS_F), rs = 1.0f / sqrtf(ss * (1.0f / 512.0f) + pg8::EPS_F);
            tab[(i * 256 + F.tid) * 2] = ra / rs; tab[(i * 256 + F.tid) * 2 + 1] = rs;
        }
    }
    LDS_WAIT(); __syncthreads();
}
template <class Sched> __device__ __forceinline__ void prep_tab_query(Frame& F, const Sched& S) {
    LAS float* tab = (LAS float*)(F.lds + TAB_OFF);
    pg8::Unit u;
    for (int i = 0; S.next(i, u) && i < 8; ++i) {
        if (F.tid < 256) {
            const int row = u.pm * 256 + F.tid; float s = 0.f;
#pragma unroll
            for (int j = 0; j < 4; ++j) { const f32x4 p = *(const GAS f32x4*)(F.SSQ2P + (size_t)row * 16 + 4 * j); s += (p[0] + p[1]) + (p[2] + p[3]); }
            tab[i * 256 + F.tid] = 1.0f / sqrtf(s * (1.0f / DM) + pg8::EPS_F);
        }
    }
    LDS_WAIT(); __syncthreads();
}

__device__ __forceinline__ void run_p1(Frame& F) {
    pg8::Gemm g{F.XB, F.Win_t, TOK, INW, DM}; pg8::StaticOrder S; S.init(TOK, INW, F.G, (int)blockIdx.x);
    pg8::EpiInProj E{F.RSTD1, F.q_norm_g, F.k_norm_g, F.sgu_norm_g, F.Q, WS_TYPE_STRIDE / 2};
    pg8::gemm_phase<pg8::EpiInProj, pg8::StaticOrder, true, true>(F.lds + RING_OFF, g, S, E);
}
__device__ __forceinline__ void run_p3(Frame& F) {
    pg8::Gemm g{F.MIX, F.Wout_t, TOK, DM, DM}; pg8::StaticOrder S; S.init(TOK, DM, F.G, (int)blockIdx.x);
    prep_tab_outproj(F, S);
    pg8::EpiOutProj E{F.x, F.out, F.XB, F.SSQ2P, F.MAXP, (const LAS float*)(F.lds + TAB_OFF)};
    pg8::gemm_phase<pg8::EpiOutProj, pg8::StaticOrder, true, true>(F.lds + RING_OFF, g, S, E);
}
__device__ __forceinline__ void run_p4(Frame& F) {
    pg8::Gemm g{F.XB, F.Wq_t, TOK, QPW, DM}; pg8::StaticOrder S; S.init(TOK, QPW, F.G, (int)blockIdx.x);
    prep_tab_query(F, S);
    pg8::EpiQuery E{F.QP, (const LAS float*)(F.lds + TAB_OFF)};
    pg8::gemm_phase<pg8::EpiQuery, pg8::StaticOrder, true, true>(F.lds + RING_OFF, g, S, E);
}

__global__ void __launch_bounds__(NWAVES * 64, 2) hyb_fwd(Args args) {
    extern __shared__ __attribute__((aligned(16))) unsigned char lds[];
    Frame F;
    F.lds = (LAS unsigned char*)lds;
    F.MISC = (volatile LAS unsigned*)(F.lds + MISC_OFF);
    F.tid = threadIdx.x; F.lane = F.tid & 63; F.wave = __builtin_amdgcn_readfirstlane(F.tid >> 6);
    F.G = gridDim.x; { const int bx = blockIdx.x; F.vcu = (F.G % 8 == 0) ? (bx % 8) * (F.G / 8) + bx / 8 : bx; }
    unsigned char* ws = args.ws;
    F.ctl = (gu32*)(ws + WS_CTL);
    F.x = args.in[0]; F.norm1_g = args.in[1]; F.w_in = args.in[2]; F.q_norm_g = args.in[3]; F.k_norm_g = args.in[4]; F.sgu_norm_g = args.in[5]; F.sgu_w = args.in[6]; F.sgu_b = args.in[7];
    F.attn_out_g = args.in[8]; F.sgu_out_g = args.in[9]; F.w_out = args.in[10]; F.norm2_g = args.in[11]; F.w_query = args.in[12]; F.sub_keys = args.in[13]; F.expert_u = args.in[14]; F.expert_v = args.in[15];
    F.out = args.out;
    F.Win_t = (bf16*)(ws + WS_WIN); F.Wout_t = (bf16*)(ws + WS_WOUT); F.Wq_t = (bf16*)(ws + WS_WQ); F.SK = (bf16*)(ws + WS_SK); F.SGUW = (bf16*)(ws + WS_SGUW);
    F.U8 = (signed char*)(ws + WS_UB); F.V8 = (signed char*)(ws + WS_VB); F.ws = ws;
    F.H8 = (signed char*)(ws + WS_H8); F.MAXP = (float*)(ws + WS_MAXP); F.HINV = (float*)(ws + WS_HINV); F.HS = (float*)(ws + WS_HS); F.PA = (int*)(ws + WS_PA); F.CQ = (unsigned*)(ws + WS_COEF); F.CS = (float*)(ws + WS_COEF0);
    F.XB = (bf16*)(ws + WS_XB); F.Q = (bf16*)(ws + WS_Q); F.QP = (bf16*)(ws + WS_QP); F.MIX = (bf16*)(ws + WS_MIX);
    F.RSTD1 = (float*)(ws + WS_RSTD1); F.SSQA = (float*)(ws + WS_SSQA); F.SSQS = (float*)(ws + WS_SSQS); F.SSQ2P = (float*)(ws + WS_SSQ2P); F.GATE = (float*)(ws + WS_GATE); F.EIDX = (unsigned short*)(ws + WS_EIDX);
    for (int u = F.tid; u < (LDS_BYTES - LDSCTL_OFF) / 4; u += NWAVES * 64) ((LAS unsigned*)(F.lds + LDSCTL_OFF))[u] = 0u;
    __syncthreads();
    XcdBarrier bar; bar.bar = (unsigned*)(F.ctl + CW_BAR); bar.x = 0; bar.st = nullptr;
    const int lo = args.ph_lo, hi = args.ph_hi;
    if (hi - lo > 1) bar = xcd_barrier_post((unsigned*)(F.ctl + CW_BAR), F.MISC + 8);
#define IN(k) (lo <= (k) && (k) < hi)

#define SEAM(k) do { if (IN(k) && IN((k) + 1)) { xcd_barrier(bar); if (PROBE_REPEAT == 100 + (k)) { xcd_barrier(bar); xcd_barrier(bar); xcd_barrier(bar); xcd_barrier(bar); } } } while (0)

    if (IN(0)) { p0_prologue(F); if (PROBE_REPEAT == 0) { xcd_barrier(bar); p0_prologue(F); } } SEAM(0);
    if (IN(1)) { run_p1(F); if (PROBE_REPEAT == 1) { xcd_barrier(bar); run_p1(F); } } SEAM(1);
    if (IN(2)) { p2_mixers(F); if (PROBE_REPEAT == 2) { xcd_barrier(bar); p2_mixers(F); } } SEAM(2);
    if (IN(3)) { run_p3(F); if (PROBE_REPEAT == 3) { xcd_barrier(bar); run_p3(F); } } SEAM(3);
    if (IN(4)) { run_p4(F); if (PROBE_REPEAT == 4) { xcd_barrier(bar); run_p4(F); } }
    if (!(IN(4) && IN(5))) {   } else { asm volatile("s_waitcnt vmcnt(0)" ::: "memory"); __syncthreads(); }
    if (IN(5)) {
#pragma unroll 1
        for (int rep = 0; rep < (PROBE_REPEAT == 5 ? 2 : 1); ++rep) p5_topk(F);
#pragma unroll 1
        for (int rep = 0; rep < (PROBE_REPEAT == 15 ? 2 : 1); ++rep) p5_scales(F);
    } SEAM(5);
    if (IN(6)) {
#pragma unroll 1
        for (int rep = 0; rep < (PROBE_REPEAT == 6 ? 2 : 1); ++rep) {
            if (rep) { xcd_barrier(bar); if (blockIdx.x == 0 && F.tid < 8) __hip_atomic_store((unsigned*)(F.ctl + CW_QA + 64 * F.tid), 0u, __ATOMIC_RELAXED, __HIP_MEMORY_SCOPE_AGENT); xcd_barrier(bar); }
            p6_sliced<false>(F);
        }
        if (hi - lo > 1) xcd_barrier(bar);
#pragma unroll 1
        for (int rep = 0; rep < (PROBE_REPEAT == 7 ? 2 : 1); ++rep) p6_reduce(F);
        if (hi - lo > 1) xcd_barrier(bar);
#pragma unroll 1
        for (int rep = 0; rep < (PROBE_REPEAT == 8 ? 2 : 1); ++rep) {
            if (rep) { xcd_barrier(bar); if (blockIdx.x == 0 && F.tid < 8) __hip_atomic_store((unsigned*)(F.ctl + CW_QB + 64 * F.tid), 0u, __ATOMIC_RELAXED, __HIP_MEMORY_SCOPE_AGENT); xcd_barrier(bar); }
            p6_sliced<true>(F);
        }
    }
#undef IN
#undef SEAM
}

extern "C" void kernel_launch(void* const* d_in, const int* in_sizes, int n_in, void* d_out, int out_size, void* d_ws, size_t ws_size, hipStream_t stream) {
    static int grid = 0;
    if (grid == 0) {
        if (n_in != 16 || in_sizes[0] != TOK * DM || out_size != TOK * DM || ws_size < WS_END) { fprintf(stderr, "kernel_launch: unexpected shapes (n_in %d, in0 %d, out %d, ws %zu)\n", n_in, n_in > 0 ? in_sizes[0] : -1, out_size, ws_size); grid = -1; return; }
        int dev = 0, cus = 0, per_cu = 0;
        if (hipGetDevice(&dev) != hipSuccess || hipDeviceGetAttribute(&cus, hipDeviceAttributeMultiprocessorCount, dev) != hipSuccess) { fprintf(stderr, "kernel_launch: device query failed\n"); grid = -1; return; }
        if (hipFuncSetAttribute((const void*)hyb_fwd, hipFuncAttributeMaxDynamicSharedMemorySize, LDS_BYTES) != hipSuccess) { fprintf(stderr, "kernel_launch: hipFuncSetAttribute failed\n"); grid = -1; return; }
        if (hipOccupancyMaxActiveBlocksPerMultiprocessor(&per_cu, (const void*)hyb_fwd, NWAVES * 64, LDS_BYTES) != hipSuccess || per_cu < 1) { fprintf(stderr, "kernel_launch: occupancy query reports %d blocks per CU\n", per_cu); per_cu = 1; }
        (void)hipGetLastError();
        grid = cus;
        if (grid % 8 != 0) grid -= grid % 8;
    }
    if (grid < 0) return;
    (void)hipMemsetAsync((char*)d_ws + WS_CTL, 0, CTL_ZERO_BYTES, stream);
    Args a{};
    for (int i = 0; i < 16; ++i) a.in[i] = (const float*)d_in[i];
    a.out = (float*)d_out; a.ws = (unsigned char*)d_ws;
    if (N_LAUNCHES == 1) { a.ph_lo = 0; a.ph_hi = NPHASE; hipLaunchKernelGGL(hyb_fwd, dim3(grid), dim3(NWAVES * 64), LDS_BYTES, stream, a); }
    else for (int li = 0; li < NPHASE; ++li) { a.ph_lo = li; a.ph_hi = li + 1; hipLaunchKernelGGL(hyb_fwd, dim3(grid), dim3(NWAVES * 64), LDS_BYTES, stream, a); }
}
```

```cpp
#include <hip/hip_runtime.h>
#include <cstdio>
#include <cstdint>
#include <cmath>
namespace pg8 {
#define PG8_LAS __attribute__((address_space(3)))
typedef unsigned short bf16_t;
typedef short bf16x8 __attribute__((ext_vector_type(8)));
typedef float f32x4 __attribute__((ext_vector_type(4)));
typedef unsigned u32x4 __attribute__((ext_vector_type(4)));
constexpr int BM = 256, BK = 64, HALF = 128, HTB = HALF * BK * 2  , STAGE_BYTES = 8 * HTB, NXCD = 8, WGM = 8;

__host__ __device__ __forceinline__ int lds_byte(int r, int c) { const int st = (r >> 4) * 2 + (c >> 5), rr = r & 15, cc = c & 31, ob = rr * 64 + cc * 2; return st * 1024 + (ob ^ (((ob >> 9) & 1) << 5)); }
__host__ __device__ __forceinline__ void stage_rc(int b, int& R, int& C) { const int st = b / 1024, sb = b % 1024, swz = sb ^ (((sb >> 9) & 1) << 5); R = (st >> 1) * 16 + swz / 64; C = (st & 1) * 32 + (swz % 64) / 2; }
__host__ __device__ __forceinline__ int perm32(int rho) { const int n = rho >> 4, i = rho & 15; return 8 * (i >> 2) + 4 * n + (i & 3); }

struct Unit { int pm, pn; };
struct Gemm { const bf16_t* A; const bf16_t* Bt; int M, N, K; };

struct StaticOrder {
    int nM, nN, nwg, G, c;
    __host__ __device__ void init(int M, int N, int G_, int c_) { nM = M / BM; nN = N / BM; nwg = nM * nN; G = G_; c = c_; }
    __host__ __device__ bool next(int i, Unit& u) const {
        const long L = (long)i * G + c; if (L >= nwg) return false;
        int wgid = (int)L; { const int q = nwg / NXCD, r = nwg % NXCD, xcd = wgid % NXCD, off = wgid / NXCD; wgid = (xcd < r ? xcd * (q + 1) : r * (q + 1) + (xcd - r) * q) + off; }
        const int nig = WGM * nN, gid = wgid / nig, fm = gid * WGM, gsz = (nM - fm) < WGM ? (nM - fm) : WGM;
        u.pm = fm + ((wgid % nig) % gsz); u.pn = (wgid % nig) / gsz; return true;
    }
    __device__ __forceinline__ void a_ready(const Unit&) const {}
    __device__ __forceinline__ void done(const Unit&) const {}
};


__device__ __forceinline__ unsigned cvt_pk_bf16(float lo, float hi) { unsigned r; asm volatile("v_cvt_pk_bf16_f32 %0, %1, %2" : "=v"(r) : "v"(lo), "v"(hi)); return r; }

constexpr float EPS_F = 1e-6f;
constexpr float QSCALE = 0.125f * 1.4426950408889634f;

struct EpiInProj {
    static constexpr bool PERM = true; static constexpr int MID_T = 0;
    const PG8_LAS float* tab;
    const PG8_LAS float* gtab;
    bf16_t* out0; size_t type_stride;
    __device__ __forceinline__ void operator()(const f32x4 (&acc)[2][2][4][2], const Unit& u, int ui, int wr, int wc, int fr, int fq) const {
        const int type = u.pn >> 1, half = u.pn & 1;
        bf16_t* base = out0 + (size_t)type * type_stride;
        const int colb = 256 * half + 64 * wc + 8 * fq;
        const bool normed = (type == 0) || (type == 1) || (type == 4);
        const int goff = (type == 0) ? 8 * fq : (type == 1) ? 64 + 8 * fq : 128 + colb;
        float g[2][8];
#pragma unroll
        for (int bj = 0; bj < 2; ++bj) {
            const f32x4 g0 = *(const PG8_LAS f32x4*)(gtab + goff + 32 * bj), g1 = *(const PG8_LAS f32x4*)(gtab + goff + 32 * bj + 4);
#pragma unroll
            for (int e = 0; e < 4; ++e) { g[bj][e] = normed ? g0[e] : 1.f; g[bj][4 + e] = normed ? g1[e] : 1.f; }
        }
#pragma unroll
        for (int ai = 0; ai < 2; ++ai)
#pragma unroll
            for (int m = 0; m < 4; ++m) {
                const int lr = ai * HALF + wr * 64 + m * 16 + fr, row = u.pm * BM + lr;
                const float rs = tab[ui * 256 + lr];
                f32x4 v[2][2];
                float ss = 0.f;
#pragma unroll
                for (int bj = 0; bj < 2; ++bj)
#pragma unroll
                    for (int n = 0; n < 2; ++n) { v[bj][n] = acc[ai][bj][m][n] * rs; const f32x4 x = v[bj][n]; ss += (x[0] * x[0] + x[1] * x[1]) + (x[2] * x[2] + x[3] * x[3]); }
                float r = 1.f;
                if (normed) { ss += __shfl_xor(ss, 16); ss += __shfl_xor(ss, 32); r = 1.0f / sqrtf(ss * (1.0f / 64.0f) + EPS_F); }
                bf16_t* rowp = base + (size_t)row * 512 + colb;
#pragma unroll
                for (int bj = 0; bj < 2; ++bj) {
                    const f32x4 a = v[bj][0], b = v[bj][1];
                    u32x4 w;
                    w.x = cvt_pk_bf16(a[0] * r * g[bj][0], a[1] * r * g[bj][1]); w.y = cvt_pk_bf16(a[2] * r * g[bj][2], a[3] * r * g[bj][3]);
                    w.z = cvt_pk_bf16(b[0] * r * g[bj][4], b[1] * r * g[bj][5]); w.w = cvt_pk_bf16(b[2] * r * g[bj][6], b[3] * r * g[bj][7]);
                    *(u32x4*)(rowp + 32 * bj) = w;
                }
            }
    }
};

struct EpiOutProj {
    static constexpr bool PERM = true; static constexpr int MID_T = 8;
    const float* x; float* x1; bf16_t* x1b; float* ssq2p; float* maxp; const PG8_LAS float* tab;
    __device__ __forceinline__ void mid(f32x4 (&acc)[2][2][4][2], const Unit&, int ui, int wr, int, int fr, int) const {
#pragma unroll
        for (int ai = 0; ai < 2; ++ai)
#pragma unroll
            for (int m = 0; m < 4; ++m) {
                const float rt = tab[(ui * 256 + ai * HALF + wr * 64 + m * 16 + fr) * 2];
#pragma unroll
                for (int bj = 0; bj < 2; ++bj)
#pragma unroll
                    for (int n = 0; n < 2; ++n) acc[ai][bj][m][n] *= rt;
            }
    }
    __device__ __forceinline__ void operator()(const f32x4 (&acc)[2][2][4][2], const Unit& u, int ui, int wr, int wc, int fr, int fq) const {
        const size_t cbase = (size_t)u.pn * BM + wc * 32 + 8 * fq;
        u32x4 xn[2];
#define OP_LOADX(it_) do { const int r_ = u.pm * BM + ((it_) >> 2) * HALF + wr * 64 + ((it_) & 3) * 16 + fr; \
            _Pragma("unroll") for (int bj = 0; bj < 2; ++bj) xn[bj] = *(const u32x4*)(x1b + (size_t)r_ * 1024 + cbase + bj * HALF); } while (0)
        OP_LOADX(0);
#pragma unroll
        for (int it = 0; it < 8; ++it) {
            const int ai = it >> 2, m = it & 3;
            const int lr = ai * HALF + wr * 64 + m * 16 + fr, row = u.pm * BM + lr;
            const float rs = tab[(ui * 256 + lr) * 2 + 1];
            u32x4 xc[2];
#pragma unroll
            for (int bj = 0; bj < 2; ++bj) xc[bj] = xn[bj];
            if (it + 1 < 8) OP_LOADX(it + 1);
            float ss = 0.f, mx = 0.f;
#pragma unroll
            for (int bj = 0; bj < 2; ++bj) {
                const size_t off = (size_t)row * 1024 + cbase + bj * HALF;
                f32x4 xa, xb_; xa[0] = __builtin_bit_cast(float, xc[bj].x << 16); xa[1] = __builtin_bit_cast(float, xc[bj].x & 0xffff0000u); xa[2] = __builtin_bit_cast(float, xc[bj].y << 16); xa[3] = __builtin_bit_cast(float, xc[bj].y & 0xffff0000u);
                xb_[0] = __builtin_bit_cast(float, xc[bj].z << 16); xb_[1] = __builtin_bit_cast(float, xc[bj].z & 0xffff0000u); xb_[2] = __builtin_bit_cast(float, xc[bj].w << 16); xb_[3] = __builtin_bit_cast(float, xc[bj].w & 0xffff0000u);
                const f32x4 a = xa + acc[ai][bj][m][0] * rs, b = xb_ + acc[ai][bj][m][1] * rs;
                ss += (a[0] * a[0] + a[1] * a[1]) + (a[2] * a[2] + a[3] * a[3]) + (b[0] * b[0] + b[1] * b[1]) + (b[2] * b[2] + b[3] * b[3]);
                mx = fmaxf(mx, fmaxf(fmaxf(fmaxf(fabsf(a[0]), fabsf(a[1])), fmaxf(fabsf(a[2]), fabsf(a[3]))), fmaxf(fmaxf(fabsf(b[0]), fabsf(b[1])), fmaxf(fabsf(b[2]), fabsf(b[3])))));
                u32x4 w; w.x = cvt_pk_bf16(a[0], a[1]); w.y = cvt_pk_bf16(a[2], a[3]); w.z = cvt_pk_bf16(b[0], b[1]); w.w = cvt_pk_bf16(b[2], b[3]);
                *(u32x4*)(x1b + off) = w;
            }
            ss += __shfl_xor(ss, 16); ss += __shfl_xor(ss, 32); mx = fmaxf(mx, __shfl_xor(mx, 16)); mx = fmaxf(mx, __shfl_xor(mx, 32));
            if (fq == 0) { ssq2p[(size_t)row * 16 + u.pn * 4 + wc] = ss; maxp[(size_t)row * 16 + u.pn * 4 + wc] = mx; }
        }
#undef OP_LOADX
    }
};

struct EpiQuery {
    static constexpr bool PERM = true; static constexpr int MID_T = 0;
    bf16_t* qp; const PG8_LAS float* tab;
    __device__ __forceinline__ void operator()(const f32x4 (&acc)[2][2][4][2], const Unit& u, int ui, int wr, int wc, int fr, int fq) const {
#pragma unroll
        for (int ai = 0; ai < 2; ++ai)
#pragma unroll
            for (int m = 0; m < 4; ++m) {
                const int lr = ai * HALF + wr * 64 + m * 16 + fr, row = u.pm * BM + lr;
                const float rs = tab[ui * 256 + lr];
#pragma unroll
                for (int bj = 0; bj < 2; ++bj) {
                    const size_t off = ((((size_t)(row >> 5) * 8 + u.pn) * 2 + bj) * 8 + 2 * wc + (fq >> 1)) * 512 + (size_t)(32 * (fq & 1) + (row & 31)) * 8;
                    const f32x4 a = acc[ai][bj][m][0] * rs, b = acc[ai][bj][m][1] * rs;
                    u32x4 w; w.x = cvt_pk_bf16(a[0], a[1]); w.y = cvt_pk_bf16(a[2], a[3]); w.z = cvt_pk_bf16(b[0], b[1]); w.w = cvt_pk_bf16(b[2], b[3]);
                    *(u32x4*)(qp + off) = w;
                }
            }
    }
};

template <class Epi, class Sched, bool ALIGN_EPI = false, bool SP2 = false>
__device__ __forceinline__ void gemm_phase(PG8_LAS unsigned char* lds, const Gemm g, const Sched& S, const Epi& E) {
    const int tid = threadIdx.x, wid = __builtin_amdgcn_readfirstlane(tid >> 6), lane = tid & 63, wr = wid >> 2, wc = wid & 3, fr = lane & 15, fq = lane >> 4;
    const int K = g.K, nt = K / BK;
    unsigned voffA[2], voffB[2];
#pragma unroll
    for (int i = 0; i < 2; ++i) { int R, C; stage_rc(tid * 16 + i * 8192, R, C); const int Rb = Epi::PERM ? ((R & ~31) + perm32(R & 31)) : R;
        voffA[i] = (unsigned)(R * K + C) * 2u; voffB[i] = (unsigned)(Rb * K + C) * 2u; }
    const size_t kstep = (size_t)(BK * 2);
    const size_t hstep = (size_t)HALF * K * 2;
    const size_t tstep = 2 * hstep;
    const unsigned ldsw = (unsigned)wid * 1024u;
    const int aoff = lds_byte(wr * 64 + fr, fq * 8), boff = lds_byte(wc * 32 + fr, fq * 8);
#define PG8_SA(b, h) (((b) * 2 + (h)) * HTB)
#define PG8_SB(b, h) ((4 + (b) * 2 + (h)) * HTB)
#define PG8_STAGE(bufoff, gbase, voff) do { _Pragma("unroll") for (int _i = 0; _i < 2; ++_i) \
        __builtin_amdgcn_global_load_lds((const unsigned*)((const char*)(gbase) + (voff)[_i]), (PG8_LAS unsigned*)(lds + (bufoff) + ldsw + _i * 8192), 16, 0, 0); } while (0)
#define PG8_LDA(dst, b, h) do { _Pragma("unroll") for (int m = 0; m < 4; ++m) _Pragma("unroll") for (int k = 0; k < 2; ++k) dst[m][k] = *(const PG8_LAS bf16x8*)(lds + PG8_SA(b, h) + aoff + m * 2048 + k * 1024); } while (0)
#define PG8_LDB(dst, b, h) do { _Pragma("unroll") for (int n = 0; n < 2; ++n) _Pragma("unroll") for (int k = 0; k < 2; ++k) dst[n][k] = *(const PG8_LAS bf16x8*)(lds + PG8_SB(b, h) + boff + n * 2048 + k * 1024); } while (0)
#define PG8_MMA(ai, bj, At, Bt) do { __builtin_amdgcn_s_setprio(1); _Pragma("unroll") for (int m = 0; m < 4; ++m) _Pragma("unroll") for (int n = 0; n < 2; ++n) _Pragma("unroll") for (int k = 0; k < 2; ++k) \
        acc[ai][bj][m][n] = __builtin_amdgcn_mfma_f32_16x16x32_bf16(Bt[n][k], At[m][k], acc[ai][bj][m][n], 0, 0, 0); __builtin_amdgcn_s_setprio(0); } while (0)
#define PG8_WAIT_V(n) asm volatile("s_waitcnt vmcnt(" #n ")" ::: "memory")
#define PG8_WAIT_L(n) asm volatile("s_waitcnt lgkmcnt(" #n ")" ::: "memory")
#define PG8_BAR __builtin_amdgcn_s_barrier()
#define PG8_SCHED __builtin_amdgcn_sched_barrier(0)
    Unit cur, nxt; int ui = 0;
    if (!S.next(0, cur)) return;
    f32x4 acc[2][2][4][2];
#pragma unroll
    for (int a = 0; a < 2; ++a)
#pragma unroll
        for (int b = 0; b < 2; ++b)
#pragma unroll
            for (int m = 0; m < 4; ++m)
#pragma unroll
                for (int n = 0; n < 2; ++n) acc[a][b][m][n] = (f32x4){0.f, 0.f, 0.f, 0.f};
    bf16x8 At[4][2], B0[2][2], B1[2][2];
    const char* cA = (const char*)g.A + (size_t)cur.pm * tstep; const char* cB = (const char*)g.Bt + (size_t)cur.pn * tstep;
    S.a_ready(cur);
    if constexpr (SP2) {
        PG8_STAGE(PG8_SB(0, 0), cB, voffB); PG8_STAGE(PG8_SB(0, 1), cB + hstep, voffB); PG8_STAGE(PG8_SA(0, 0), cA, voffA); PG8_STAGE(PG8_SA(0, 1), cA + hstep, voffA);
        if (wr == 1) PG8_BAR;
        PG8_WAIT_V(2); PG8_BAR;
        PG8_STAGE(PG8_SB(1, 0), cB + kstep, voffB); PG8_STAGE(PG8_SA(1, 0), cA + kstep, voffA); PG8_STAGE(PG8_SB(1, 1), cB + hstep + kstep, voffB);
        PG8_WAIT_V(6); PG8_BAR;
    } else {
        PG8_STAGE(PG8_SB(0, 0), cB, voffB); PG8_STAGE(PG8_SA(0, 0), cA, voffA); PG8_STAGE(PG8_SB(0, 1), cB + hstep, voffB); PG8_STAGE(PG8_SA(0, 1), cA + hstep, voffA);
        if (wr == 1) PG8_BAR;
        PG8_WAIT_V(4); PG8_BAR;
        PG8_STAGE(PG8_SB(1, 0), cB + kstep, voffB); PG8_STAGE(PG8_SA(1, 0), cA + kstep, voffA); PG8_STAGE(PG8_SB(1, 1), cB + hstep + kstep, voffB);
        PG8_WAIT_V(6); PG8_BAR;
    }
    for (;;) {
        const bool has_next = S.next(ui + 1, nxt);
        const char* nA = has_next ? (const char*)g.A + (size_t)nxt.pm * tstep : cA; const char* nB = has_next ? (const char*)g.Bt + (size_t)nxt.pn * tstep : cB;
        for (int t = 0; t < nt; t += 2) {
            if constexpr (Epi::MID_T > 0) { if (t == Epi::MID_T) E.mid(acc, cur, ui, wr, wc, fr, fq); }
            const bool last = (t == nt - 2);
            const char* a1 = cA + (size_t)(t + 1) * kstep;
            const char* a2 = last ? nA : cA + (size_t)(t + 2) * kstep; const char* b2 = last ? nB : cB + (size_t)(t + 2) * kstep;
            const char* a3 = a2 + kstep; const char* b3 = b2 + kstep;
            if (last && has_next) S.a_ready(nxt);
            if constexpr (SP2) {
            PG8_LDB(B0, 0, 0); PG8_LDB(B1, 0, 1); PG8_SCHED; PG8_LDA(At, 0, 0); PG8_STAGE(PG8_SA(1, 1), a1 + hstep, voffA);
            PG8_WAIT_V(8); PG8_WAIT_L(0); PG8_BAR; PG8_MMA(0, 0, At, B0); PG8_MMA(0, 1, At, B1); PG8_BAR; PG8_SCHED;
            PG8_LDA(At, 0, 1); PG8_STAGE(PG8_SB(0, 0), b2, voffB); PG8_STAGE(PG8_SB(0, 1), b2 + hstep, voffB); PG8_STAGE(PG8_SA(0, 0), a2, voffA);
            PG8_WAIT_V(8); PG8_WAIT_L(0); PG8_BAR; PG8_MMA(1, 0, At, B0); PG8_MMA(1, 1, At, B1); PG8_BAR; PG8_SCHED;
            PG8_LDB(B0, 1, 0); PG8_LDB(B1, 1, 1); PG8_SCHED; PG8_LDA(At, 1, 0); PG8_STAGE(PG8_SA(0, 1), a2 + hstep, voffA);
            PG8_WAIT_V(8); PG8_WAIT_L(0); PG8_BAR; PG8_MMA(0, 0, At, B0); PG8_MMA(0, 1, At, B1); PG8_BAR; PG8_SCHED;
            PG8_LDA(At, 1, 1); PG8_STAGE(PG8_SB(1, 0), b3, voffB); PG8_STAGE(PG8_SB(1, 1), b3 + hstep, voffB); PG8_STAGE(PG8_SA(1, 0), a3, voffA);
            PG8_WAIT_V(8); PG8_WAIT_L(0); PG8_BAR; PG8_MMA(1, 0, At, B0); PG8_MMA(1, 1, At, B1); PG8_BAR; PG8_SCHED;
            } else {
            PG8_LDB(B0, 0, 0); PG8_SCHED; PG8_LDA(At, 0, 0); PG8_STAGE(PG8_SA(1, 1), a1 + hstep, voffA);
            PG8_WAIT_L(8); PG8_BAR; PG8_WAIT_L(0); PG8_MMA(0, 0, At, B0); PG8_BAR; PG8_SCHED;
            PG8_LDB(B1, 0, 1); PG8_STAGE(PG8_SB(0, 0), b2, voffB);
            PG8_BAR; PG8_WAIT_L(0); PG8_MMA(0, 1, At, B1); PG8_BAR;
            PG8_LDA(At, 0, 1); PG8_STAGE(PG8_SA(0, 0), a2, voffA);
            PG8_BAR; PG8_WAIT_L(0); PG8_MMA(1, 0, At, B0); PG8_BAR; PG8_SCHED;
            PG8_STAGE(PG8_SB(0, 1), b2 + hstep, voffB);
            PG8_WAIT_V(6); PG8_BAR; PG8_MMA(1, 1, At, B1); PG8_BAR;
            PG8_LDB(B0, 1, 0); PG8_SCHED; PG8_LDA(At, 1, 0); PG8_STAGE(PG8_SA(0, 1), a2 + hstep, voffA);
            PG8_WAIT_L(8); PG8_BAR; PG8_WAIT_L(0); PG8_MMA(0, 0, At, B0); PG8_BAR; PG8_SCHED;
            PG8_LDB(B1, 1, 1); PG8_STAGE(PG8_SB(1, 0), b3, voffB);
            PG8_BAR; PG8_WAIT_L(0); PG8_MMA(0, 1, At, B1); PG8_BAR;
            PG8_LDA(At, 1, 1); PG8_STAGE(PG8_SA(1, 0), a3, voffA);
            PG8_BAR; PG8_WAIT_L(0); PG8_MMA(1, 0, At, B0); PG8_BAR; PG8_SCHED;
            PG8_STAGE(PG8_SB(1, 1), b3 + hstep, voffB);
            PG8_WAIT_V(6); PG8_BAR; PG8_MMA(1, 1, At, B1); PG8_BAR;
            }
        }
        if constexpr (ALIGN_EPI) { if (wr == 0) PG8_BAR; }
        E(acc, cur, ui, wr, wc, fr, fq); S.done(cur);
        if (!has_next) break;
#pragma unroll
        for (int a = 0; a < 2; ++a)
#pragma unroll
            for (int b = 0; b < 2; ++b)
#pragma unroll
                for (int m = 0; m < 4; ++m)
#pragma unroll
                    for (int n = 0; n < 2; ++n) acc[a][b][m][n] = (f32x4){0.f, 0.f, 0.f, 0.f};
        cur = nxt; cA = nA; cB = nB; ++ui;
        if constexpr (ALIGN_EPI) { if (wr == 1) PG8_BAR; }
    }
    PG8_WAIT_V(0);
    if constexpr (!ALIGN_EPI) { if (wr == 0) PG8_BAR; }
    PG8_BAR;
#undef PG8_SA
#undef PG8_SB
#undef PG8_STAGE
#undef PG8_LDA
#undef PG8_LDB
#undef PG8_MMA
#undef PG8_WAIT_V
#undef PG8_WAIT_L
#undef PG8_BAR
#undef PG8_SCHED
}
}

constexpr int NWAVES = 8;
constexpr int DM = 1024, BATCH = 8, SEQ = 4096, TOK = BATCH * SEQ;
constexpr int AW = 512, INW = 2560, QPW = 2048, NEXP = 16384;
constexpr int NPHASE = 7;
#ifndef MK_N_LAUNCHES
#define MK_N_LAUNCHES 1
#endif
constexpr int N_LAUNCHES = MK_N_LAUNCHES;

constexpr size_t MiB = 1u << 20;
constexpr size_t WS_CTL = 0, CTL_ZERO_BYTES = 64 * 1024;
constexpr size_t WS_WIN = 2 * MiB, WS_WOUT = 8 * MiB, WS_WQ = 10 * MiB, WS_SK = 14 * MiB, WS_SGUW = 14 * MiB + 512 * 1024, WS_RSTD1 = 15 * MiB;
constexpr size_t WS_SCU = 15 * MiB + 256 * 1024, WS_SCV = 15 * MiB + 512 * 1024;
constexpr size_t WS_UB = 16 * MiB, WS_VB = 48 * MiB;
constexpr size_t WS_XB = 80 * MiB;
constexpr size_t WS_Q = 144 * MiB, WS_TYPE_STRIDE = 32 * MiB;
constexpr size_t WS_QP = 144 * MiB;
constexpr size_t WS_MIX = 304 * MiB;
constexpr size_t WS_SSQA = 368 * MiB, WS_SSQS = 369 * MiB, WS_SSQ2P = 370 * MiB, WS_MAXP = 372 * MiB, WS_HINV = 374 * MiB;
constexpr size_t WS_PA = 144 * MiB;
constexpr size_t WS_COEF = 304 * MiB, WS_COEF0 = 320 * MiB, WS_H8 = 324 * MiB, WS_HS = 356 * MiB;
constexpr size_t WS_EIDX = 376 * MiB, WS_GATE = 392 * MiB, WS_END = 408 * MiB;
constexpr int CW_BAR = 1024;

constexpr int RING_OFF = 0, RING_BYTES = 131072;
constexpr int TAB_OFF = RING_BYTES, TAB_BYTES = 8192;
constexpr int LDSCTL_OFF = 153600, MISC_OFF = LDSCTL_OFF + 64;
constexpr int LDS_BYTES = 155648;
static_assert(MISC_OFF + 128 <= LDS_BYTES, "LDS map");

#define GAS __attribute__((address_space(1)))
#define LAS __attribute__((address_space(3)))
typedef unsigned short bf16;
typedef unsigned v4u __attribute__((ext_vector_type(4)));
typedef unsigned v2u __attribute__((ext_vector_type(2)));
typedef float f32x4 __attribute__((ext_vector_type(4)));
typedef float f32x16 __attribute__((ext_vector_type(16)));
typedef short bf16x8 __attribute__((ext_vector_type(8)));
typedef short s16x4 __attribute__((ext_vector_type(4)));
typedef __bf16 bf16x2_t __attribute__((ext_vector_type(2)));
typedef GAS unsigned gu32;
#define RLX_AGENT __ATOMIC_RELAXED, __HIP_MEMORY_SCOPE_AGENT
#define LDS_WAIT() asm volatile("s_waitcnt lgkmcnt(0)" ::: "memory")
#define VM_WAIT() asm volatile("s_waitcnt vmcnt(0)" ::: "memory")
__device__ __forceinline__ unsigned f2bf(float f) { unsigned u = __builtin_bit_cast(unsigned, f); return (u + 0x7fffu + ((u >> 16) & 1u)) >> 16; }
__device__ __forceinline__ unsigned pk2(float lo, float hi) { return pg8::cvt_pk_bf16(lo, hi); }
__device__ __forceinline__ float bf_lo(unsigned w) { return __builtin_bit_cast(float, w << 16); }
__device__ __forceinline__ float bf_hi(unsigned w) { return __builtin_bit_cast(float, w & 0xffff0000u); }
__device__ __forceinline__ int crow(int r, int hi) { return (r & 3) + 8 * (r >> 2) + 4 * hi; }
#define XB_TMO      128
#define XB_XCNT(j)  (256  + 64 * (j))
#define XB_XSUB(j)  (1280 + 64 * (j))
#define XB_XGEN(j)  (2304 + 64 * (j))
#define XB_TOP      3328
#define XB_TOPGEN   3392
#define XCD_BAR_WORDS 3456
#define XB_SPIN_CAP (1u << 18)

__device__ __forceinline__ unsigned xb_ld(unsigned* p)              { return __hip_atomic_load(p, __ATOMIC_RELAXED, __HIP_MEMORY_SCOPE_AGENT); }
__device__ __forceinline__ unsigned xb_add(unsigned* p, unsigned v) { return __hip_atomic_fetch_add(p, v, __ATOMIC_RELAXED, __HIP_MEMORY_SCOPE_AGENT); }
__device__ __forceinline__ unsigned xb_xcc_id() { return (unsigned)__builtin_amdgcn_s_getreg((3 << 11) | 20) & 0xFu; }
#define XB_SPIN(cond, bar) do { unsigned _sp = 0; while (cond) { __builtin_amdgcn_s_sleep(1); \
    if ((++_sp & 255u) == 0u) { if (xb_ld(&(bar)[XB_TMO])) break; if (_sp > XB_SPIN_CAP) { atomicAdd(&(bar)[XB_TMO], 1u); break; } } } } while (0)

struct XcdBarrier {
    unsigned* bar; unsigned x;
    volatile LAS unsigned* st;
};

__device__ __forceinline__ XcdBarrier xcd_barrier_post(unsigned* bar, volatile LAS unsigned* st) {
    XcdBarrier b; b.bar = bar; b.x = xb_xcc_id(); b.st = st;
    if (threadIdx.x == 0) (void)xb_add(&bar[XB_XCNT(b.x)], 1u);
    return b;
}
__device__ __forceinline__ void xcd_barrier_complete(unsigned* bar, unsigned x, unsigned& nloc, unsigned& nx) {
    const unsigned G = gridDim.x * gridDim.y * gridDim.z;
    unsigned sum, cnt, mine, sp = 0u;
    for (;;) {
        sum = 0u; cnt = 0u; mine = 0u;
#pragma unroll
        for (unsigned j = 0; j < 16; ++j) { const unsigned c = xb_ld(&bar[XB_XCNT(j)]); sum += c; cnt += (c > 0u) ? 1u : 0u; mine = (j == x) ? c : mine; }
        if (sum == G) break;
        __builtin_amdgcn_s_sleep(1);
        if ((++sp & 255u) == 0u) { if (xb_ld(&bar[XB_TMO])) break; if (sp > XB_SPIN_CAP) { atomicAdd(&bar[XB_TMO], 1u); break; } }
    }
    nloc = mine > 0u ? mine : 1u; nx = cnt > 0u ? cnt : 1u;
}

__device__ __forceinline__ void xcd_barrier(const XcdBarrier& b) {
    asm volatile("s_waitcnt vmcnt(0)" ::: "memory");
    __syncthreads();
    if (threadIdx.x == 0) {
        unsigned* bar = b.bar;
        __builtin_amdgcn_s_waitcnt(0);
        unsigned nloc = b.st[0], nx = b.st[1];
        if (nloc == 0u) { xcd_barrier_complete(bar, b.x, nloc, nx); b.st[0] = nloc; b.st[1] = nx; }
        const unsigned old = xb_add(&bar[XB_XSUB(b.x)], 1u);
        const unsigned gen = old / nloc;
        if (old + 1u == (gen + 1u) * nloc) {
            __builtin_amdgcn_fence(__ATOMIC_RELEASE, "agent");
            asm volatile("s_waitcnt vmcnt(0)" ::: "memory");
            const unsigned og = xb_add(&bar[XB_TOP], 1u);
            const unsigned tg = og / nx;
            if (og + 1u == (tg + 1u) * nx) xb_add(&bar[XB_TOPGEN], 1u);
            else XB_SPIN(xb_ld(&bar[XB_TOPGEN]) == tg, bar);
            __builtin_amdgcn_fence(__ATOMIC_ACQUIRE, "agent");
            xb_add(&bar[XB_XGEN(b.x)], 1u);
            asm volatile("s_waitcnt vmcnt(0)" ::: "memory");
        } else {
            XB_SPIN(xb_ld(&bar[XB_XGEN(b.x)]) == gen, bar);
            __builtin_amdgcn_fence(__ATOMIC_ACQUIRE, "agent");
            asm volatile("s_waitcnt vmcnt(0)" ::: "memory");
        }
    }
    __syncthreads();
}

struct Frame {
    LAS unsigned char* lds;
    volatile LAS unsigned* MISC;
    gu32* ctl;
    int tid, lane, wave;
    int vcu, G;
    unsigned char* ws;
    const float *x, *norm1_g, *w_in, *q_norm_g, *k_norm_g, *sgu_norm_g, *sgu_w, *sgu_b, *attn_out_g, *sgu_out_g, *w_out, *norm2_g, *w_query, *sub_keys, *expert_u, *expert_v;
    float* out;
    bf16 *Win_t, *Wout_t, *Wq_t, *SK, *SGUW, *XB, *Q, *QP, *MIX;
    float *RSTD1, *SSQA, *SSQS, *SSQ2P, *GATE, *HS, *CS, *MAXP, *HINV;
    signed char *U8, *H8, *V8; int* PA; unsigned* CQ;
    unsigned short* EIDX;
};

__device__ __forceinline__ float wave_sum(float v) {
#pragma unroll
    for (int o = 1; o < 64; o <<= 1) v += __shfl_xor(v, o);
    return v;
}

__device__ __forceinline__ void p0_transpose_item(const float* W, int K, int N, bf16* WT, const float* gain_a, const float* gain_b, int gsplit, LAS float* scr, int item, int lane, bool permute) {
    const int nblk = N / 32, kb = item / nblk, nb = item % nblk, k0 = 64 * kb, n0 = 32 * nb;
#pragma unroll 8
    for (int i = 0; i < 32; ++i) { const int kk = 2 * i + (lane >> 5); const int k = k0 + kk; const float gv = (k < gsplit) ? gain_a[k] : gain_b[k - gsplit];
        scr[kk * 33 + (lane & 31)] = __builtin_nontemporal_load((const GAS float*)(W + (size_t)k * N + n0 + (lane & 31))) * gv; }
    LDS_WAIT(); asm volatile("" ::: "memory");
    int orow0 = n0;
    if (permute) { const int l = n0 & 255; orow0 = (n0 & ~255) + 128 * ((l >> 5) & 1) + 32 * (l >> 6); }
    const int c = lane & 7;
#pragma unroll
    for (int j = 0; j < 4; ++j) { const int n = (lane >> 3) + 8 * j; const LAS float* s = scr + (8 * c) * 33 + n;
        v4u o; o.x = pk2(s[0 * 33], s[1 * 33]); o.y = pk2(s[2 * 33], s[3 * 33]); o.z = pk2(s[4 * 33], s[5 * 33]); o.w = pk2(s[6 * 33], s[7 * 33]);
        *(GAS v4u*)(WT + (size_t)(orow0 + n) * K + k0 + 8 * c) = o; }
    LDS_WAIT(); asm volatile("" ::: "memory");
}

__device__ __forceinline__ float row_to_bf16(const float* src, bf16* dst, const float* gain, int lane) {
    float ss = 0.f;
    f32x4 v[4];
#pragma unroll
    for (int j = 0; j < 4; ++j) v[j] = __builtin_nontemporal_load((const GAS f32x4*)(src + 4 * lane + 256 * j));
#pragma unroll
    for (int j = 0; j < 4; ++j) {
        f32x4 a = v[j];
        ss += (a[0] * a[0] + a[1] * a[1]) + (a[2] * a[2] + a[3] * a[3]);
        if (gain) a = a * *(const GAS f32x4*)(gain + 4 * lane + 256 * j);
        v2u o; o.x = pk2(a[0], a[1]); o.y = pk2(a[2], a[3]);
        *(GAS v2u*)(dst + 4 * lane + 256 * j) = o;
    }
    return ss;
}

__device__ __forceinline__ void p0_prologue(Frame& F) {
    LAS float* scr = (LAS float*)(F.lds + RING_OFF + F.wave * 16384);
    const int gw = F.vcu * NWAVES + F.wave, NGW = F.G * NWAVES;
    constexpr int I_IN = (DM / 64) * (INW / 32), I_OUT = (DM / 64) * (DM / 32), I_Q = (DM / 64) * (QPW / 32);
    for (int it = gw; it < I_IN + I_OUT + I_Q; it += NGW) {
        int r = it;
        if (r < I_IN) { p0_transpose_item(F.w_in, DM, INW, F.Win_t, F.norm1_g, F.norm1_g, DM, scr, r, F.lane, true); continue; } r -= I_IN;
        if (r < I_OUT) { p0_transpose_item(F.w_out, DM, DM, F.Wout_t, F.attn_out_g, F.sgu_out_g, AW, scr, r, F.lane, false); continue; } r -= I_OUT;
        p0_transpose_item(F.w_query, DM, QPW, F.Wq_t, F.norm2_g, F.norm2_g, DM, scr, r, F.lane, false);
    }
    for (int m = 2 * gw; m < TOK; m += 2 * NGW) {
        const float s0 = row_to_bf16(F.x + (size_t)m * DM, F.XB + (size_t)m * DM, nullptr, F.lane);
        const float s1 = row_to_bf16(F.x + (size_t)(m + 1) * DM, F.XB + (size_t)(m + 1) * DM, nullptr, F.lane);
        const float ss0 = wave_sum(s0), ss1 = wave_sum(s1);
        if (F.lane == 0) { F.RSTD1[m] = 1.0f / sqrtf(ss0 * (1.0f / DM) + pg8::EPS_F); F.RSTD1[m + 1] = 1.0f / sqrtf(ss1 * (1.0f / DM) + pg8::EPS_F); }
    }
    for (int e0 = 2 * gw; e0 < 2 * NEXP; e0 += 2 * NGW) {
        const bool isu = e0 < NEXP; const int r0 = isu ? e0 : e0 - NEXP;
        f32x4 v[2][4]; float mx[2] = {0.f, 0.f};
#pragma unroll
        for (int b = 0; b < 2; ++b) {
            const float* src = (isu ? F.expert_u : F.expert_v) + (size_t)(r0 + b) * DM + 4 * F.lane;
#pragma unroll
            for (int q = 0; q < 4; ++q) v[b][q] = __builtin_nontemporal_load((const GAS f32x4*)(src + 256 * q));
        }
#pragma unroll
        for (int b = 0; b < 2; ++b) {
#pragma unroll
            for (int q = 0; q < 4; ++q) { if (isu) v[b][q] = v[b][q] * *(const GAS f32x4*)(F.norm2_g + 4 * F.lane + 256 * q);
                mx[b] = fmaxf(mx[b], fmaxf(fmaxf(fabsf(v[b][q][0]), fabsf(v[b][q][1])), fmaxf(fabsf(v[b][q][2]), fabsf(v[b][q][3])))); }
#pragma unroll
            for (int o = 1; o < 64; o <<= 1) mx[b] = fmaxf(mx[b], __shfl_xor(mx[b], o));
            const float sc = fmaxf(mx[b], 1e-30f) * (1.0f / 127.0f), inv = 1.0f / sc; const int r = r0 + b;
            signed char* tab = isu ? F.U8 : F.V8;
#pragma unroll
            for (int q = 0; q < 4; ++q) { const int b0 = (int)rintf(v[b][q][0] * inv), b1 = (int)rintf(v[b][q][1] * inv), b2 = (int)rintf(v[b][q][2] * inv), b3 = (int)rintf(v[b][q][3] * inv);
                const unsigned o = (unsigned)(b0 & 0xff) | ((unsigned)(b1 & 0xff) << 8) | ((unsigned)(b2 & 0xff) << 16) | ((unsigned)(b3 & 0xff) << 24);
                *(GAS unsigned*)(tab + ((size_t)(2 * q + (F.lane >> 5)) * NEXP + r) * 128 + 4 * (F.lane & 31)) = o; }
            if (F.lane == 0) { float* scp = (float*)(F.ws + (isu ? WS_SCU : WS_SCV)); scp[r] = sc; }
        }
    }
    const int gt = F.vcu * NWAVES * 64 + F.tid, NGT = F.G * NWAVES * 64;
    for (int i = gt; i < 8 * 128 * 128; i += NGT) { const int g = i >> 14, t = (i >> 7) & 127, s = i & 127;
        const int o = ((((g * 4 + (t >> 5)) * 8 + (s >> 4)) * 64) + 32 * ((s >> 3) & 1) + (t & 31)) * 8 + (s & 7);
        F.SGUW[o] = (bf16)f2bf(s <= t ? F.sgu_w[i] : 0.f); }
    for (int i = gt; i < 2 * 128 * 128; i += NGT) F.SK[i] = (bf16)f2bf(F.sub_keys[i]);
}

constexpr int AT_OPITCH = 136;
constexpr int AT_OACC = 0, AT_LACC = 512 * AT_OPITCH, AT_VS = AT_LACC + 2048, AT_VS_WAVE = 32 * 128;
constexpr int AT_KS = AT_VS + NWAVES * AT_VS_WAVE, AT_KS_WAVE = 32 * 128;
static_assert(AT_KS + NWAVES * AT_KS_WAVE <= LDSCTL_OFF, "attention LDS");
__device__ __forceinline__ int at_rowmap(int p) { return (p & ~15) | ((p ^ (p >> 4)) & 15); }
__device__ __forceinline__ s16x4 vtr(const LAS unsigned char* p) { typedef short v4i16_t __attribute__((ext_vector_type(4))); return __builtin_bit_cast(s16x4, __builtin_amdgcn_ds_read_tr16_b64_v4i16((LAS v4i16_t*)p)); }

struct AtDesc { int b, h, span, dil, res, a; };
__device__ __forceinline__ AtDesc at_desc(int u, int stage, int tsk) {
    AtDesc d; const int bh = u >> 3; d.b = bh >> 3; d.h = bh & 7; d.span = u & 7;
    if (stage == 0) { d.dil = 16; d.res = tsk; d.a = d.span; }
    else if (stage == 1) { d.dil = 4; d.res = tsk & 3; d.a = 4 * d.span + (tsk >> 2); }
    else { d.dil = 1; d.res = 0; d.a = 16 * d.span + tsk; }
    return d;
}
__device__ __forceinline__ void at_dma(LAS unsigned char* ks, LAS unsigned char* vs, const char* kptr, const char* vptr, size_t vrow8) {
#pragma unroll
    for (int it = 0; it < 4; ++it) __builtin_amdgcn_global_load_lds((const unsigned*)(kptr + it * vrow8), (LAS unsigned*)(ks + it * 1024), 16, 0, 0);
#pragma unroll
    for (int it = 0; it < 4; ++it) __builtin_amdgcn_global_load_lds((const unsigned*)(vptr + it * vrow8), (LAS unsigned*)(vs + it * 1024), 16, 0, 0);
}
__device__ __forceinline__ size_t at_koff(int lane, int h) { return (size_t)h * 128 + (size_t)((((lane & 7) ^ (lane >> 3)) & 7) << 4); }
__device__ __forceinline__ size_t at_voff(int lane, int h) { return (size_t)h * 128 + (size_t)(((lane & 7) ^ (((lane >> 4) & 1) << 2)) << 4); }
__device__ __forceinline__ void at_start(Frame& F, const AtDesc& d, bf16x8 (&qn)[4]) {
    const int lane = F.lane, r32 = lane & 31, hi = lane >> 5;
    const int c0 = (d.a >= 4) ? 0 : 4 - d.a;
    const size_t krow = (size_t)d.b * SEQ + d.res + (size_t)d.dil * (32 * (d.a - 4 + c0) + (lane >> 3));
    const char* kp = (const char*)(F.Q + WS_TYPE_STRIDE / 2) + krow * 1024; const char* vp = (const char*)(F.Q + 2 * (WS_TYPE_STRIDE / 2)) + krow * 1024;
    at_dma(F.lds + AT_KS + F.wave * AT_KS_WAVE, F.lds + AT_VS + F.wave * AT_VS_WAVE, kp + at_koff(lane, d.h), vp + at_voff(lane, d.h), (size_t)d.dil * 8 * 1024);
    const size_t qrow = (size_t)d.b * SEQ + d.res + (size_t)d.dil * (32 * d.a + r32);
    const bf16* qp = F.Q + qrow * 512 + d.h * 64 + hi * 8;
#pragma unroll
    for (int d0 = 0; d0 < 4; ++d0) qn[d0] = *(const GAS bf16x8*)(qp + 16 * d0);
}

template <int STAGE>
__device__ __forceinline__ void attn_task(Frame& F, const AtDesc& d, float sl, float mlog2, bf16x8 (&qn)[4], const AtDesc& nd) {
    const int lane = F.lane, r32 = lane & 31, hi = lane >> 5;
    const int b = d.b, h = d.h, span = d.span, dil = d.dil, res = d.res, a = d.a;
    const size_t tokbase = (size_t)b * SEQ;
    LAS unsigned char* vs = F.lds + AT_VS + F.wave * AT_VS_WAVE;
    LAS unsigned char* ks = F.lds + AT_KS + F.wave * AT_KS_WAVE;
    const int posq = res + dil * (32 * a + r32);
    bf16x8 qf[4];
#pragma unroll
    for (int d0 = 0; d0 < 4; ++d0) qf[d0] = qn[d0];
    f32x16 o[2]; o[0] = f32x16{}; o[1] = f32x16{};
    float lsum = 0.f;
    const float base_i = -sl * (float)(128 + r32) - mlog2 + sl * (float)(4 * hi);
    const int G = lane >> 4, gi = lane & 15, gq4 = gi >> 2, gp = gi & 3;
    const int c0 = (a >= 4) ? 0 : 4 - a;
    const size_t cstride = (size_t)dil * 32 * 1024, vrow8 = (size_t)dil * 8 * 1024;
    const size_t krow1 = tokbase + res + (size_t)dil * (32 * (a - 3 + c0) + (lane >> 3));
    const char* kptr = (const char*)(F.Q + WS_TYPE_STRIDE / 2) + krow1 * 1024 + at_koff(lane, h);
    const char* vptr = (const char*)(F.Q + 2 * (WS_TYPE_STRIDE / 2)) + krow1 * 1024 + at_voff(lane, h);
    bf16x8 kf[4], va[2][2];
#define AT_TOP() do { \
        asm volatile("s_waitcnt vmcnt(0)" ::: "memory"); \
        _Pragma("unroll") for (int d0 = 0; d0 < 4; ++d0) kf[d0] = *(const LAS bf16x8*)(ks + r32 * 128 + (((2 * d0 + hi) ^ (r32 & 7)) << 4)); \
          \
        _Pragma("unroll") for (int d0 = 0; d0 < 2; ++d0) \
            _Pragma("unroll") for (int ks_ = 0; ks_ < 2; ++ks_) { \
                const LAS unsigned char* pa = vs + (16 * ks_ + 4 * (G >> 1) + gq4) * 128 + ((64 * d0 + 32 * (G & 1) + 8 * gp) ^ (((gq4 >> 1) & 1) << 6)); \
                const s16x4 lo = vtr(pa), hi4 = vtr(pa + 8 * 128); \
                va[d0][ks_] = (bf16x8){lo[0], lo[1], lo[2], lo[3], hi4[0], hi4[1], hi4[2], hi4[3]}; } \
        LDS_WAIT(); } while (0)
#define AT_MATH(c) do { \
        f32x16 s; \
        const float bc = base_i + sl * (float)(32 * (c)); \
        _Pragma("unroll") for (int r = 0; r < 16; ++r) s[r] = bc + sl * (float)((r & 3) + 8 * (r >> 2)); \
        _Pragma("unroll") for (int d0 = 0; d0 < 4; ++d0) s = __builtin_amdgcn_mfma_f32_32x32x16_bf16(kf[d0], qf[d0], s, 0, 0, 0); \
          \
        const int dbase = 128 - 32 * (c) + r32 - 4 * hi; \
        if (((c) == 0) || ((c) == 4)) { \
            _Pragma("unroll") for (int r = 0; r < 16; ++r) { float p = __builtin_amdgcn_exp2f(s[r]); p = ((unsigned)(dbase - ((r & 3) + 8 * (r >> 2))) <= 128u) ? p : 0.f; s[r] = p; lsum += p; } \
        } else { \
            _Pragma("unroll") for (int r = 0; r < 16; ++r) { const float p = __builtin_amdgcn_exp2f(s[r]); s[r] = p; lsum += p; } \
        } \
        bf16x8 pb[2]; \
        _Pragma("unroll") for (int ks_ = 0; ks_ < 2; ++ks_) { v4u w; w.x = pk2(s[8 * ks_ + 0], s[8 * ks_ + 1]); w.y = pk2(s[8 * ks_ + 2], s[8 * ks_ + 3]); w.z = pk2(s[8 * ks_ + 4], s[8 * ks_ + 5]); w.w = pk2(s[8 * ks_ + 6], s[8 * ks_ + 7]); pb[ks_] = __builtin_bit_cast(bf16x8, w); } \
          \
        _Pragma("unroll") for (int d0 = 0; d0 < 2; ++d0) \
            _Pragma("unroll") for (int ks_ = 0; ks_ < 2; ++ks_) o[d0] = __builtin_amdgcn_mfma_f32_32x32x16_bf16(va[d0][ks_], pb[ks_], o[d0], 0, 0, 0); \
    } while (0)
#pragma unroll 1
    for (int c = c0; c < 4; ++c) {
        AT_TOP();
        at_dma(ks, vs, kptr, vptr, vrow8); kptr += cstride; vptr += cstride;
        AT_MATH(c);
    }
    AT_TOP();
    at_start(F, nd, qn);
    AT_MATH(4);
#undef AT_MATH
#undef AT_TOP
    lsum += __shfl_xor(lsum, 32);
    const int pl = posq - span * 512;
    LAS unsigned char* orow = F.lds + AT_OACC + at_rowmap(pl) * AT_OPITCH;
    LAS float* lacc = (LAS float*)(F.lds + AT_LACC);
    if (STAGE > 0) {
        lsum += lacc[pl];
#pragma unroll
        for (int d0 = 0; d0 < 2; ++d0)
#pragma unroll
            for (int g4 = 0; g4 < 4; ++g4) { const v2u w = *(LAS v2u*)(orow + (32 * d0 + 8 * g4 + 4 * hi) * 2);
                o[d0][4 * g4 + 0] += bf_lo(w.x); o[d0][4 * g4 + 1] += bf_hi(w.x); o[d0][4 * g4 + 2] += bf_lo(w.y); o[d0][4 * g4 + 3] += bf_hi(w.y); }
    }
    if (STAGE < 2) {
        if (hi == 0) lacc[pl] = lsum;
#pragma unroll
        for (int d0 = 0; d0 < 2; ++d0)
#pragma unroll
            for (int g4 = 0; g4 < 4; ++g4) { v2u w; w.x = pk2(o[d0][4 * g4 + 0], o[d0][4 * g4 + 1]); w.y = pk2(o[d0][4 * g4 + 2], o[d0][4 * g4 + 3]);
                *(LAS v2u*)(orow + (32 * d0 + 8 * g4 + 4 * hi) * 2) = w; }
    } else {
        const float inv = 1.0f / lsum;
        float ss = 0.f;
#pragma unroll
        for (int d0 = 0; d0 < 2; ++d0)
#pragma unroll
            for (int g4 = 0; g4 < 4; ++g4) { const float a0 = o[d0][4 * g4 + 0] * inv, a1 = o[d0][4 * g4 + 1] * inv, a2 = o[d0][4 * g4 + 2] * inv, a3 = o[d0][4 * g4 + 3] * inv;
                ss += (a0 * a0 + a1 * a1) + (a2 * a2 + a3 * a3);
                v2u w; w.x = pk2(a0, a1); w.y = pk2(a2, a3);
                *(LAS v2u*)(orow + (32 * d0 + 8 * g4 + 4 * hi) * 2) = w; }
        ss += __shfl_xor(ss, 32);
        if (hi == 0) F.SSQA[(tokbase + posq) * 8 + h] = ss;
        LDS_WAIT(); asm volatile("" ::: "memory");
#pragma unroll
        for (int it = 0; it < 4; ++it) { const int row = (lane >> 3) + 8 * it;
            const LAS unsigned char* src = F.lds + AT_OACC + at_rowmap(res + dil * (32 * a + row) - span * 512) * AT_OPITCH + (lane & 7) * 16;
            const v2u lo = *(const LAS v2u*)src, hi2 = *(const LAS v2u*)(src + 8);
            v4u ov; ov.x = lo.x; ov.y = lo.y; ov.z = hi2.x; ov.w = hi2.y;
            *(GAS v4u*)(F.MIX + (tokbase + res + (size_t)dil * (32 * a + row)) * 1024 + h * 64 + (lane & 7) * 8) = ov; }
        LDS_WAIT(); asm volatile("" ::: "memory");
    }
}

__device__ __forceinline__ void attn_unit(Frame& F, int u, int un, float mlog2, bf16x8 (&qn)[4]) {
    const int h = (u >> 3) & 7;
    const float slope = __builtin_amdgcn_exp2f(-(float)(h + 1)) * 1.4426950408889634f;
    const int w = F.wave;
#pragma unroll 1
    for (int k = 0; k < 2; ++k) attn_task<0>(F, at_desc(u, 0, 2 * w + k), slope * 16.f, mlog2, qn, at_desc(u, k, k ? 2 * w : 2 * w + 1));
    LDS_WAIT(); __syncthreads();
#pragma unroll 1
    for (int k = 0; k < 2; ++k) attn_task<1>(F, at_desc(u, 1, 2 * w + k), slope * 4.f, mlog2, qn, at_desc(u, 1 + k, k ? 2 * w : 2 * w + 1));
    LDS_WAIT(); __syncthreads();
#pragma unroll 1
    for (int k = 0; k < 2; ++k) attn_task<2>(F, at_desc(u, 2, 2 * w + k), slope, mlog2, qn, k ? at_desc(un, 0, 2 * w) : at_desc(u, 2, 2 * w + 1));
    LDS_WAIT(); __syncthreads();
}

constexpr int SG_PITCH = 192, SG_TILE = 128 * SG_PITCH;
static_assert(4 * SG_TILE <= RING_BYTES, "SGU LDS");
struct SguPre { v4u tile[4]; bf16x8 wb[8]; v4u sul[4]; float bias; };
constexpr int SG_SU_OFF = 4 * SG_TILE, SG_SU_WAVE = 32 * 144;
static_assert(SG_SU_OFF + NWAVES * SG_SU_WAVE <= LDSCTL_OFF, "SGU LDS");
__device__ __forceinline__ void sgu_load(Frame& F, int u, SguPre& p) {
    const int gp = u & 3, ch = (u >> 2) & 31, b = u >> 7;
    const int lane = F.lane, r32 = lane & 31, hi = lane >> 5, w = F.wave, gsel = w >> 2, tb = w & 3, g = 2 * gp + gsel, t = 32 * tb + r32;
    const size_t tok0 = (size_t)b * SEQ + (size_t)ch * 128;
    const bf16* SVN = F.Q + 4 * (WS_TYPE_STRIDE / 2); const bf16* SU = F.Q + 3 * (WS_TYPE_STRIDE / 2);
#pragma unroll
    for (int gg = 0; gg < 2; ++gg)
#pragma unroll
        for (int it = 0; it < 2; ++it) { const int idx = F.tid + 512 * it, s_ = idx >> 3, c8 = idx & 7;
            p.tile[2 * gg + it] = __builtin_nontemporal_load((const GAS v4u*)(SVN + (tok0 + s_) * 512 + (2 * gp + gg) * 64 + c8 * 8)); }
    const bf16* Wg = F.SGUW + ((size_t)(g * 4 + tb) * 8 * 64 + lane) * 8;
#pragma unroll
    for (int ks = 0; ks < 8; ++ks) p.wb[ks] = *(const GAS bf16x8*)(Wg + ks * 512);
    p.bias = F.sgu_b[g * 128 + t];
#pragma unroll
    for (int i = 0; i < 4; ++i) p.sul[i] = __builtin_nontemporal_load((const GAS v4u*)(SU + (tok0 + 32 * tb + (lane >> 3) + 8 * i) * 512 + g * 64 + (lane & 7) * 8));
}
__device__ __forceinline__ void sgu_phase(Frame& F) {
    const int lane = F.lane, r32 = lane & 31, hi = lane >> 5, w = F.wave, gsel = w >> 2, tb = w & 3, t = 32 * tb + r32;
    const int G = lane >> 4, gi = lane & 15, gq4 = gi >> 2, gpp = gi & 3;
    constexpr int NU = BATCH * 32 * 4;
    int u = F.vcu; if (u >= NU) return;
    SguPre pre; sgu_load(F, u, pre);
    for (int it_ = 0; u < NU; u += F.G, ++it_) {
        LAS unsigned char* buf = F.lds + (it_ & 1) * (2 * SG_TILE);
#pragma unroll
        for (int gg = 0; gg < 2; ++gg)
#pragma unroll
            for (int it = 0; it < 2; ++it) { const int idx = F.tid + 512 * it, s_ = idx >> 3, c8 = idx & 7; *(LAS v4u*)(buf + gg * SG_TILE + s_ * SG_PITCH + c8 * 16) = pre.tile[2 * gg + it]; }
        bf16x8 wb[8]; const float bias = pre.bias;
#pragma unroll
        for (int i = 0; i < 8; ++i) wb[i] = pre.wb[i];
        LAS unsigned char* sus = F.lds + SG_SU_OFF + w * SG_SU_WAVE;
#pragma unroll
        for (int i = 0; i < 4; ++i) *(LAS v4u*)(sus + ((lane >> 3) + 8 * i) * 144 + (lane & 7) * 16) = pre.sul[i];
        LDS_WAIT(); __syncthreads();
        const int un = (u + F.G < NU) ? u + F.G : u;
        sgu_load(F, un, pre);
        const int gp = u & 3, ch = (u >> 2) & 31, b = u >> 7, g = 2 * gp + gsel;
        const size_t tok0 = (size_t)b * SEQ + (size_t)ch * 128;
        const LAS unsigned char* ts = buf + gsel * SG_TILE;
        f32x16 acc[2]; acc[0] = f32x16{}; acc[1] = f32x16{};
#pragma unroll
        for (int ks = 0; ks < 8; ++ks) {
#pragma unroll
            for (int eb = 0; eb < 2; ++eb) {
                const LAS unsigned char* pa = ts + (16 * ks + 8 * (G >> 1) + gq4) * SG_PITCH + (32 * eb + 16 * (G & 1) + 4 * gpp) * 2;
                const s16x4 lo = vtr(pa), hi4 = vtr(pa + 4 * SG_PITCH);
                const bf16x8 va = (bf16x8){lo[0], lo[1], lo[2], lo[3], hi4[0], hi4[1], hi4[2], hi4[3]};
                acc[eb] = __builtin_amdgcn_mfma_f32_32x32x16_bf16(va, wb[ks], acc[eb], 0, 0, 0);
            }
        }
        float ss = 0.f;
#pragma unroll
        for (int eb = 0; eb < 2; ++eb)
#pragma unroll
            for (int g4 = 0; g4 < 4; ++g4) { const int e = 32 * eb + 8 * g4 + 4 * hi;
                const v2u sw = *(const LAS v2u*)(sus + r32 * 144 + e * 2);
                const float a0 = bf_lo(sw.x) * (acc[eb][4 * g4 + 0] + bias), a1 = bf_hi(sw.x) * (acc[eb][4 * g4 + 1] + bias), a2 = bf_lo(sw.y) * (acc[eb][4 * g4 + 2] + bias), a3 = bf_hi(sw.y) * (acc[eb][4 * g4 + 3] + bias);
                ss += (a0 * a0 + a1 * a1) + (a2 * a2 + a3 * a3);
                v2u wv; wv.x = pk2(a0, a1); wv.y = pk2(a2, a3); *(LAS v2u*)(sus + r32 * 144 + e * 2) = wv; }
        ss += __shfl_xor(ss, 32);
        if (hi == 0) F.SSQS[(tok0 + t) * 8 + g] = ss;
        LDS_WAIT(); asm volatile("" ::: "memory");
#pragma unroll
        for (int i = 0; i < 4; ++i) { const int row = (lane >> 3) + 8 * i; const v4u ov = *(const LAS v4u*)(sus + row * 144 + (lane & 7) * 16);
            *(GAS v4u*)(F.MIX + (tok0 + 32 * tb + row) * 1024 + 512 + g * 64 + (lane & 7) * 8) = ov; }
        LDS_WAIT(); asm volatile("" ::: "memory");
    }
    LDS_WAIT(); __syncthreads();
}

#ifndef P2_VARIANT
#define P2_VARIANT 0
#endif
__device__ __forceinline__ void p2_mixers(Frame& F) {
    float mq = fabsf(F.q_norm_g[F.lane]), mk = fabsf(F.k_norm_g[F.lane]);
#pragma unroll
    for (int o = 1; o < 64; o <<= 1) { mq = fmaxf(mq, __shfl_xor(mq, o)); mk = fmaxf(mk, __shfl_xor(mk, o)); }
    const float mlog2 = 8.0f * mq * mk * 1.4426950408889634f;
    {
        constexpr int NU = BATCH * 8 * 8;
        bf16x8 qn[4];
        if (F.vcu < NU) at_start(F, at_desc(F.vcu, 0, 2 * F.wave), qn);
#pragma unroll 1
        for (int u = F.vcu; u < NU; u += F.G) attn_unit(F, u, (u + F.G < NU) ? u + F.G : u, mlog2, qn);
        asm volatile("s_waitcnt vmcnt(0)" ::: "memory"); __syncthreads();
    }
#pragma unroll 1
    for (int rep = 0; rep < (P2_VARIANT == 2 ? 2 : 1); ++rep)
    sgu_phase(F);
}

__device__ __forceinline__ unsigned f2ord(float f) { const unsigned u = __builtin_bit_cast(unsigned, f); return u ^ ((unsigned)((int)u >> 31) | 0x80000000u); }
__device__ __forceinline__ float ord2f(unsigned k) { const unsigned u = (k & 0x80000000u) ? (k ^ 0x80000000u) : ~k; return __builtin_bit_cast(float, u); }
#define CE_DESC(a, b) do { const unsigned _mx = max((a), (b)), _mn = min((a), (b)); (a) = _mx; (b) = _mn; } while (0)
__device__ __forceinline__ void sort16(unsigned (&k)[16]) {
#pragma unroll
    for (int k2 = 2; k2 <= 16; k2 <<= 1)
#pragma unroll
        for (int j = k2 >> 1; j > 0; j >>= 1)
#pragma unroll
            for (int i = 0; i < 16; ++i) { const int l = i ^ j; if (l > i) { if ((i & k2) == 0) CE_DESC(k[i], k[l]); else CE_DESC(k[l], k[i]); } }
}
__device__ __forceinline__ void merge16(unsigned (&a)[16], const unsigned (&b)[16]) {
#pragma unroll
    for (int i = 0; i < 16; ++i) a[i] = max(a[i], b[15 - i]);
#pragma unroll
    for (int j = 8; j > 0; j >>= 1)
#pragma unroll
        for (int i = 0; i < 16; ++i) { const int l = i ^ j; if (l > i) CE_DESC(a[i], a[l]); }
}
__device__ __forceinline__ void swap16(const unsigned (&x)[16], const unsigned (&y)[16], unsigned (&xo)[16], unsigned (&yo)[16]) {
#pragma unroll
    for (int i = 0; i < 16; ++i) { auto rr = __builtin_amdgcn_permlane32_swap(x[i], y[i], false, false); xo[i] = rr[0]; yo[i] = rr[1]; }
}

__host__ __device__ constexpr int cand0(int q) { return q < 16 ? q : q < 21 ? 0x20 + (q - 16) : q < 24 ? 0x40 + (q - 21) : q < 26 ? 0x60 + (q - 24) : q == 26 ? 0x80 : q == 27 ? 0xa0 : q == 28 ? 0xc0 : q == 29 ? 0xe0 : 0xff; }
__host__ __device__ constexpr int cand1(int q) { return q < 8 ? 0x10 + q : q < 12 ? 0x30 + (q - 8) : q < 14 ? 0x50 + (q - 12) : q < 16 ? 0x70 + (q - 14) : q == 16 ? 0x90 : q == 17 ? 0xb0 : q == 18 ? 0xd0 : q == 19 ? 0xf0 : 0xff; }

constexpr int TK_SK_BYTES = 2 * 128 * 256;
constexpr int TK_LDS_WAVE = 32 * 32 * 4, TK_SCR_OFF = TK_SK_BYTES;
static_assert(TK_SCR_OFF + NWAVES * TK_LDS_WAVE <= RING_BYTES, "top-k LDS");
__device__ __forceinline__ void tk_load_q(Frame& F, size_t t0, int hd, int half, int r32, int hi, bf16x8 (&qf)[8]) {
#pragma unroll
    for (int i = 0; i < 8; ++i) qf[i] = __builtin_nontemporal_load((const GAS bf16x8*)(F.QP + ((((t0 >> 5) * 8 + hd) * 2 + half) * 8 + i) * 512 + (size_t)(32 * hi + r32) * 8));
}
template <int HALF_> __device__ __forceinline__ void half_top16(Frame& F, const bf16x8 (&qf)[8], int r32, int hi, unsigned (&best)[16]) {
#pragma unroll
    for (int nb = 0; nb < 4; ++nb) {
        f32x16 acc;
#pragma unroll
        for (int r = 0; r < 16; ++r) acc[r] = 64.0f;
        const int row = HALF_ * 128 + 32 * nb + r32;
#pragma unroll
        for (int ks = 0; ks < 8; ++ks) { const bf16x8 a = *(const LAS bf16x8*)(F.lds + row * 256 + (((2 * ks + hi) ^ (row & 15)) << 4));
            acc = __builtin_amdgcn_mfma_f32_32x32x16_bf16(a, qf[ks], acc, 0, 0, 0); }
        unsigned k[16];
#pragma unroll
        for (int r = 0; r < 16; ++r) { const int n = 32 * nb + (r & 3) + 8 * (r >> 2) + 4 * hi; k[r] = (__builtin_bit_cast(unsigned, __builtin_amdgcn_fmed3f(acc[r], 4.0f, 124.0f)) & ~127u) | (unsigned)(127 - n); }
        sort16(k);
        if (nb == 0) {
#pragma unroll
            for (int i = 0; i < 16; ++i) best[i] = k[i];
        } else merge16(best, k);
    }
}

__device__ __forceinline__ void topk_task(Frame& F, int tb, int hd, bf16x8 (&qa)[8], bool has_next, int tb_next, int hd_next) {
    const int lane = F.lane, r32 = lane & 31, hi = lane >> 5;
    const size_t t0 = (size_t)tb * 32;
    unsigned bk[2][16];
    bf16x8 qb[8];
    tk_load_q(F, t0, hd, 1, r32, hi, qb);
    half_top16<0>(F, qa, r32, hi, bk[0]);
    if (has_next) tk_load_q(F, (size_t)tb_next * 32, hd_next, 0, r32, hi, qa);
    half_top16<1>(F, qb, r32, hi, bk[1]);
    unsigned xa[16], ya[16];
    swap16(bk[0], bk[1], xa, ya);
    merge16(xa, ya);
    unsigned A[16], B[16];
    swap16(xa, xa, A, B);
    LAS unsigned* tk = (LAS unsigned*)(F.lds + TK_SCR_OFF + F.wave * TK_LDS_WAVE) + r32 * 32;
#pragma unroll
    for (int i = 0; i < 16; ++i) tk[16 * hi + i] = hi ? B[i] : A[i];
    float v1[16], v2[16];
#pragma unroll
    for (int i = 0; i < 16; ++i) { v1[i] = __builtin_bit_cast(float, A[i] & ~127u); v2[i] = __builtin_bit_cast(float, B[i] & ~127u); }
    unsigned c0[16], c1[16];
#pragma unroll
    for (int q = 0; q < 32; ++q) {
        const int ij0 = cand0(q), ij1 = cand1(q);
        const float s0 = (ij0 == 0xff) ? 0.0f : v1[ij0 >> 4] + v2[ij0 & 15];
        const float s1 = (ij1 == 0xff) ? 0.0f : v1[ij1 >> 4] + v2[ij1 & 15];
        const unsigned k0 = (__builtin_bit_cast(unsigned, s0) & ~255u) | (unsigned)(ij0 & 255), k1 = (__builtin_bit_cast(unsigned, s1) & ~255u) | (unsigned)(ij1 & 255);
        const unsigned kk = hi ? k1 : k0;
        if (q < 16) c0[q] = kk; else c1[q - 16] = kk;
    }
    sort16(c0); sort16(c1); merge16(c0, c1);
    unsigned L0[16], L1[16];
    swap16(c0, c0, L0, L1);
    merge16(L0, L1);
    const float mx = __builtin_bit_cast(float, L0[0] & ~255u);
    float ex[16], den = 0.f;
#pragma unroll
    for (int i = 0; i < 16; ++i) { ex[i] = __expf(__builtin_bit_cast(float, L0[i] & ~255u) - mx); den += ex[i]; }
    const float rden = 1.0f / den;
    LDS_WAIT(); asm volatile("" ::: "memory");
    int ei[8]; float gt[8];
#pragma unroll
    for (int kk = 0; kk < 8; ++kk) {
        const unsigned key = hi ? L0[8 + kk] : L0[kk]; const float e = hi ? ex[8 + kk] : ex[kk];
        const int i = (key >> 4) & 15, j = key & 15;
        const int i1 = 127 - (int)(tk[i] & 127u), i2 = 127 - (int)(tk[16 + j] & 127u);
        ei[kk] = i1 * 128 + i2; gt[kk] = e * rden;
    }
    unsigned short* ep = F.EIDX + (t0 + r32) * 128 + hd * 16 + 8 * hi; float* gp = F.GATE + (t0 + r32) * 128 + hd * 16 + 8 * hi;
    *(GAS v4u*)ep = (v4u){(unsigned)ei[0] | ((unsigned)ei[1] << 16), (unsigned)ei[2] | ((unsigned)ei[3] << 16), (unsigned)ei[4] | ((unsigned)ei[5] << 16), (unsigned)ei[6] | ((unsigned)ei[7] << 16)};
    *(GAS f32x4*)gp = (f32x4){gt[0], gt[1], gt[2], gt[3]}; *(GAS f32x4*)(gp + 4) = (f32x4){gt[4], gt[5], gt[6], gt[7]};
    LDS_WAIT(); asm volatile("" ::: "memory");
}

__device__ __forceinline__ void p5_topk(Frame& F) {
    for (int i = F.tid; i < 2 * 128 * 16; i += NWAVES * 64) { const int row = i >> 4, ch = i & 15;
        *(LAS v4u*)(F.lds + row * 256 + ((ch ^ (row & 15)) << 4)) = *(const GAS v4u*)(F.SK + (size_t)row * 128 + ch * 8); }
    LDS_WAIT(); __syncthreads();
    pg8::StaticOrder S; S.init(TOK, QPW, F.G, (int)blockIdx.x);
    pg8::Unit u, un;
    bf16x8 qf[8];
    bool have = S.next(0, u);
    if (have) tk_load_q(F, (size_t)(u.pm * 8 + F.wave) * 32, u.pn, 0, F.lane & 31, F.lane >> 5, qf);
#pragma unroll 1
    for (int i = 0; have; ++i) {
        const bool hn = S.next(i + 1, un);
        topk_task(F, u.pm * 8 + F.wave, u.pn, qf, hn, un.pm * 8 + F.wave, un.pn);
        u = un; have = hn;
    }
    LDS_WAIT(); __syncthreads();
}

constexpr int PE_TPI = 16, PE_NITEM = TOK / PE_TPI;
constexpr int CW_QA = 8192, CW_QB = 8192 + 8 * 64;

template <int CTRL> __device__ __forceinline__ int dpp_i(int v) { return __builtin_amdgcn_update_dpp(0, v, CTRL, 0xf, 0xf, true); }
template <int CTRL> __device__ __forceinline__ float dpp_f(float v) { return __builtin_bit_cast(float, __builtin_amdgcn_update_dpp(0, __builtin_bit_cast(int, v), CTRL, 0xf, 0xf, true)); }
constexpr int DPP_XOR1 = 0xB1, DPP_XOR2 = 0x4E, DPP_HMIRROR = 0x141, DPP_ROR8 = 0x128;

__device__ __forceinline__ void pe_load_ix(Frame& F, int t, v4u (&ix)[2]) {
    const int gl = F.lane >> 3;
#pragma unroll
    for (int q = 0; q < 2; ++q) ix[q] = *(const GAS v4u*)(F.EIDX + (size_t)t * 128 + gl * 16 + 8 * q);
}
__device__ __forceinline__ void pe_load_rows(const void* TAB, const v4u (&ix)[2], int coloff, v4u (&w)[16]) {
#pragma unroll
    for (int i = 0; i < 16; ++i) { const unsigned pr = ix[i >> 3][(i >> 1) & 3]; const unsigned e = (i & 1) ? (pr >> 16) : (pr & 0xffffu);
        w[i] = *(const GAS v4u*)((const char*)TAB + (size_t)e * 128 + coloff); }
}
__device__ __forceinline__ v4u pe_quant16(const v4u& lo, const v4u& hi, float inv) {
    v4u o;
#pragma unroll
    for (int q = 0; q < 4; ++q) { const unsigned w0 = (q < 2) ? lo[2 * q] : hi[2 * q - 4], w1 = (q < 2) ? lo[2 * q + 1] : hi[2 * q - 3];
        const int b0 = (int)rintf(bf_lo(w0) * inv), b1 = (int)rintf(bf_hi(w0) * inv), b2 = (int)rintf(bf_lo(w1) * inv), b3 = (int)rintf(bf_hi(w1) * inv);
        o[q] = (unsigned)(b0 & 0xff) | ((unsigned)(b1 & 0xff) << 8) | ((unsigned)(b2 & 0xff) << 16) | ((unsigned)(b3 & 0xff) << 24); }
    return o;
}
__device__ __forceinline__ void peA_compute(Frame& F, int* PA, int j, int t, const v4u& hq, const v4u (&w)[16]) {
    const int gl = F.lane >> 3, sub = F.lane & 7;
    int r0 = 0, r1 = 0;
#pragma unroll
    for (int i = 0; i < 16; ++i) {
        int p = __builtin_amdgcn_sdot4((int)w[i].x, (int)hq.x, 0, false);
        p = __builtin_amdgcn_sdot4((int)w[i].y, (int)hq.y, p, false); p = __builtin_amdgcn_sdot4((int)w[i].z, (int)hq.z, p, false); p = __builtin_amdgcn_sdot4((int)w[i].w, (int)hq.w, p, false);
        p += dpp_i<DPP_XOR1>(p); p += dpp_i<DPP_XOR2>(p); p += dpp_i<DPP_HMIRROR>(p);
        if (i < 8) r0 = (sub == i) ? p : r0; else r1 = (sub == i - 8) ? p : r1;
    }
    const unsigned pk = ((unsigned)((r0 + 32) >> 6) & 0xffffu) | ((unsigned)((r1 + 32) >> 6) << 16);
    ((unsigned*)PA)[((size_t)j * TOK + t) * 64 + gl * 8 + sub] = pk;
}
__device__ __forceinline__ void peB_compute(Frame& F, int j, int t, const v4u& cq, float cs, const v4u (&w)[16]) {
    const int lane = F.lane, gl = lane >> 3, sub = lane & 7;
    typedef float f32x2_t __attribute__((ext_vector_type(2)));
    const int mycol = 128 * j + 2 * lane;
    const unsigned xw = *(const GAS unsigned*)(F.XB + (size_t)t * DM + mycol);
    f32x2_t xin; xin.x = bf_lo(xw); xin.y = bf_hi(xw);
    int acc[16];
#pragma unroll
    for (int c = 0; c < 16; ++c) acc[c] = 0;
#pragma unroll
    for (int m = 0; m < 4; ++m)
#pragma unroll
        for (int q = 0; q < 4; ++q) {
            const unsigned a0 = w[4 * m + 0][q], a1 = w[4 * m + 1][q], a2 = w[4 * m + 2][q], a3 = w[4 * m + 3][q];
            const unsigned t0 = __builtin_amdgcn_perm(a1, a0, 0x05010400u), t1 = __builtin_amdgcn_perm(a1, a0, 0x07030602u);
            const unsigned t2 = __builtin_amdgcn_perm(a3, a2, 0x05010400u), t3 = __builtin_amdgcn_perm(a3, a2, 0x07030602u);
            const unsigned o0 = __builtin_amdgcn_perm(t2, t0, 0x05040100u), o1 = __builtin_amdgcn_perm(t2, t0, 0x07060302u);
            const unsigned o2 = __builtin_amdgcn_perm(t3, t1, 0x05040100u), o3 = __builtin_amdgcn_perm(t3, t1, 0x07060302u);
            acc[4 * q + 0] = __builtin_amdgcn_sdot4((int)o0, (int)cq[m], acc[4 * q + 0], false); acc[4 * q + 1] = __builtin_amdgcn_sdot4((int)o1, (int)cq[m], acc[4 * q + 1], false);
            acc[4 * q + 2] = __builtin_amdgcn_sdot4((int)o2, (int)cq[m], acc[4 * q + 2], false); acc[4 * q + 3] = __builtin_amdgcn_sdot4((int)o3, (int)cq[m], acc[4 * q + 3], false);
        }
    int h8v[8];
#pragma unroll
    for (int c = 0; c < 8; ++c) { auto rr = __builtin_amdgcn_permlane32_swap((unsigned)acc[c], (unsigned)acc[c + 8], false, false);
        unsigned r0 = rr[0], r1 = rr[1]; asm volatile("" : "+v"(r0), "+v"(r1));
        h8v[c] = (int)r0 + (int)r1; }
    const bool b4 = (lane >> 4) & 1, b3 = (lane >> 3) & 1;
    int h4[4];
#pragma unroll
    for (int c = 0; c < 4; ++c) { const int keep = b4 ? h8v[c + 4] : h8v[c], give = b4 ? h8v[c] : h8v[c + 4]; h4[c] = keep + __builtin_amdgcn_ds_swizzle(give, 0x401F); }
    int h2[2];
#pragma unroll
    for (int c = 0; c < 2; ++c) { const int keep = b3 ? h4[c + 2] : h4[c], give = b3 ? h4[c] : h4[c + 2]; h2[c] = keep + dpp_i<DPP_ROR8>(give); }
    const int srcl = ((lane >> 3) + 8 * (lane & 1) + 16 * ((lane >> 1) & 1) + 32 * ((lane >> 2) & 1)) * 4;
    const int q0 = __builtin_amdgcn_ds_bpermute(srcl, h2[0]), q1 = __builtin_amdgcn_ds_bpermute(srcl, h2[1]);
    f32x2_t o; o.x = xin.x + cs * (float)q0; o.y = xin.y + cs * (float)q1;
    __builtin_nontemporal_store(o, (GAS f32x2_t*)(F.out + (size_t)t * DM + mycol));
}

template <bool PHASE_B> __device__ __forceinline__ void pe_item(Frame& F, int j, int t0) {
    const int sub = F.lane & 7, gl = F.lane >> 3, coloff = 128 * j + 16 * sub;
    const void* TAB = (const char*)(PHASE_B ? (const void*)F.V8 : (const void*)F.U8) + (size_t)j * NEXP * 128;
    const int rowoff = 16 * sub;
    v4u ixA[2], ixB[2], wA[16], wB[16], auxA, auxB, aux2A = {}, aux2B = {}; float csA = 0.f, csB = 0.f;
#define PE_AUX(t, aux, aux2, cs) do { if (PHASE_B) { aux = *(const GAS v4u*)(F.CQ + (size_t)(t) * 32 + gl * 4); cs = F.CS[t]; } \
        else { aux = *(const GAS v4u*)(F.XB + (size_t)(t) * DM + coloff); aux2 = *(const GAS v4u*)(F.XB + (size_t)(t) * DM + coloff + 8); cs = F.HINV[t]; } } while (0)
#define PE_COMPUTE(t, aux, aux2, cs, w) do { if (PHASE_B) peB_compute(F, j, (t), aux, cs, w); else peA_compute(F, F.PA, j, (t), pe_quant16(aux, aux2, cs), w); } while (0)
    pe_load_ix(F, t0, ixA); pe_load_rows(TAB, ixA, rowoff, wA); PE_AUX(t0, auxA, aux2A, csA); pe_load_ix(F, t0 + 1, ixB);
#pragma unroll 1
    for (int k = 0; k < PE_TPI - 2; k += 2) {
        pe_load_rows(TAB, ixB, rowoff, wB); PE_AUX(t0 + k + 1, auxB, aux2B, csB);
        pe_load_ix(F, t0 + k + 2, ixA);
        PE_COMPUTE(t0 + k, auxA, aux2A, csA, wA);
        pe_load_rows(TAB, ixA, rowoff, wA); PE_AUX(t0 + k + 2, auxA, aux2A, csA); pe_load_ix(F, t0 + k + 3, ixB);
        PE_COMPUTE(t0 + k + 1, auxB, aux2B, csB, wB);
    }
    pe_load_rows(TAB, ixB, rowoff, wB); PE_AUX(t0 + PE_TPI - 1, auxB, aux2B, csB);
    PE_COMPUTE(t0 + PE_TPI - 2, auxA, aux2A, csA, wA);
    PE_COMPUTE(t0 + PE_TPI - 1, auxB, aux2B, csB, wB);
#undef PE_AUX
#undef PE_COMPUTE
}

template <bool PHASE_B> __device__ __forceinline__ void p6_sliced(Frame& F) {
    const unsigned x = xb_xcc_id() & 7u;
    gu32* Q = F.ctl + (PHASE_B ? CW_QB : CW_QA);
    for (unsigned s = 0; s < 8; ++s) {
        const int j = (int)((x + s) & 7u);
        for (;;) {
            unsigned c = 0;
            if (F.lane == 0) c = __hip_atomic_fetch_add((unsigned*)(Q + 64 * j), 1u, __ATOMIC_RELAXED, __HIP_MEMORY_SCOPE_AGENT);
            c = (unsigned)__builtin_amdgcn_readfirstlane((int)c);
            if (c >= (unsigned)PE_NITEM) break;
            pe_item<PHASE_B>(F, j, (int)c * PE_TPI);
        }
    }
}

__device__ __forceinline__ void p6_reduce(Frame& F) {
    const int gw = F.vcu * NWAVES + F.wave, NGW = F.G * NWAVES, lane = F.lane;
    const int p0 = 16 * (lane >> 3) + (lane & 7);
    constexpr int NB = 4;
    for (int tb = gw * NB; tb < TOK; tb += NGW * NB) {
        int s[NB][2], e[NB][2]; float gt[NB][2], hs[NB];
#pragma unroll
        for (int b = 0; b < NB; ++b) {
            const int t = tb + b; hs[b] = F.HS[t];
            int a0 = 0, a1 = 0;
#pragma unroll
            for (int j = 0; j < 8; ++j) { const unsigned w = __builtin_nontemporal_load((const GAS unsigned*)F.PA + ((size_t)j * TOK + t) * 64 + lane); a0 += (int)(short)(w & 0xffffu); a1 += (int)w >> 16; }
            s[b][0] = a0; s[b][1] = a1;
#pragma unroll
            for (int hh = 0; hh < 2; ++hh) { const int p = p0 + 8 * hh; e[b][hh] = (int)F.EIDX[(size_t)t * 128 + p]; gt[b][hh] = F.GATE[(size_t)t * 128 + p]; }
        }
        float su[NB][2], sv[NB][2];
#pragma unroll
        for (int b = 0; b < NB; ++b)
#pragma unroll
            for (int hh = 0; hh < 2; ++hh) { su[b][hh] = ((const float*)(F.ws + WS_SCU))[e[b][hh]]; sv[b][hh] = ((const float*)(F.ws + WS_SCV))[e[b][hh]]; }
#pragma unroll
        for (int b = 0; b < NB; ++b) {
            const int t = tb + b;
            float cf[2]; float mx = 0.f;
#pragma unroll
            for (int hh = 0; hh < 2; ++hh) { const float a = hs[b] * su[b][hh] * (64.0f * (float)s[b][hh]);
                cf[hh] = gt[b][hh] * 0.5f * a * (1.0f + erff(a * 0.70710678118654752f)) * sv[b][hh]; mx = fmaxf(mx, fabsf(cf[hh])); }
#pragma unroll
            for (int o = 1; o < 64; o <<= 1) mx = fmaxf(mx, __shfl_xor(mx, o));
            const float sc = fmaxf(mx, 1e-30f) * (1.0f / 127.0f), inv = 1.0f / sc;
#pragma unroll
            for (int hh = 0; hh < 2; ++hh) {
                int v = ((int)rintf(cf[hh] * inv) & 0xff) << (8 * (lane & 3));
                v |= dpp_i<DPP_XOR1>(v); v |= dpp_i<DPP_XOR2>(v);
                if ((lane & 3) == 0) F.CQ[(size_t)t * 32 + ((p0 + 8 * hh) >> 2)] = (unsigned)v;
            }
            if (lane == 0) F.CS[t] = sc;
        }
    }
}

__device__ __forceinline__ void p5_scales(Frame& F) {
    const int gt = F.vcu * NWAVES * 64 + F.tid, NGT = F.G * NWAVES * 64;
    for (int t = gt; t < TOK; t += NGT) {
        float mx = 0.f, ss = 0.f;
#pragma unroll
        for (int q = 0; q < 4; ++q) { const f32x4 m = *(const GAS f32x4*)(F.MAXP + (size_t)t * 16 + 4 * q), p = *(const GAS f32x4*)(F.SSQ2P + (size_t)t * 16 + 4 * q);
            mx = fmaxf(mx, fmaxf(fmaxf(m[0], m[1]), fmaxf(m[2], m[3]))); ss += (p[0] + p[1]) + (p[2] + p[3]); }
        const float rstd2 = 1.0f / sqrtf(ss * (1.0f / DM) + pg8::EPS_F), sc = fmaxf(mx, 1e-20f) * (1.0f / 127.0f);
        F.HINV[t] = 1.0f / sc; F.HS[t] = sc * rstd2;
    }
}

#ifndef PROBE_REPEAT
#define PROBE_REPEAT -1
#endif
struct Args { const float* in[16]; float* out; unsigned char* ws; int ph_lo, ph_hi; };

template <class Sched> __device__ __forceinline__ void prep_tab_outproj(Frame& F, const Sched& S) {
    LAS float* tab = (LAS float*)(F.lds + TAB_OFF);
    pg8::Unit u;
    for (int i = 0; S.next(i, u) && i < 4; ++i) {
        if (F.tid < 256) {
            const int row = u.pm * 256 + F.tid;
            const f32x4 a0 = *(const GAS f32x4*)(F.SSQA + (size_t)row * 8), a1 = *(const GAS f32x4*)(F.SSQA + (size_t)row * 8 + 4);
            const f32x4 s0 = *(const GAS f32x4*)(F.SSQS + (size_t)row * 8), s1 = *(const GAS f32x4*)(F.SSQS + (size_t)row * 8 + 4);
            const float sa = ((a0[0] + a0[1]) + (a0[2] + a0[3])) + ((a1[0] + a1[1]) + (a1[2] + a1[3]));
            const float ss = ((s0[0] + s0[1]) + (s0[2] + s0[3])) + ((s1[0] + s1[1]) + (s1[2] + s1[3]));
            const float ra = 1.0f / sqrtf(sa * (1.0f / 512.0f) + pg8::EPS_F), rs = 1.0f / sqrtf(ss * (1.0f / 512.0f) + pg8::EPS_F);
            tab[(i * 256 + F.tid) * 2] = ra / rs; tab[(i * 256 + F.tid) * 2 + 1] = rs;
        }
    }
    LDS_WAIT(); __syncthreads();
}
template <class Sched> __device__ __forceinline__ void prep_tab_query(Frame& F, const Sched& S) {
    LAS float* tab = (LAS float*)(F.lds + TAB_OFF);
    pg8::Unit u;
    for (int i = 0; S.next(i, u) && i < 8; ++i) {
        if (F.tid < 256) {
            const int row = u.pm * 256 + F.tid; float s = 0.f;
#pragma unroll
            for (int j = 0; j < 4; ++j) { const f32x4 p = *(const GAS f32x4*)(F.SSQ2P + (size_t)row * 16 + 4 * j); s += (p[0] + p[1]) + (p[2] + p[3]); }
            tab[i * 256 + F.tid] = 1.0f / sqrtf(s * (1.0f / DM) + pg8::EPS_F);
        }
    }
    LDS_WAIT(); __syncthreads();
}

template <class Sched> __device__ __forceinline__ void prep_tab_inproj(Frame& F, const Sched& S) {
    LAS float* tab = (LAS float*)(F.lds + TAB_OFF);
    LAS float* gtab = (LAS float*)(F.lds + TAB_OFF + 8192);
    pg8::Unit u;
    for (int i = 0; S.next(i, u) && i < 8; ++i)
        if (F.tid < 256) tab[i * 256 + F.tid] = F.RSTD1[u.pm * 256 + F.tid];
    for (int i = F.tid; i < 640; i += NWAVES * 64) gtab[i] = (i < 64) ? F.q_norm_g[i] * pg8::QSCALE : (i < 128) ? F.k_norm_g[i - 64] : F.sgu_norm_g[i - 128];
    LDS_WAIT(); __syncthreads();
}
__device__ __forceinline__ void run_p1(Frame& F) {
    pg8::Gemm g{F.XB, F.Win_t, TOK, INW, DM}; pg8::StaticOrder S; S.init(TOK, INW, F.G, (int)blockIdx.x);
    prep_tab_inproj(F, S);
    pg8::EpiInProj E{(const LAS float*)(F.lds + TAB_OFF), (const LAS float*)(F.lds + TAB_OFF + 8192), F.Q, WS_TYPE_STRIDE / 2};
    pg8::gemm_phase<pg8::EpiInProj, pg8::StaticOrder, true, true>(F.lds + RING_OFF, g, S, E);
}
__device__ __forceinline__ void run_p3(Frame& F) {
    pg8::Gemm g{F.MIX, F.Wout_t, TOK, DM, DM}; pg8::StaticOrder S; S.init(TOK, DM, F.G, (int)blockIdx.x);
    prep_tab_outproj(F, S);
    pg8::EpiOutProj E{F.x, F.out, F.XB, F.SSQ2P, F.MAXP, (const LAS float*)(F.lds + TAB_OFF)};
    pg8::gemm_phase<pg8::EpiOutProj, pg8::StaticOrder, true, true>(F.lds + RING_OFF, g, S, E);
}
__device__ __forceinline__ void run_p4(Frame& F) {
    pg8::Gemm g{F.XB, F.Wq_t, TOK, QPW, DM}; pg8::StaticOrder S; S.init(TOK, QPW, F.G, (int)blockIdx.x);
    prep_tab_query(F, S);
    pg8::EpiQuery E{F.QP, (const LAS float*)(F.lds + TAB_OFF)};
    pg8::gemm_phase<pg8::EpiQuery, pg8::StaticOrder, true, true>(F.lds + RING_OFF, g, S, E);
}

__global__ void __launch_bounds__(NWAVES * 64, 2) hyb_fwd(Args args) {
    extern __shared__ __attribute__((aligned(16))) unsigned char lds[];
    Frame F;
    F.lds = (LAS unsigned char*)lds;
    F.MISC = (volatile LAS unsigned*)(F.lds + MISC_OFF);
    F.tid = threadIdx.x; F.lane = F.tid & 63; F.wave = __builtin_amdgcn_readfirstlane(F.tid >> 6);
    F.G = gridDim.x; { const int bx = blockIdx.x; F.vcu = (F.G % 8 == 0) ? (bx % 8) * (F.G / 8) + bx / 8 : bx; }
    unsigned char* ws = args.ws;
    F.ctl = (gu32*)(ws + WS_CTL);
    F.x = args.in[0]; F.norm1_g = args.in[1]; F.w_in = args.in[2]; F.q_norm_g = args.in[3]; F.k_norm_g = args.in[4]; F.sgu_norm_g = args.in[5]; F.sgu_w = args.in[6]; F.sgu_b = args.in[7];
    F.attn_out_g = args.in[8]; F.sgu_out_g = args.in[9]; F.w_out = args.in[10]; F.norm2_g = args.in[11]; F.w_query = args.in[12]; F.sub_keys = args.in[13]; F.expert_u = args.in[14]; F.expert_v = args.in[15];
    F.out = args.out;
    F.Win_t = (bf16*)(ws + WS_WIN); F.Wout_t = (bf16*)(ws + WS_WOUT); F.Wq_t = (bf16*)(ws + WS_WQ); F.SK = (bf16*)(ws + WS_SK); F.SGUW = (bf16*)(ws + WS_SGUW);
    F.U8 = (signed char*)(ws + WS_UB); F.V8 = (signed char*)(ws + WS_VB); F.ws = ws;
    F.H8 = (signed char*)(ws + WS_H8); F.MAXP = (float*)(ws + WS_MAXP); F.HINV = (float*)(ws + WS_HINV); F.HS = (float*)(ws + WS_HS); F.PA = (int*)(ws + WS_PA); F.CQ = (unsigned*)(ws + WS_COEF); F.CS = (float*)(ws + WS_COEF0);
    F.XB = (bf16*)(ws + WS_XB); F.Q = (bf16*)(ws + WS_Q); F.QP = (bf16*)(ws + WS_QP); F.MIX = (bf16*)(ws + WS_MIX);
    F.RSTD1 = (float*)(ws + WS_RSTD1); F.SSQA = (float*)(ws + WS_SSQA); F.SSQS = (float*)(ws + WS_SSQS); F.SSQ2P = (float*)(ws + WS_SSQ2P); F.GATE = (float*)(ws + WS_GATE); F.EIDX = (unsigned short*)(ws + WS_EIDX);
    for (int u = F.tid; u < (LDS_BYTES - LDSCTL_OFF) / 4; u += NWAVES * 64) ((LAS unsigned*)(F.lds + LDSCTL_OFF))[u] = 0u;
    __syncthreads();
    XcdBarrier bar; bar.bar = (unsigned*)(F.ctl + CW_BAR); bar.x = 0; bar.st = nullptr;
    const int lo = args.ph_lo, hi = args.ph_hi;
    if (hi - lo > 1) bar = xcd_barrier_post((unsigned*)(F.ctl + CW_BAR), F.MISC + 8);
#define IN(k) (lo <= (k) && (k) < hi)

#define SEAM(k) do { if (IN(k) && IN((k) + 1)) { xcd_barrier(bar); if (PROBE_REPEAT == 100 + (k)) { xcd_barrier(bar); xcd_barrier(bar); xcd_barrier(bar); xcd_barrier(bar); } } } while (0)

    if (IN(0)) { p0_prologue(F); if (PROBE_REPEAT == 0) { xcd_barrier(bar); p0_prologue(F); } } SEAM(0);
    if (IN(1)) { run_p1(F); if (PROBE_REPEAT == 1) { xcd_barrier(bar); run_p1(F); } } SEAM(1);
    if (IN(2)) { p2_mixers(F); if (PROBE_REPEAT == 2) { xcd_barrier(bar); p2_mixers(F); } } SEAM(2);
    if (IN(3)) { run_p3(F); if (PROBE_REPEAT == 3) { xcd_barrier(bar); run_p3(F); } } SEAM(3);
    if (IN(4)) { run_p4(F); if (PROBE_REPEAT == 4) { xcd_barrier(bar); run_p4(F); } }
    if (!(IN(4) && IN(5))) {   } else { asm volatile("s_waitcnt vmcnt(0)" ::: "memory"); __syncthreads(); }
    if (IN(5)) {
#pragma unroll 1
        for (int rep = 0; rep < (PROBE_REPEAT == 5 ? 2 : 1); ++rep) p5_topk(F);
#pragma unroll 1
        for (int rep = 0; rep < (PROBE_REPEAT == 15 ? 2 : 1); ++rep) p5_scales(F);
    } SEAM(5);
    if (IN(6)) {
#pragma unroll 1
        for (int rep = 0; rep < (PROBE_REPEAT == 6 ? 2 : 1); ++rep) {
            if (rep) { xcd_barrier(bar); if (blockIdx.x == 0 && F.tid < 8) __hip_atomic_store((unsigned*)(F.ctl + CW_QA + 64 * F.tid), 0u, __ATOMIC_RELAXED, __HIP_MEMORY_SCOPE_AGENT); xcd_barrier(bar); }
            p6_sliced<false>(F);
        }
        if (hi - lo > 1) xcd_barrier(bar);
#pragma unroll 1
        for (int rep = 0; rep < (PROBE_REPEAT == 7 ? 2 : 1); ++rep) p6_reduce(F);
        if (hi - lo > 1) xcd_barrier(bar);
#pragma unroll 1
        for (int rep = 0; rep < (PROBE_REPEAT == 8 ? 2 : 1); ++rep) {
            if (rep) { xcd_barrier(bar); if (blockIdx.x == 0 && F.tid < 8) __hip_atomic_store((unsigned*)(F.ctl + CW_QB + 64 * F.tid), 0u, __ATOMIC_RELAXED, __HIP_MEMORY_SCOPE_AGENT); xcd_barrier(bar); }
            p6_sliced<true>(F);
        }
    }
#undef IN
#undef SEAM
}

extern "C" void kernel_launch(void* const* d_in, const int* in_sizes, int n_in, void* d_out, int out_size, void* d_ws, size_t ws_size, hipStream_t stream) {
    static int grid = 0;
    if (grid == 0) {
        if (n_in != 16 || in_sizes[0] != TOK * DM || out_size != TOK * DM || ws_size < WS_END) { fprintf(stderr, "kernel_launch: unexpected shapes (n_in %d, in0 %d, out %d, ws %zu)\n", n_in, n_in > 0 ? in_sizes[0] : -1, out_size, ws_size); grid = -1; return; }
        int dev = 0, cus = 0, per_cu = 0;
        if (hipGetDevice(&dev) != hipSuccess || hipDeviceGetAttribute(&cus, hipDeviceAttributeMultiprocessorCount, dev) != hipSuccess) { fprintf(stderr, "kernel_launch: device query failed\n"); grid = -1; return; }
        if (hipFuncSetAttribute((const void*)hyb_fwd, hipFuncAttributeMaxDynamicSharedMemorySize, LDS_BYTES) != hipSuccess) { fprintf(stderr, "kernel_launch: hipFuncSetAttribute failed\n"); grid = -1; return; }
        if (hipOccupancyMaxActiveBlocksPerMultiprocessor(&per_cu, (const void*)hyb_fwd, NWAVES * 64, LDS_BYTES) != hipSuccess || per_cu < 1) { fprintf(stderr, "kernel_launch: occupancy query reports %d blocks per CU\n", per_cu); per_cu = 1; }
        (void)hipGetLastError();
        grid = cus;
        if (grid % 8 != 0) grid -= grid % 8;
    }
    if (grid < 0) return;
    (void)hipMemsetAsync((char*)d_ws + WS_CTL, 0, CTL_ZERO_BYTES, stream);
    Args a{};
    for (int i = 0; i < 16; ++i) a.in[i] = (const float*)d_in[i];
    a.out = (float*)d_out; a.ws = (unsigned char*)d_ws;
    if (N_LAUNCHES == 1) { a.ph_lo = 0; a.ph_hi = NPHASE; hipLaunchKernelGGL(hyb_fwd, dim3(grid), dim3(NWAVES * 64), LDS_BYTES, stream, a); }
    else for (int li = 0; li < NPHASE; ++li) { a.ph_lo = li; a.ph_hi = li + 1; hipLaunchKernelGGL(hyb_fwd, dim3(grid), dim3(NWAVES * 64), LDS_BYTES, stream, a); }
}
```

```cpp
#include <hip/hip_runtime.h>
#include <cstdio>
#include <cstdint>
#include <cmath>
namespace pg8 {
#define PG8_LAS __attribute__((address_space(3)))
typedef unsigned short bf16_t;
typedef short bf16x8 __attribute__((ext_vector_type(8)));
typedef float f32x4 __attribute__((ext_vector_type(4)));
typedef unsigned u32x4 __attribute__((ext_vector_type(4)));
constexpr int BM = 256, BK = 64, HALF = 128, HTB = HALF * BK * 2  , STAGE_BYTES = 8 * HTB, NXCD = 8, WGM = 8;

__host__ __device__ __forceinline__ int lds_byte(int r, int c) { const int st = (r >> 4) * 2 + (c >> 5), rr = r & 15, cc = c & 31, ob = rr * 64 + cc * 2; return st * 1024 + (ob ^ (((ob >> 9) & 1) << 5)); }
__host__ __device__ __forceinline__ void stage_rc(int b, int& R, int& C) { const int st = b / 1024, sb = b % 1024, swz = sb ^ (((sb >> 9) & 1) << 5); R = (st >> 1) * 16 + swz / 64; C = (st & 1) * 32 + (swz % 64) / 2; }
__host__ __device__ __forceinline__ int perm32(int rho) { const int n = rho >> 4, i = rho & 15; return 8 * (i >> 2) + 4 * n + (i & 3); }

struct Unit { int pm, pn; };
struct Gemm { const bf16_t* A; const bf16_t* Bt; int M, N, K; };

struct StaticOrder {
    int nM, nN, nwg, G, c;
    __host__ __device__ void init(int M, int N, int G_, int c_) { nM = M / BM; nN = N / BM; nwg = nM * nN; G = G_; c = c_; }
    __host__ __device__ bool next(int i, Unit& u) const {
        const long L = (long)i * G + c; if (L >= nwg) return false;
        int wgid = (int)L; { const int q = nwg / NXCD, r = nwg % NXCD, xcd = wgid % NXCD, off = wgid / NXCD; wgid = (xcd < r ? xcd * (q + 1) : r * (q + 1) + (xcd - r) * q) + off; }
        const int nig = WGM * nN, gid = wgid / nig, fm = gid * WGM, gsz = (nM - fm) < WGM ? (nM - fm) : WGM;
        u.pm = fm + ((wgid % nig) % gsz); u.pn = (wgid % nig) / gsz; return true;
    }
    __device__ __forceinline__ void a_ready(const Unit&) const {}
    __device__ __forceinline__ void done(const Unit&) const {}
};


__device__ __forceinline__ unsigned cvt_pk_bf16(float lo, float hi) { unsigned r; asm volatile("v_cvt_pk_bf16_f32 %0, %1, %2" : "=v"(r) : "v"(lo), "v"(hi)); return r; }

constexpr float EPS_F = 1e-6f;
constexpr float QSCALE = 0.125f * 1.4426950408889634f;

struct EpiInProj {
    static constexpr bool PERM = true; static constexpr int MID_T = 0;
    const PG8_LAS float* tab;
    const PG8_LAS float* gtab;
    bf16_t* out0; size_t type_stride;
    __device__ __forceinline__ void operator()(const f32x4 (&acc)[2][2][4][2], const Unit& u, int ui, int wr, int wc, int fr, int fq) const {
        const int type = u.pn >> 1, half = u.pn & 1;
        bf16_t* base = out0 + (size_t)type * type_stride;
        const int colb = 256 * half + 64 * wc + 8 * fq;
        const bool normed = (type == 0) || (type == 1) || (type == 4);
        const int goff = (type == 0) ? 8 * fq : (type == 1) ? 64 + 8 * fq : 128 + colb;
        float g[2][8];
#pragma unroll
        for (int bj = 0; bj < 2; ++bj) {
            const f32x4 g0 = *(const PG8_LAS f32x4*)(gtab + goff + 32 * bj), g1 = *(const PG8_LAS f32x4*)(gtab + goff + 32 * bj + 4);
#pragma unroll
            for (int e = 0; e < 4; ++e) { g[bj][e] = normed ? g0[e] : 1.f; g[bj][4 + e] = normed ? g1[e] : 1.f; }
        }
#pragma unroll
        for (int ai = 0; ai < 2; ++ai)
#pragma unroll
            for (int m = 0; m < 4; ++m) {
                const int lr = ai * HALF + wr * 64 + m * 16 + fr, row = u.pm * BM + lr;
                const float rs = tab[ui * 256 + lr];
                f32x4 v[2][2];
                float ss = 0.f;
#pragma unroll
                for (int bj = 0; bj < 2; ++bj)
#pragma unroll
                    for (int n = 0; n < 2; ++n) { v[bj][n] = acc[ai][bj][m][n] * rs; const f32x4 x = v[bj][n]; ss += (x[0] * x[0] + x[1] * x[1]) + (x[2] * x[2] + x[3] * x[3]); }
                float r = 1.f;
                if (normed) { ss += __shfl_xor(ss, 16); ss += __shfl_xor(ss, 32); r = 1.0f / sqrtf(ss * (1.0f / 64.0f) + EPS_F); }
                bf16_t* rowp = base + (size_t)row * 512 + colb;
#pragma unroll
                for (int bj = 0; bj < 2; ++bj) {
                    const f32x4 a = v[bj][0], b = v[bj][1];
                    u32x4 w;
                    w.x = cvt_pk_bf16(a[0] * r * g[bj][0], a[1] * r * g[bj][1]); w.y = cvt_pk_bf16(a[2] * r * g[bj][2], a[3] * r * g[bj][3]);
                    w.z = cvt_pk_bf16(b[0] * r * g[bj][4], b[1] * r * g[bj][5]); w.w = cvt_pk_bf16(b[2] * r * g[bj][6], b[3] * r * g[bj][7]);
                    *(u32x4*)(rowp + 32 * bj) = w;
                }
            }
    }
};

struct EpiOutProj {
    static constexpr bool PERM = true; static constexpr int MID_T = 8;
    const float* x; float* x1; bf16_t* x1b; float* ssq2p; float* maxp; const PG8_LAS float* tab;
    __device__ __forceinline__ void mid(f32x4 (&acc)[2][2][4][2], const Unit&, int ui, int wr, int, int fr, int) const {
#pragma unroll
        for (int ai = 0; ai < 2; ++ai)
#pragma unroll
            for (int m = 0; m < 4; ++m) {
                const float rt = tab[(ui * 256 + ai * HALF + wr * 64 + m * 16 + fr) * 2];
#pragma unroll
                for (int bj = 0; bj < 2; ++bj)
#pragma unroll
                    for (int n = 0; n < 2; ++n) acc[ai][bj][m][n] *= rt;
            }
    }
    __device__ __forceinline__ void operator()(const f32x4 (&acc)[2][2][4][2], const Unit& u, int ui, int wr, int wc, int fr, int fq) const {
        const size_t cbase = (size_t)u.pn * BM + wc * 32 + 8 * fq;
        u32x4 xn[2];
#define OP_LOADX(it_) do { const int r_ = u.pm * BM + ((it_) >> 2) * HALF + wr * 64 + ((it_) & 3) * 16 + fr; \
            _Pragma("unroll") for (int bj = 0; bj < 2; ++bj) xn[bj] = *(const u32x4*)(x1b + (size_t)r_ * 1024 + cbase + bj * HALF); } while (0)
        OP_LOADX(0);
#pragma unroll
        for (int it = 0; it < 8; ++it) {
            const int ai = it >> 2, m = it & 3;
            const int lr = ai * HALF + wr * 64 + m * 16 + fr, row = u.pm * BM + lr;
            const float rs = tab[(ui * 256 + lr) * 2 + 1];
            u32x4 xc[2];
#pragma unroll
            for (int bj = 0; bj < 2; ++bj) xc[bj] = xn[bj];
            if (it + 1 < 8) OP_LOADX(it + 1);
            float ss = 0.f, mx = 0.f;
#pragma unroll
            for (int bj = 0; bj < 2; ++bj) {
                const size_t off = (size_t)row * 1024 + cbase + bj * HALF;
                f32x4 xa, xb_; xa[0] = __builtin_bit_cast(float, xc[bj].x << 16); xa[1] = __builtin_bit_cast(float, xc[bj].x & 0xffff0000u); xa[2] = __builtin_bit_cast(float, xc[bj].y << 16); xa[3] = __builtin_bit_cast(float, xc[bj].y & 0xffff0000u);
                xb_[0] = __builtin_bit_cast(float, xc[bj].z << 16); xb_[1] = __builtin_bit_cast(float, xc[bj].z & 0xffff0000u); xb_[2] = __builtin_bit_cast(float, xc[bj].w << 16); xb_[3] = __builtin_bit_cast(float, xc[bj].w & 0xffff0000u);
                const f32x4 a = xa + acc[ai][bj][m][0] * rs, b = xb_ + acc[ai][bj][m][1] * rs;
                ss += (a[0] * a[0] + a[1] * a[1]) + (a[2] * a[2] + a[3] * a[3]) + (b[0] * b[0] + b[1] * b[1]) + (b[2] * b[2] + b[3] * b[3]);
                mx = fmaxf(mx, fmaxf(fmaxf(fmaxf(fabsf(a[0]), fabsf(a[1])), fmaxf(fabsf(a[2]), fabsf(a[3]))), fmaxf(fmaxf(fabsf(b[0]), fabsf(b[1])), fmaxf(fabsf(b[2]), fabsf(b[3])))));
                u32x4 w; w.x = cvt_pk_bf16(a[0], a[1]); w.y = cvt_pk_bf16(a[2], a[3]); w.z = cvt_pk_bf16(b[0], b[1]); w.w = cvt_pk_bf16(b[2], b[3]);
                *(u32x4*)(x1b + off) = w;
            }
            ss += __shfl_xor(ss, 16); ss += __shfl_xor(ss, 32); mx = fmaxf(mx, __shfl_xor(mx, 16)); mx = fmaxf(mx, __shfl_xor(mx, 32));
            if (fq == 0) { ssq2p[(size_t)row * 16 + u.pn * 4 + wc] = ss; maxp[(size_t)row * 16 + u.pn * 4 + wc] = mx; }
        }
#undef OP_LOADX
    }
};

struct EpiQuery {
    static constexpr bool PERM = true; static constexpr int MID_T = 0;
    bf16_t* qp; const PG8_LAS float* tab;
    __device__ __forceinline__ void operator()(const f32x4 (&acc)[2][2][4][2], const Unit& u, int ui, int wr, int wc, int fr, int fq) const {
#pragma unroll
        for (int ai = 0; ai < 2; ++ai)
#pragma unroll
            for (int m = 0; m < 4; ++m) {
                const int lr = ai * HALF + wr * 64 + m * 16 + fr, row = u.pm * BM + lr;
                const float rs = tab[ui * 256 + lr];
#pragma unroll
                for (int bj = 0; bj < 2; ++bj) {
                    const size_t off = ((((size_t)(row >> 5) * 8 + u.pn) * 2 + bj) * 8 + 2 * wc + (fq >> 1)) * 512 + (size_t)(32 * (fq & 1) + (row & 31)) * 8;
                    const f32x4 a = acc[ai][bj][m][0] * rs, b = acc[ai][bj][m][1] * rs;
                    u32x4 w; w.x = cvt_pk_bf16(a[0], a[1]); w.y = cvt_pk_bf16(a[2], a[3]); w.z = cvt_pk_bf16(b[0], b[1]); w.w = cvt_pk_bf16(b[2], b[3]);
                    *(u32x4*)(qp + off) = w;
                }
            }
    }
};

template <class Epi, class Sched, bool ALIGN_EPI = false, bool SP2 = false>
__device__ __forceinline__ void gemm_phase(PG8_LAS unsigned char* lds, const Gemm g, const Sched& S, const Epi& E) {
    const int tid = threadIdx.x, wid = __builtin_amdgcn_readfirstlane(tid >> 6), lane = tid & 63, wr = wid >> 2, wc = wid & 3, fr = lane & 15, fq = lane >> 4;
    const int K = g.K, nt = K / BK;
    unsigned voffA[2], voffB[2];
#pragma unroll
    for (int i = 0; i < 2; ++i) { int R, C; stage_rc(tid * 16 + i * 8192, R, C); const int Rb = Epi::PERM ? ((R & ~31) + perm32(R & 31)) : R;
        voffA[i] = (unsigned)(R * K + C) * 2u; voffB[i] = (unsigned)(Rb * K + C) * 2u; }
    const size_t kstep = (size_t)(BK * 2);
    const size_t hstep = (size_t)HALF * K * 2;
    const size_t tstep = 2 * hstep;
    const unsigned ldsw = (unsigned)wid * 1024u;
    const int aoff = lds_byte(wr * 64 + fr, fq * 8), boff = lds_byte(wc * 32 + fr, fq * 8);
#define PG8_SA(b, h) (((b) * 2 + (h)) * HTB)
#define PG8_SB(b, h) ((4 + (b) * 2 + (h)) * HTB)
#define PG8_STAGE(bufoff, gbase, voff) do { _Pragma("unroll") for (int _i = 0; _i < 2; ++_i) \
        __builtin_amdgcn_global_load_lds((const unsigned*)((const char*)(gbase) + (voff)[_i]), (PG8_LAS unsigned*)(lds + (bufoff) + ldsw + _i * 8192), 16, 0, 0); } while (0)
#define PG8_LDA(dst, b, h) do { _Pragma("unroll") for (int m = 0; m < 4; ++m) _Pragma("unroll") for (int k = 0; k < 2; ++k) dst[m][k] = *(const PG8_LAS bf16x8*)(lds + PG8_SA(b, h) + aoff + m * 2048 + k * 1024); } while (0)
#define PG8_LDB(dst, b, h) do { _Pragma("unroll") for (int n = 0; n < 2; ++n) _Pragma("unroll") for (int k = 0; k < 2; ++k) dst[n][k] = *(const PG8_LAS bf16x8*)(lds + PG8_SB(b, h) + boff + n * 2048 + k * 1024); } while (0)
#define PG8_MMA(ai, bj, At, Bt) do { __builtin_amdgcn_s_setprio(1); _Pragma("unroll") for (int m = 0; m < 4; ++m) _Pragma("unroll") for (int n = 0; n < 2; ++n) _Pragma("unroll") for (int k = 0; k < 2; ++k) \
        acc[ai][bj][m][n] = __builtin_amdgcn_mfma_f32_16x16x32_bf16(Bt[n][k], At[m][k], acc[ai][bj][m][n], 0, 0, 0); __builtin_amdgcn_s_setprio(0); } while (0)
#define PG8_WAIT_V(n) asm volatile("s_waitcnt vmcnt(" #n ")" ::: "memory")
#define PG8_WAIT_L(n) asm volatile("s_waitcnt lgkmcnt(" #n ")" ::: "memory")
#define PG8_BAR __builtin_amdgcn_s_barrier()
#define PG8_SCHED __builtin_amdgcn_sched_barrier(0)
    Unit cur, nxt; int ui = 0;
    if (!S.next(0, cur)) return;
    f32x4 acc[2][2][4][2];
#pragma unroll
    for (int a = 0; a < 2; ++a)
#pragma unroll
        for (int b = 0; b < 2; ++b)
#pragma unroll
            for (int m = 0; m < 4; ++m)
#pragma unroll
                for (int n = 0; n < 2; ++n) acc[a][b][m][n] = (f32x4){0.f, 0.f, 0.f, 0.f};
    bf16x8 At[4][2], B0[2][2], B1[2][2];
    const char* cA = (const char*)g.A + (size_t)cur.pm * tstep; const char* cB = (const char*)g.Bt + (size_t)cur.pn * tstep;
    S.a_ready(cur);
    if constexpr (SP2) {
        PG8_STAGE(PG8_SB(0, 0), cB, voffB); PG8_STAGE(PG8_SB(0, 1), cB + hstep, voffB); PG8_STAGE(PG8_SA(0, 0), cA, voffA); PG8_STAGE(PG8_SA(0, 1), cA + hstep, voffA);
        if (wr == 1) PG8_BAR;
        PG8_WAIT_V(2); PG8_BAR;
        PG8_STAGE(PG8_SB(1, 0), cB + kstep, voffB); PG8_STAGE(PG8_SA(1, 0), cA + kstep, voffA); PG8_STAGE(PG8_SB(1, 1), cB + hstep + kstep, voffB);
        PG8_WAIT_V(6); PG8_BAR;
    } else {
        PG8_STAGE(PG8_SB(0, 0), cB, voffB); PG8_STAGE(PG8_SA(0, 0), cA, voffA); PG8_STAGE(PG8_SB(0, 1), cB + hstep, voffB); PG8_STAGE(PG8_SA(0, 1), cA + hstep, voffA);
        if (wr == 1) PG8_BAR;
        PG8_WAIT_V(4); PG8_BAR;
        PG8_STAGE(PG8_SB(1, 0), cB + kstep, voffB); PG8_STAGE(PG8_SA(1, 0), cA + kstep, voffA); PG8_STAGE(PG8_SB(1, 1), cB + hstep + kstep, voffB);
        PG8_WAIT_V(6); PG8_BAR;
    }
    for (;;) {
        const bool has_next = S.next(ui + 1, nxt);
        const char* nA = has_next ? (const char*)g.A + (size_t)nxt.pm * tstep : cA; const char* nB = has_next ? (const char*)g.Bt + (size_t)nxt.pn * tstep : cB;
        for (int t = 0; t < nt; t += 2) {
            if constexpr (Epi::MID_T > 0) { if (t == Epi::MID_T) E.mid(acc, cur, ui, wr, wc, fr, fq); }
            const bool last = (t == nt - 2);
            const char* a1 = cA + (size_t)(t + 1) * kstep;
            const char* a2 = last ? nA : cA + (size_t)(t + 2) * kstep; const char* b2 = last ? nB : cB + (size_t)(t + 2) * kstep;
            const char* a3 = a2 + kstep; const char* b3 = b2 + kstep;
            if (last && has_next) S.a_ready(nxt);
            if constexpr (SP2) {
            PG8_LDB(B0, 0, 0); PG8_LDB(B1, 0, 1); PG8_SCHED; PG8_LDA(At, 0, 0); PG8_STAGE(PG8_SA(1, 1), a1 + hstep, voffA);
            PG8_WAIT_V(8); PG8_WAIT_L(0); PG8_BAR; PG8_MMA(0, 0, At, B0); PG8_MMA(0, 1, At, B1); PG8_BAR; PG8_SCHED;
            PG8_LDA(At, 0, 1); PG8_STAGE(PG8_SB(0, 0), b2, voffB); PG8_STAGE(PG8_SB(0, 1), b2 + hstep, voffB); PG8_STAGE(PG8_SA(0, 0), a2, voffA);
            PG8_WAIT_V(8); PG8_WAIT_L(0); PG8_BAR; PG8_MMA(1, 0, At, B0); PG8_MMA(1, 1, At, B1); PG8_BAR; PG8_SCHED;
            PG8_LDB(B0, 1, 0); PG8_LDB(B1, 1, 1); PG8_SCHED; PG8_LDA(At, 1, 0); PG8_STAGE(PG8_SA(0, 1), a2 + hstep, voffA);
            PG8_WAIT_V(8); PG8_WAIT_L(0); PG8_BAR; PG8_MMA(0, 0, At, B0); PG8_MMA(0, 1, At, B1); PG8_BAR; PG8_SCHED;
            PG8_LDA(At, 1, 1); PG8_STAGE(PG8_SB(1, 0), b3, voffB); PG8_STAGE(PG8_SB(1, 1), b3 + hstep, voffB); PG8_STAGE(PG8_SA(1, 0), a3, voffA);
            PG8_WAIT_V(8); PG8_WAIT_L(0); PG8_BAR; PG8_MMA(1, 0, At, B0); PG8_MMA(1, 1, At, B1); PG8_BAR; PG8_SCHED;
            } else {
            PG8_LDB(B0, 0, 0); PG8_SCHED; PG8_LDA(At, 0, 0); PG8_STAGE(PG8_SA(1, 1), a1 + hstep, voffA);
            PG8_WAIT_L(8); PG8_BAR; PG8_WAIT_L(0); PG8_MMA(0, 0, At, B0); PG8_BAR; PG8_SCHED;
            PG8_LDB(B1, 0, 1); PG8_STAGE(PG8_SB(0, 0), b2, voffB);
            PG8_BAR; PG8_WAIT_L(0); PG8_MMA(0, 1, At, B1); PG8_BAR;
            PG8_LDA(At, 0, 1); PG8_STAGE(PG8_SA(0, 0), a2, voffA);
            PG8_BAR; PG8_WAIT_L(0); PG8_MMA(1, 0, At, B0); PG8_BAR; PG8_SCHED;
            PG8_STAGE(PG8_SB(0, 1), b2 + hstep, voffB);
            PG8_WAIT_V(6); PG8_BAR; PG8_MMA(1, 1, At, B1); PG8_BAR;
            PG8_LDB(B0, 1, 0); PG8_SCHED; PG8_LDA(At, 1, 0); PG8_STAGE(PG8_SA(0, 1), a2 + hstep, voffA);
            PG8_WAIT_L(8); PG8_BAR; PG8_WAIT_L(0); PG8_MMA(0, 0, At, B0); PG8_BAR; PG8_SCHED;
            PG8_LDB(B1, 1, 1); PG8_STAGE(PG8_SB(1, 0), b3, voffB);
            PG8_BAR; PG8_WAIT_L(0); PG8_MMA(0, 1, At, B1); PG8_BAR;
            PG8_LDA(At, 1, 1); PG8_STAGE(PG8_SA(1, 0), a3, voffA);
            PG8_BAR; PG8_WAIT_L(0); PG8_MMA(1, 0, At, B0); PG8_BAR; PG8_SCHED;
            PG8_STAGE(PG8_SB(1, 1), b3 + hstep, voffB);
            PG8_WAIT_V(6); PG8_BAR; PG8_MMA(1, 1, At, B1); PG8_BAR;
            }
        }
        if constexpr (ALIGN_EPI) { if (wr == 0) PG8_BAR; }
        E(acc, cur, ui, wr, wc, fr, fq); S.done(cur);
        if (!has_next) break;
#pragma unroll
        for (int a = 0; a < 2; ++a)
#pragma unroll
            for (int b = 0; b < 2; ++b)
#pragma unroll
                for (int m = 0; m < 4; ++m)
#pragma unroll
                    for (int n = 0; n < 2; ++n) acc[a][b][m][n] = (f32x4){0.f, 0.f, 0.f, 0.f};
        cur = nxt; cA = nA; cB = nB; ++ui;
        if constexpr (ALIGN_EPI) { if (wr == 1) PG8_BAR; }
    }
    PG8_WAIT_V(0);
    if constexpr (!ALIGN_EPI) { if (wr == 0) PG8_BAR; }
    PG8_BAR;
#undef PG8_SA
#undef PG8_SB
#undef PG8_STAGE
#undef PG8_LDA
#undef PG8_LDB
#undef PG8_MMA
#undef PG8_WAIT_V
#undef PG8_WAIT_L
#undef PG8_BAR
#undef PG8_SCHED
}
}

constexpr int NWAVES = 8;
constexpr int DM = 1024, BATCH = 8, SEQ = 4096, TOK = BATCH * SEQ;
constexpr int AW = 512, INW = 2560, QPW = 2048, NEXP = 16384;
constexpr int NPHASE = 7;
#ifndef MK_N_LAUNCHES
#define MK_N_LAUNCHES 1
#endif
constexpr int N_LAUNCHES = MK_N_LAUNCHES;

constexpr size_t MiB = 1u << 20;
constexpr size_t WS_CTL = 0, CTL_ZERO_BYTES = 64 * 1024;
constexpr size_t WS_WIN = 2 * MiB, WS_WOUT = 8 * MiB, WS_WQ = 10 * MiB, WS_SK = 14 * MiB, WS_SGUW = 14 * MiB + 512 * 1024, WS_RSTD1 = 15 * MiB;
constexpr size_t WS_SCU = 15 * MiB + 256 * 1024, WS_SCV = 15 * MiB + 512 * 1024;
constexpr size_t WS_UB = 16 * MiB, WS_VB = 48 * MiB;
constexpr size_t WS_XB = 80 * MiB;
constexpr size_t WS_Q = 144 * MiB, WS_TYPE_STRIDE = 32 * MiB;
constexpr size_t WS_QP = 144 * MiB;
constexpr size_t WS_MIX = 304 * MiB;
constexpr size_t WS_SSQA = 368 * MiB, WS_SSQS = 369 * MiB, WS_SSQ2P = 370 * MiB, WS_MAXP = 372 * MiB, WS_HINV = 374 * MiB;
constexpr size_t WS_PA = 144 * MiB;
constexpr size_t WS_COEF = 304 * MiB, WS_COEF0 = 320 * MiB, WS_H8 = 324 * MiB, WS_HS = 356 * MiB;
constexpr size_t WS_EIDX = 376 * MiB, WS_GATE = 392 * MiB, WS_END = 408 * MiB;
constexpr int CW_BAR = 1024;

constexpr int RING_OFF = 0, RING_BYTES = 131072;
constexpr int TAB_OFF = RING_BYTES, TAB_BYTES = 8192;
constexpr int LDSCTL_OFF = 153600, MISC_OFF = LDSCTL_OFF + 64;
constexpr int LDS_BYTES = 155648;
static_assert(MISC_OFF + 128 <= LDS_BYTES, "LDS map");

#define GAS __attribute__((address_space(1)))
#define LAS __attribute__((address_space(3)))
typedef unsigned short bf16;
typedef unsigned v4u __attribute__((ext_vector_type(4)));
typedef unsigned v2u __attribute__((ext_vector_type(2)));
typedef float f32x4 __attribute__((ext_vector_type(4)));
typedef float f32x16 __attribute__((ext_vector_type(16)));
typedef short bf16x8 __attribute__((ext_vector_type(8)));
typedef short s16x4 __attribute__((ext_vector_type(4)));
typedef __bf16 bf16x2_t __attribute__((ext_vector_type(2)));
typedef GAS unsigned gu32;
#define RLX_AGENT __ATOMIC_RELAXED, __HIP_MEMORY_SCOPE_AGENT
#define LDS_WAIT() asm volatile("s_waitcnt lgkmcnt(0)" ::: "memory")
#define VM_WAIT() asm volatile("s_waitcnt vmcnt(0)" ::: "memory")
__device__ __forceinline__ unsigned f2bf(float f) { unsigned u = __builtin_bit_cast(unsigned, f); return (u + 0x7fffu + ((u >> 16) & 1u)) >> 16; }
__device__ __forceinline__ unsigned pk2(float lo, float hi) { return pg8::cvt_pk_bf16(lo, hi); }
__device__ __forceinline__ float bf_lo(unsigned w) { return __builtin_bit_cast(float, w << 16); }
__device__ __forceinline__ float bf_hi(unsigned w) { return __builtin_bit_cast(float, w & 0xffff0000u); }
__device__ __forceinline__ int crow(int r, int hi) { return (r & 3) + 8 * (r >> 2) + 4 * hi; }
#define XB_TMO      128
#define XB_XCNT(j)  (256  + 64 * (j))
#define XB_XSUB(j)  (1280 + 64 * (j))
#define XB_XGEN(j)  (2304 + 64 * (j))
#define XB_TOP      3328
#define XB_TOPGEN   3392
#define XCD_BAR_WORDS 3456
#define XB_SPIN_CAP (1u << 18)

__device__ __forceinline__ unsigned xb_ld(unsigned* p)              { return __hip_atomic_load(p, __ATOMIC_RELAXED, __HIP_MEMORY_SCOPE_AGENT); }
__device__ __forceinline__ unsigned xb_add(unsigned* p, unsigned v) { return __hip_atomic_fetch_add(p, v, __ATOMIC_RELAXED, __HIP_MEMORY_SCOPE_AGENT); }
__device__ __forceinline__ unsigned xb_xcc_id() { return (unsigned)__builtin_amdgcn_s_getreg((3 << 11) | 20) & 0xFu; }
#define XB_SPIN(cond, bar) do { unsigned _sp = 0; while (cond) { __builtin_amdgcn_s_sleep(1); \
    if ((++_sp & 255u) == 0u) { if (xb_ld(&(bar)[XB_TMO])) break; if (_sp > XB_SPIN_CAP) { atomicAdd(&(bar)[XB_TMO], 1u); break; } } } } while (0)

struct XcdBarrier {
    unsigned* bar; unsigned x;
    volatile LAS unsigned* st;
};

__device__ __forceinline__ XcdBarrier xcd_barrier_post(unsigned* bar, volatile LAS unsigned* st) {
    XcdBarrier b; b.bar = bar; b.x = xb_xcc_id(); b.st = st;
    if (threadIdx.x == 0) (void)xb_add(&bar[XB_XCNT(b.x)], 1u);
    return b;
}
__device__ __forceinline__ void xcd_barrier_complete(unsigned* bar, unsigned x, unsigned& nloc, unsigned& nx) {
    const unsigned G = gridDim.x * gridDim.y * gridDim.z;
    unsigned sum, cnt, mine, sp = 0u;
    for (;;) {
        sum = 0u; cnt = 0u; mine = 0u;
#pragma unroll
        for (unsigned j = 0; j < 16; ++j) { const unsigned c = xb_ld(&bar[XB_XCNT(j)]); sum += c; cnt += (c > 0u) ? 1u : 0u; mine = (j == x) ? c : mine; }
        if (sum == G) break;
        __builtin_amdgcn_s_sleep(1);
        if ((++sp & 255u) == 0u) { if (xb_ld(&bar[XB_TMO])) break; if (sp > XB_SPIN_CAP) { atomicAdd(&bar[XB_TMO], 1u); break; } }
    }
    nloc = mine > 0u ? mine : 1u; nx = cnt > 0u ? cnt : 1u;
}

__device__ __forceinline__ void xcd_barrier(const XcdBarrier& b) {
    asm volatile("s_waitcnt vmcnt(0)" ::: "memory");
    __syncthreads();
    if (threadIdx.x == 0) {
        unsigned* bar = b.bar;
        __builtin_amdgcn_s_waitcnt(0);
        unsigned nloc = b.st[0], nx = b.st[1];
        if (nloc == 0u) { xcd_barrier_complete(bar, b.x, nloc, nx); b.st[0] = nloc; b.st[1] = nx; }
        const unsigned old = xb_add(&bar[XB_XSUB(b.x)], 1u);
        const unsigned gen = old / nloc;
        if (old + 1u == (gen + 1u) * nloc) {
            __builtin_amdgcn_fence(__ATOMIC_RELEASE, "agent");
            asm volatile("s_waitcnt vmcnt(0)" ::: "memory");
            const unsigned og = xb_add(&bar[XB_TOP], 1u);
            const unsigned tg = og / nx;
            if (og + 1u == (tg + 1u) * nx) xb_add(&bar[XB_TOPGEN], 1u);
            else XB_SPIN(xb_ld(&bar[XB_TOPGEN]) == tg, bar);
            __builtin_amdgcn_fence(__ATOMIC_ACQUIRE, "agent");
            xb_add(&bar[XB_XGEN(b.x)], 1u);
            asm volatile("s_waitcnt vmcnt(0)" ::: "memory");
        } else {
            XB_SPIN(xb_ld(&bar[XB_XGEN(b.x)]) == gen, bar);
            __builtin_amdgcn_fence(__ATOMIC_ACQUIRE, "agent");
            asm volatile("s_waitcnt vmcnt(0)" ::: "memory");
        }
    }
    __syncthreads();
}

struct Frame {
    LAS unsigned char* lds;
    volatile LAS unsigned* MISC;
    gu32* ctl;
    int tid, lane, wave;
    int vcu, G;
    unsigned char* ws;
    const float *x, *norm1_g, *w_in, *q_norm_g, *k_norm_g, *sgu_norm_g, *sgu_w, *sgu_b, *attn_out_g, *sgu_out_g, *w_out, *norm2_g, *w_query, *sub_keys, *expert_u, *expert_v;
    float* out;
    bf16 *Win_t, *Wout_t, *Wq_t, *SK, *SGUW, *XB, *Q, *QP, *MIX;
    float *RSTD1, *SSQA, *SSQS, *SSQ2P, *GATE, *HS, *CS, *MAXP, *HINV;
    signed char *U8, *H8, *V8; int* PA; unsigned* CQ;
    unsigned short* EIDX;
};

__device__ __forceinline__ float wave_sum(float v) {
#pragma unroll
    for (int o = 1; o < 64; o <<= 1) v += __shfl_xor(v, o);
    return v;
}

__device__ __forceinline__ void p0_transpose_item(const float* W, int K, int N, bf16* WT, const float* gain_a, const float* gain_b, int gsplit, LAS float* scr, int item, int lane, bool permute) {
    const int nblk = N / 32, kb = item / nblk, nb = item % nblk, k0 = 64 * kb, n0 = 32 * nb;
#pragma unroll 8
    for (int i = 0; i < 32; ++i) { const int kk = 2 * i + (lane >> 5); const int k = k0 + kk; const float gv = (k < gsplit) ? gain_a[k] : gain_b[k - gsplit];
        scr[kk * 33 + (lane & 31)] = __builtin_nontemporal_load((const GAS float*)(W + (size_t)k * N + n0 + (lane & 31))) * gv; }
    LDS_WAIT(); asm volatile("" ::: "memory");
    int orow0 = n0;
    if (permute) { const int l = n0 & 255; orow0 = (n0 & ~255) + 128 * ((l >> 5) & 1) + 32 * (l >> 6); }
    const int c = lane & 7;
#pragma unroll
    for (int j = 0; j < 4; ++j) { const int n = (lane >> 3) + 8 * j; const LAS float* s = scr + (8 * c) * 33 + n;
        v4u o; o.x = pk2(s[0 * 33], s[1 * 33]); o.y = pk2(s[2 * 33], s[3 * 33]); o.z = pk2(s[4 * 33], s[5 * 33]); o.w = pk2(s[6 * 33], s[7 * 33]);
        *(GAS v4u*)(WT + (size_t)(orow0 + n) * K + k0 + 8 * c) = o; }
    LDS_WAIT(); asm volatile("" ::: "memory");
}

__device__ __forceinline__ float row_to_bf16(const float* src, bf16* dst, const float* gain, int lane) {
    float ss = 0.f;
    f32x4 v[4];
#pragma unroll
    for (int j = 0; j < 4; ++j) v[j] = __builtin_nontemporal_load((const GAS f32x4*)(src + 4 * lane + 256 * j));
#pragma unroll
    for (int j = 0; j < 4; ++j) {
        f32x4 a = v[j];
        ss += (a[0] * a[0] + a[1] * a[1]) + (a[2] * a[2] + a[3] * a[3]);
        if (gain) a = a * *(const GAS f32x4*)(gain + 4 * lane + 256 * j);
        v2u o; o.x = pk2(a[0], a[1]); o.y = pk2(a[2], a[3]);
        *(GAS v2u*)(dst + 4 * lane + 256 * j) = o;
    }
    return ss;
}

__device__ __forceinline__ void p0_prologue(Frame& F) {
    LAS float* scr = (LAS float*)(F.lds + RING_OFF + F.wave * 16384);
    const int gw = F.vcu * NWAVES + F.wave, NGW = F.G * NWAVES;
    constexpr int I_IN = (DM / 64) * (INW / 32), I_OUT = (DM / 64) * (DM / 32), I_Q = (DM / 64) * (QPW / 32);
    for (int it = gw; it < I_IN + I_OUT + I_Q; it += NGW) {
        int r = it;
        if (r < I_IN) { p0_transpose_item(F.w_in, DM, INW, F.Win_t, F.norm1_g, F.norm1_g, DM, scr, r, F.lane, true); continue; } r -= I_IN;
        if (r < I_OUT) { p0_transpose_item(F.w_out, DM, DM, F.Wout_t, F.attn_out_g, F.sgu_out_g, AW, scr, r, F.lane, false); continue; } r -= I_OUT;
        p0_transpose_item(F.w_query, DM, QPW, F.Wq_t, F.norm2_g, F.norm2_g, DM, scr, r, F.lane, false);
    }
    for (int m = 2 * gw; m < TOK; m += 2 * NGW) {
        const float s0 = row_to_bf16(F.x + (size_t)m * DM, F.XB + (size_t)m * DM, nullptr, F.lane);
        const float s1 = row_to_bf16(F.x + (size_t)(m + 1) * DM, F.XB + (size_t)(m + 1) * DM, nullptr, F.lane);
        const float ss0 = wave_sum(s0), ss1 = wave_sum(s1);
        if (F.lane == 0) { F.RSTD1[m] = 1.0f / sqrtf(ss0 * (1.0f / DM) + pg8::EPS_F); F.RSTD1[m + 1] = 1.0f / sqrtf(ss1 * (1.0f / DM) + pg8::EPS_F); }
    }
    for (int e0 = 2 * gw; e0 < 2 * NEXP; e0 += 2 * NGW) {
        const bool isu = e0 < NEXP; const int r0 = isu ? e0 : e0 - NEXP;
        f32x4 v[2][4]; float mx[2] = {0.f, 0.f};
#pragma unroll
        for (int b = 0; b < 2; ++b) {
            const float* src = (isu ? F.expert_u : F.expert_v) + (size_t)(r0 + b) * DM + 4 * F.lane;
#pragma unroll
            for (int q = 0; q < 4; ++q) v[b][q] = __builtin_nontemporal_load((const GAS f32x4*)(src + 256 * q));
        }
#pragma unroll
        for (int b = 0; b < 2; ++b) {
#pragma unroll
            for (int q = 0; q < 4; ++q) { if (isu) v[b][q] = v[b][q] * *(const GAS f32x4*)(F.norm2_g + 4 * F.lane + 256 * q);
                mx[b] = fmaxf(mx[b], fmaxf(fmaxf(fabsf(v[b][q][0]), fabsf(v[b][q][1])), fmaxf(fabsf(v[b][q][2]), fabsf(v[b][q][3])))); }
#pragma unroll
            for (int o = 1; o < 64; o <<= 1) mx[b] = fmaxf(mx[b], __shfl_xor(mx[b], o));
            const float sc = fmaxf(mx[b], 1e-30f) * (1.0f / 127.0f), inv = 1.0f / sc; const int r = r0 + b;
            signed char* tab = isu ? F.U8 : F.V8;
#pragma unroll
            for (int q = 0; q < 4; ++q) { const int b0 = (int)rintf(v[b][q][0] * inv), b1 = (int)rintf(v[b][q][1] * inv), b2 = (int)rintf(v[b][q][2] * inv), b3 = (int)rintf(v[b][q][3] * inv);
                const unsigned o = (unsigned)(b0 & 0xff) | ((unsigned)(b1 & 0xff) << 8) | ((unsigned)(b2 & 0xff) << 16) | ((unsigned)(b3 & 0xff) << 24);
                *(GAS unsigned*)(tab + ((size_t)(2 * q + (F.lane >> 5)) * NEXP + r) * 128 + 4 * (F.lane & 31)) = o; }
            if (F.lane == 0) { float* scp = (float*)(F.ws + (isu ? WS_SCU : WS_SCV)); scp[r] = sc; }
        }
    }
    const int gt = F.vcu * NWAVES * 64 + F.tid, NGT = F.G * NWAVES * 64;
    for (int i = gt; i < 8 * 128 * 128; i += NGT) { const int g = i >> 14, t = (i >> 7) & 127, s = i & 127;
        const int o = ((((g * 4 + (t >> 5)) * 8 + (s >> 4)) * 64) + 32 * ((s >> 3) & 1) + (t & 31)) * 8 + (s & 7);
        F.SGUW[o] = (bf16)f2bf(s <= t ? F.sgu_w[i] : 0.f); }
    for (int i = gt; i < 2 * 128 * 128; i += NGT) F.SK[i] = (bf16)f2bf(F.sub_keys[i]);
}

constexpr int AT_OPITCH = 136;
constexpr int AT_OACC = 0, AT_LACC = 512 * AT_OPITCH, AT_VS = AT_LACC + 2048, AT_VS_WAVE = 32 * 128;
constexpr int AT_KS = AT_VS + NWAVES * AT_VS_WAVE, AT_KS_WAVE = 32 * 128;
static_assert(AT_KS + NWAVES * AT_KS_WAVE <= LDSCTL_OFF, "attention LDS");
__device__ __forceinline__ int at_rowmap(int p) { return (p & ~15) | ((p ^ (p >> 4)) & 15); }
__device__ __forceinline__ s16x4 vtr(const LAS unsigned char* p) { typedef short v4i16_t __attribute__((ext_vector_type(4))); return __builtin_bit_cast(s16x4, __builtin_amdgcn_ds_read_tr16_b64_v4i16((LAS v4i16_t*)p)); }

struct AtDesc { int b, h, span, dil, res, a; };
__device__ __forceinline__ AtDesc at_desc(int u, int stage, int idx) {
    AtDesc d; const int bh = u >> 3; d.b = bh >> 3; d.h = bh & 7; d.span = u & 7;
    if (stage == 0) { d.dil = 16; d.res = idx; d.a = d.span; }
    else if (stage == 1) { d.dil = 4; d.res = idx & 3; d.a = 4 * d.span + 2 * (idx >> 2); }
    else { d.dil = 1; d.res = 0; d.a = 16 * d.span + 2 * idx; }
    return d;
}
__device__ __forceinline__ void at_dma(LAS unsigned char* ks, LAS unsigned char* vs, const char* kptr, const char* vptr, size_t vrow8) {
#pragma unroll
    for (int it = 0; it < 4; ++it) __builtin_amdgcn_global_load_lds((const unsigned*)(kptr + it * vrow8), (LAS unsigned*)(ks + it * 1024), 16, 0, 0);
#pragma unroll
    for (int it = 0; it < 4; ++it) __builtin_amdgcn_global_load_lds((const unsigned*)(vptr + it * vrow8), (LAS unsigned*)(vs + it * 1024), 16, 0, 0);
}
__device__ __forceinline__ size_t at_koff(int lane, int h) { return (size_t)h * 128 + (size_t)((((lane & 7) ^ (lane >> 3)) & 7) << 4); }
__device__ __forceinline__ size_t at_voff(int lane, int h) { return (size_t)h * 128 + (size_t)(((lane & 7) ^ (((lane >> 4) & 1) << 2)) << 4); }
__device__ __forceinline__ void at_start(Frame& F, const AtDesc& d, int nt, bf16x8 (&qn)[2][4]) {
    const int lane = F.lane, r32 = lane & 31, hi = lane >> 5;
    const int j0 = (d.a >= 4) ? 0 : 4 - d.a;
    const size_t krow = (size_t)d.b * SEQ + d.res + (size_t)d.dil * (32 * (d.a - 4 + j0) + (lane >> 3));
    const char* kp = (const char*)(F.Q + WS_TYPE_STRIDE / 2) + krow * 1024; const char* vp = (const char*)(F.Q + 2 * (WS_TYPE_STRIDE / 2)) + krow * 1024;
    at_dma(F.lds + AT_KS + F.wave * AT_KS_WAVE, F.lds + AT_VS + F.wave * AT_VS_WAVE, kp + at_koff(lane, d.h), vp + at_voff(lane, d.h), (size_t)d.dil * 8 * 1024);
#pragma unroll
    for (int t = 0; t < 2; ++t) {
        const size_t qrow = (size_t)d.b * SEQ + d.res + (size_t)d.dil * (32 * (d.a + (t ? nt - 1 : 0)) + r32);
        const bf16* qp = F.Q + qrow * 512 + d.h * 64 + hi * 8;
#pragma unroll
        for (int d0 = 0; d0 < 4; ++d0) qn[t][d0] = *(const GAS bf16x8*)(qp + 16 * d0);
    }
}

template <int STAGE, int NT>
__device__ __forceinline__ void attn_task(Frame& F, const AtDesc& d, float sl, float mlog2, bf16x8 (&qn)[2][4], const AtDesc& nd, int nnt) {
    const int lane = F.lane, r32 = lane & 31, hi = lane >> 5;
    const int b = d.b, h = d.h, span = d.span, dil = d.dil, res = d.res, a = d.a;
    const size_t tokbase = (size_t)b * SEQ;
    LAS unsigned char* vs = F.lds + AT_VS + F.wave * AT_VS_WAVE;
    LAS unsigned char* ks = F.lds + AT_KS + F.wave * AT_KS_WAVE;
    bf16x8 qf[NT][4];
#pragma unroll
    for (int t = 0; t < NT; ++t)
#pragma unroll
        for (int d0 = 0; d0 < 4; ++d0) qf[t][d0] = qn[t][d0];
    f32x16 o[NT][2];
    float lsum[NT];
#pragma unroll
    for (int t = 0; t < NT; ++t) { o[t][0] = f32x16{}; o[t][1] = f32x16{}; lsum[t] = 0.f; }
    const float base_i = -sl * (float)(128 + r32) - mlog2 + sl * (float)(4 * hi);
    const int G = lane >> 4, gi = lane & 15, gq4 = gi >> 2, gp = gi & 3;
    const int j0 = (a >= 4) ? 0 : 4 - a;
    const size_t cstride = (size_t)dil * 32 * 1024, vrow8 = (size_t)dil * 8 * 1024;
    const size_t krow1 = tokbase + res + (size_t)dil * (32 * (a - 3 + j0) + (lane >> 3));
    const char* kptr = (const char*)(F.Q + WS_TYPE_STRIDE / 2) + krow1 * 1024 + at_koff(lane, h);
    const char* vptr = (const char*)(F.Q + 2 * (WS_TYPE_STRIDE / 2)) + krow1 * 1024 + at_voff(lane, h);
    bf16x8 kf[4], va[2][2];
#define AT_TOP() do { \
        asm volatile("s_waitcnt vmcnt(0)" ::: "memory"); \
        _Pragma("unroll") for (int d0 = 0; d0 < 4; ++d0) kf[d0] = *(const LAS bf16x8*)(ks + r32 * 128 + (((2 * d0 + hi) ^ (r32 & 7)) << 4)); \
          \
        _Pragma("unroll") for (int d0 = 0; d0 < 2; ++d0) \
            _Pragma("unroll") for (int ks_ = 0; ks_ < 2; ++ks_) { \
                const LAS unsigned char* pa = vs + (16 * ks_ + 4 * (G >> 1) + gq4) * 128 + ((64 * d0 + 32 * (G & 1) + 8 * gp) ^ (((gq4 >> 1) & 1) << 6)); \
                const s16x4 lo = vtr(pa), hi4 = vtr(pa + 8 * 128); \
                va[d0][ks_] = (bf16x8){lo[0], lo[1], lo[2], lo[3], hi4[0], hi4[1], hi4[2], hi4[3]}; } \
        LDS_WAIT(); } while (0)
#define AT_MATH(t, c) do { \
        f32x16 s; \
        const float bc = base_i + sl * (float)(32 * (c)); \
        _Pragma("unroll") for (int r = 0; r < 16; ++r) s[r] = bc + sl * (float)((r & 3) + 8 * (r >> 2)); \
        _Pragma("unroll") for (int d0 = 0; d0 < 4; ++d0) s = __builtin_amdgcn_mfma_f32_32x32x16_bf16(kf[d0], qf[t][d0], s, 0, 0, 0); \
          \
        const int dbase = 128 - 32 * (c) + r32 - 4 * hi; \
        float ls_ = lsum[t]; \
        if (((c) == 0) || ((c) == 4)) { \
            _Pragma("unroll") for (int r = 0; r < 16; ++r) { float p = __builtin_amdgcn_exp2f(s[r]); p = ((unsigned)(dbase - ((r & 3) + 8 * (r >> 2))) <= 128u) ? p : 0.f; s[r] = p; ls_ += p; } \
        } else { \
            _Pragma("unroll") for (int r = 0; r < 16; ++r) { const float p = __builtin_amdgcn_exp2f(s[r]); s[r] = p; ls_ += p; } \
        } \
        lsum[t] = ls_; \
        bf16x8 pb[2]; \
        _Pragma("unroll") for (int ks_ = 0; ks_ < 2; ++ks_) { v4u w; w.x = pk2(s[8 * ks_ + 0], s[8 * ks_ + 1]); w.y = pk2(s[8 * ks_ + 2], s[8 * ks_ + 3]); w.z = pk2(s[8 * ks_ + 4], s[8 * ks_ + 5]); w.w = pk2(s[8 * ks_ + 6], s[8 * ks_ + 7]); pb[ks_] = __builtin_bit_cast(bf16x8, w); } \
          \
        _Pragma("unroll") for (int d0 = 0; d0 < 2; ++d0) \
            _Pragma("unroll") for (int ks_ = 0; ks_ < 2; ++ks_) o[t][d0] = __builtin_amdgcn_mfma_f32_32x32x16_bf16(va[d0][ks_], pb[ks_], o[t][d0], 0, 0, 0); \
    } while (0)
#pragma unroll 1
    for (int j = j0; j < 3 + NT; ++j) {
        AT_TOP();
        at_dma(ks, vs, kptr, vptr, vrow8); kptr += cstride; vptr += cstride;
        AT_MATH(0, j);
        if (NT == 2) { if (j >= 1) AT_MATH(NT - 1, j - 1); }
    }
    AT_TOP();
    at_start(F, nd, nnt, qn);
    AT_MATH(NT - 1, 4);
#undef AT_MATH
#undef AT_TOP
    LAS float* lacc = (LAS float*)(F.lds + AT_LACC);
#pragma unroll
    for (int t = 0; t < NT; ++t) {
        float ls = lsum[t];
        ls += __shfl_xor(ls, 32);
        const int posq = res + dil * (32 * (a + t) + r32);
        const int pl = posq - span * 512;
        LAS unsigned char* orow = F.lds + AT_OACC + at_rowmap(pl) * AT_OPITCH;
        if (STAGE > 0) {
            ls += lacc[pl];
#pragma unroll
            for (int d0 = 0; d0 < 2; ++d0)
#pragma unroll
                for (int g4 = 0; g4 < 4; ++g4) { const v2u w = *(LAS v2u*)(orow + (32 * d0 + 8 * g4 + 4 * hi) * 2);
                    o[t][d0][4 * g4 + 0] += bf_lo(w.x); o[t][d0][4 * g4 + 1] += bf_hi(w.x); o[t][d0][4 * g4 + 2] += bf_lo(w.y); o[t][d0][4 * g4 + 3] += bf_hi(w.y); }
        }
        if (STAGE < 2) {
            if (hi == 0) lacc[pl] = ls;
#pragma unroll
            for (int d0 = 0; d0 < 2; ++d0)
#pragma unroll
                for (int g4 = 0; g4 < 4; ++g4) { v2u w; w.x = pk2(o[t][d0][4 * g4 + 0], o[t][d0][4 * g4 + 1]); w.y = pk2(o[t][d0][4 * g4 + 2], o[t][d0][4 * g4 + 3]);
                    *(LAS v2u*)(orow + (32 * d0 + 8 * g4 + 4 * hi) * 2) = w; }
        } else {
            const float inv = 1.0f / ls;
            float ss = 0.f;
#pragma unroll
            for (int d0 = 0; d0 < 2; ++d0)
#pragma unroll
                for (int g4 = 0; g4 < 4; ++g4) { const float a0 = o[t][d0][4 * g4 + 0] * inv, a1 = o[t][d0][4 * g4 + 1] * inv, a2 = o[t][d0][4 * g4 + 2] * inv, a3 = o[t][d0][4 * g4 + 3] * inv;
                    ss += (a0 * a0 + a1 * a1) + (a2 * a2 + a3 * a3);
                    v2u w; w.x = pk2(a0, a1); w.y = pk2(a2, a3);
                    *(LAS v2u*)(orow + (32 * d0 + 8 * g4 + 4 * hi) * 2) = w; }
            ss += __shfl_xor(ss, 32);
            if (hi == 0) F.SSQA[(tokbase + posq) * 8 + h] = ss;
            LDS_WAIT(); asm volatile("" ::: "memory");
#pragma unroll
            for (int it = 0; it < 4; ++it) { const int row = (lane >> 3) + 8 * it;
                const LAS unsigned char* src = F.lds + AT_OACC + at_rowmap(res + dil * (32 * (a + t) + row) - span * 512) * AT_OPITCH + (lane & 7) * 16;
                const v2u lo = *(const LAS v2u*)src, hi2 = *(const LAS v2u*)(src + 8);
                v4u ov; ov.x = lo.x; ov.y = lo.y; ov.z = hi2.x; ov.w = hi2.y;
                *(GAS v4u*)(F.MIX + (tokbase + res + (size_t)dil * (32 * (a + t) + row)) * 1024 + h * 64 + (lane & 7) * 8) = ov; }
            LDS_WAIT(); asm volatile("" ::: "memory");
        }
    }
}

__device__ __forceinline__ void attn_unit(Frame& F, int u, int un, float mlog2, bf16x8 (&qn)[2][4]) {
    const int h = (u >> 3) & 7;
    const float slope = __builtin_amdgcn_exp2f(-(float)(h + 1)) * 1.4426950408889634f;
    const int w = F.wave;
#pragma unroll 1
    for (int k = 0; k < 2; ++k) attn_task<0, 1>(F, at_desc(u, 0, 2 * w + k), slope * 16.f, mlog2, qn, k ? at_desc(u, 1, w) : at_desc(u, 0, 2 * w + 1), 1 + k);
    LDS_WAIT(); __syncthreads();
    attn_task<1, 2>(F, at_desc(u, 1, w), slope * 4.f, mlog2, qn, at_desc(u, 2, w), 2);
    LDS_WAIT(); __syncthreads();
    attn_task<2, 2>(F, at_desc(u, 2, w), slope, mlog2, qn, at_desc(un, 0, 2 * w), 1);
    LDS_WAIT(); __syncthreads();
}

constexpr int SG_PITCH = 192, SG_TILE = 128 * SG_PITCH;
static_assert(4 * SG_TILE <= RING_BYTES, "SGU LDS");
struct SguPre { v4u tile[4]; bf16x8 wb[8]; v4u sul[4]; float bias; };
constexpr int SG_SU_OFF = 4 * SG_TILE, SG_SU_WAVE = 32 * 144;
static_assert(SG_SU_OFF + NWAVES * SG_SU_WAVE <= LDSCTL_OFF, "SGU LDS");
__device__ __forceinline__ void sgu_load(Frame& F, int u, SguPre& p) {
    const int gp = u & 3, ch = (u >> 2) & 31, b = u >> 7;
    const int lane = F.lane, r32 = lane & 31, hi = lane >> 5, w = F.wave, gsel = w >> 2, tb = w & 3, g = 2 * gp + gsel, t = 32 * tb + r32;
    const size_t tok0 = (size_t)b * SEQ + (size_t)ch * 128;
    const bf16* SVN = F.Q + 4 * (WS_TYPE_STRIDE / 2); const bf16* SU = F.Q + 3 * (WS_TYPE_STRIDE / 2);
#pragma unroll
    for (int gg = 0; gg < 2; ++gg)
#pragma unroll
        for (int it = 0; it < 2; ++it) { const int idx = F.tid + 512 * it, s_ = idx >> 3, c8 = idx & 7;
            p.tile[2 * gg + it] = __builtin_nontemporal_load((const GAS v4u*)(SVN + (tok0 + s_) * 512 + (2 * gp + gg) * 64 + c8 * 8)); }
    const bf16* Wg = F.SGUW + ((size_t)(g * 4 + tb) * 8 * 64 + lane) * 8;
#pragma unroll
    for (int ks = 0; ks < 8; ++ks) p.wb[ks] = *(const GAS bf16x8*)(Wg + ks * 512);
    p.bias = F.sgu_b[g * 128 + t];
#pragma unroll
    for (int i = 0; i < 4; ++i) p.sul[i] = __builtin_nontemporal_load((const GAS v4u*)(SU + (tok0 + 32 * tb + (lane >> 3) + 8 * i) * 512 + g * 64 + (lane & 7) * 8));
}
__device__ __forceinline__ void sgu_phase(Frame& F) {
    const int lane = F.lane, r32 = lane & 31, hi = lane >> 5, w = F.wave, gsel = w >> 2, tb = w & 3, t = 32 * tb + r32;
    const int G = lane >> 4, gi = lane & 15, gq4 = gi >> 2, gpp = gi & 3;
    constexpr int NU = BATCH * 32 * 4;
    int u = F.vcu; if (u >= NU) return;
    SguPre pre; sgu_load(F, u, pre);
    for (int it_ = 0; u < NU; u += F.G, ++it_) {
        LAS unsigned char* buf = F.lds + (it_ & 1) * (2 * SG_TILE);
#pragma unroll
        for (int gg = 0; gg < 2; ++gg)
#pragma unroll
            for (int it = 0; it < 2; ++it) { const int idx = F.tid + 512 * it, s_ = idx >> 3, c8 = idx & 7; *(LAS v4u*)(buf + gg * SG_TILE + s_ * SG_PITCH + c8 * 16) = pre.tile[2 * gg + it]; }
        bf16x8 wb[8]; const float bias = pre.bias;
#pragma unroll
        for (int i = 0; i < 8; ++i) wb[i] = pre.wb[i];
        LAS unsigned char* sus = F.lds + SG_SU_OFF + w * SG_SU_WAVE;
#pragma unroll
        for (int i = 0; i < 4; ++i) *(LAS v4u*)(sus + ((lane >> 3) + 8 * i) * 144 + (lane & 7) * 16) = pre.sul[i];
        LDS_WAIT(); __syncthreads();
        const int un = (u + F.G < NU) ? u + F.G : u;
        sgu_load(F, un, pre);
        const int gp = u & 3, ch = (u >> 2) & 31, b = u >> 7, g = 2 * gp + gsel;
        const size_t tok0 = (size_t)b * SEQ + (size_t)ch * 128;
        const LAS unsigned char* ts = buf + gsel * SG_TILE;
        f32x16 acc[2]; acc[0] = f32x16{}; acc[1] = f32x16{};
#pragma unroll
        for (int ks = 0; ks < 8; ++ks) {
#pragma unroll
            for (int eb = 0; eb < 2; ++eb) {
                const LAS unsigned char* pa = ts + (16 * ks + 8 * (G >> 1) + gq4) * SG_PITCH + (32 * eb + 16 * (G & 1) + 4 * gpp) * 2;
                const s16x4 lo = vtr(pa), hi4 = vtr(pa + 4 * SG_PITCH);
                const bf16x8 va = (bf16x8){lo[0], lo[1], lo[2], lo[3], hi4[0], hi4[1], hi4[2], hi4[3]};
                acc[eb] = __builtin_amdgcn_mfma_f32_32x32x16_bf16(va, wb[ks], acc[eb], 0, 0, 0);
            }
        }
        float ss = 0.f;
#pragma unroll
        for (int eb = 0; eb < 2; ++eb)
#pragma unroll
            for (int g4 = 0; g4 < 4; ++g4) { const int e = 32 * eb + 8 * g4 + 4 * hi;
                const v2u sw = *(const LAS v2u*)(sus + r32 * 144 + e * 2);
                const float a0 = bf_lo(sw.x) * (acc[eb][4 * g4 + 0] + bias), a1 = bf_hi(sw.x) * (acc[eb][4 * g4 + 1] + bias), a2 = bf_lo(sw.y) * (acc[eb][4 * g4 + 2] + bias), a3 = bf_hi(sw.y) * (acc[eb][4 * g4 + 3] + bias);
                ss += (a0 * a0 + a1 * a1) + (a2 * a2 + a3 * a3);
                v2u wv; wv.x = pk2(a0, a1); wv.y = pk2(a2, a3); *(LAS v2u*)(sus + r32 * 144 + e * 2) = wv; }
        ss += __shfl_xor(ss, 32);
        if (hi == 0) F.SSQS[(tok0 + t) * 8 + g] = ss;
        LDS_WAIT(); asm volatile("" ::: "memory");
#pragma unroll
        for (int i = 0; i < 4; ++i) { const int row = (lane >> 3) + 8 * i; const v4u ov = *(const LAS v4u*)(sus + row * 144 + (lane & 7) * 16);
            *(GAS v4u*)(F.MIX + (tok0 + 32 * tb + row) * 1024 + 512 + g * 64 + (lane & 7) * 8) = ov; }
        LDS_WAIT(); asm volatile("" ::: "memory");
    }
    LDS_WAIT(); __syncthreads();
}

#ifndef P2_VARIANT
#define P2_VARIANT 0
#endif
__device__ __forceinline__ void p2_mixers(Frame& F) {
    float mq = fabsf(F.q_norm_g[F.lane]), mk = fabsf(F.k_norm_g[F.lane]);
#pragma unroll
    for (int o = 1; o < 64; o <<= 1) { mq = fmaxf(mq, __shfl_xor(mq, o)); mk = fmaxf(mk, __shfl_xor(mk, o)); }
    const float mlog2 = 8.0f * mq * mk * 1.4426950408889634f;
    {
        constexpr int NU = BATCH * 8 * 8;
        bf16x8 qn[2][4];
        if (F.vcu < NU) at_start(F, at_desc(F.vcu, 0, 2 * F.wave), 1, qn);
#pragma unroll 1
        for (int u = F.vcu; u < NU; u += F.G) attn_unit(F, u, (u + F.G < NU) ? u + F.G : u, mlog2, qn);
        asm volatile("s_waitcnt vmcnt(0)" ::: "memory"); __syncthreads();
    }
#pragma unroll 1
    for (int rep = 0; rep < (P2_VARIANT == 2 ? 2 : 1); ++rep)
    sgu_phase(F);
}

__device__ __forceinline__ unsigned f2ord(float f) { const unsigned u = __builtin_bit_cast(unsigned, f); return u ^ ((unsigned)((int)u >> 31) | 0x80000000u); }
__device__ __forceinline__ float ord2f(unsigned k) { const unsigned u = (k & 0x80000000u) ? (k ^ 0x80000000u) : ~k; return __builtin_bit_cast(float, u); }
#define CE_DESC(a, b) do { const unsigned _mx = max((a), (b)), _mn = min((a), (b)); (a) = _mx; (b) = _mn; } while (0)
__device__ __forceinline__ void sort16(unsigned (&k)[16]) {
#pragma unroll
    for (int k2 = 2; k2 <= 16; k2 <<= 1)
#pragma unroll
        for (int j = k2 >> 1; j > 0; j >>= 1)
#pragma unroll
            for (int i = 0; i < 16; ++i) { const int l = i ^ j; if (l > i) { if ((i & k2) == 0) CE_DESC(k[i], k[l]); else CE_DESC(k[l], k[i]); } }
}
__device__ __forceinline__ void merge16(unsigned (&a)[16], const unsigned (&b)[16]) {
#pragma unroll
    for (int i = 0; i < 16; ++i) a[i] = max(a[i], b[15 - i]);
#pragma unroll
    for (int j = 8; j > 0; j >>= 1)
#pragma unroll
        for (int i = 0; i < 16; ++i) { const int l = i ^ j; if (l > i) CE_DESC(a[i], a[l]); }
}
__device__ __forceinline__ void swap16(const unsigned (&x)[16], const unsigned (&y)[16], unsigned (&xo)[16], unsigned (&yo)[16]) {
#pragma unroll
    for (int i = 0; i < 16; ++i) { auto rr = __builtin_amdgcn_permlane32_swap(x[i], y[i], false, false); xo[i] = rr[0]; yo[i] = rr[1]; }
}

__host__ __device__ constexpr int cand0(int q) { return q < 16 ? q : q < 21 ? 0x20 + (q - 16) : q < 24 ? 0x40 + (q - 21) : q < 26 ? 0x60 + (q - 24) : q == 26 ? 0x80 : q == 27 ? 0xa0 : q == 28 ? 0xc0 : q == 29 ? 0xe0 : 0xff; }
__host__ __device__ constexpr int cand1(int q) { return q < 8 ? 0x10 + q : q < 12 ? 0x30 + (q - 8) : q < 14 ? 0x50 + (q - 12) : q < 16 ? 0x70 + (q - 14) : q == 16 ? 0x90 : q == 17 ? 0xb0 : q == 18 ? 0xd0 : q == 19 ? 0xf0 : 0xff; }

constexpr int TK_SK_BYTES = 2 * 128 * 256;
constexpr int TK_LDS_WAVE = 32 * 32 * 4, TK_SCR_OFF = TK_SK_BYTES;
static_assert(TK_SCR_OFF + NWAVES * TK_LDS_WAVE <= RING_BYTES, "top-k LDS");
__device__ __forceinline__ void tk_load_q(Frame& F, size_t t0, int hd, int half, int r32, int hi, bf16x8 (&qf)[8]) {
#pragma unroll
    for (int i = 0; i < 8; ++i) qf[i] = __builtin_nontemporal_load((const GAS bf16x8*)(F.QP + ((((t0 >> 5) * 8 + hd) * 2 + half) * 8 + i) * 512 + (size_t)(32 * hi + r32) * 8));
}
template <int HALF_> __device__ __forceinline__ void half_top16(Frame& F, const bf16x8 (&qf)[8], int r32, int hi, unsigned (&best)[16]) {
#pragma unroll
    for (int nb = 0; nb < 4; ++nb) {
        f32x16 acc;
#pragma unroll
        for (int r = 0; r < 16; ++r) acc[r] = 64.0f;
        const int row = HALF_ * 128 + 32 * nb + r32;
#pragma unroll
        for (int ks = 0; ks < 8; ++ks) { const bf16x8 a = *(const LAS bf16x8*)(F.lds + row * 256 + (((2 * ks + hi) ^ (row & 15)) << 4));
            acc = __builtin_amdgcn_mfma_f32_32x32x16_bf16(a, qf[ks], acc, 0, 0, 0); }
        unsigned k[16];
#pragma unroll
        for (int r = 0; r < 16; ++r) { const int n = 32 * nb + (r & 3) + 8 * (r >> 2) + 4 * hi; k[r] = (__builtin_bit_cast(unsigned, __builtin_amdgcn_fmed3f(acc[r], 4.0f, 124.0f)) & ~127u) | (unsigned)(127 - n); }
        sort16(k);
        if (nb == 0) {
#pragma unroll
            for (int i = 0; i < 16; ++i) best[i] = k[i];
        } else merge16(best, k);
    }
}

__device__ __forceinline__ void topk_task(Frame& F, int tb, int hd, bf16x8 (&qa)[8], bool has_next, int tb_next, int hd_next) {
    const int lane = F.lane, r32 = lane & 31, hi = lane >> 5;
    const size_t t0 = (size_t)tb * 32;
    unsigned bk[2][16];
    bf16x8 qb[8];
    tk_load_q(F, t0, hd, 1, r32, hi, qb);
    half_top16<0>(F, qa, r32, hi, bk[0]);
    if (has_next) tk_load_q(F, (size_t)tb_next * 32, hd_next, 0, r32, hi, qa);
    half_top16<1>(F, qb, r32, hi, bk[1]);
    unsigned xa[16], ya[16];
    swap16(bk[0], bk[1], xa, ya);
    merge16(xa, ya);
    unsigned A[16], B[16];
    swap16(xa, xa, A, B);
    LAS unsigned* tk = (LAS unsigned*)(F.lds + TK_SCR_OFF + F.wave * TK_LDS_WAVE) + r32 * 32;
#pragma unroll
    for (int i = 0; i < 16; ++i) tk[16 * hi + i] = hi ? B[i] : A[i];
    float v1[16], v2[16];
#pragma unroll
    for (int i = 0; i < 16; ++i) { v1[i] = __builtin_bit_cast(float, A[i] & ~127u); v2[i] = __builtin_bit_cast(float, B[i] & ~127u); }
    unsigned c0[16], c1[16];
#pragma unroll
    for (int q = 0; q < 32; ++q) {
        const int ij0 = cand0(q), ij1 = cand1(q);
        const float s0 = (ij0 == 0xff) ? 0.0f : v1[ij0 >> 4] + v2[ij0 & 15];
        const float s1 = (ij1 == 0xff) ? 0.0f : v1[ij1 >> 4] + v2[ij1 & 15];
        const unsigned k0 = (__builtin_bit_cast(unsigned, s0) & ~255u) | (unsigned)(ij0 & 255), k1 = (__builtin_bit_cast(unsigned, s1) & ~255u) | (unsigned)(ij1 & 255);
        const unsigned kk = hi ? k1 : k0;
        if (q < 16) c0[q] = kk; else c1[q - 16] = kk;
    }
    sort16(c0); sort16(c1); merge16(c0, c1);
    unsigned L0[16], L1[16];
    swap16(c0, c0, L0, L1);
    merge16(L0, L1);
    const float mx = __builtin_bit_cast(float, L0[0] & ~255u);
    float ex[16], den = 0.f;
#pragma unroll
    for (int i = 0; i < 16; ++i) { ex[i] = __expf(__builtin_bit_cast(float, L0[i] & ~255u) - mx); den += ex[i]; }
    const float rden = 1.0f / den;
    LDS_WAIT(); asm volatile("" ::: "memory");
    int ei[8]; float gt[8];
#pragma unroll
    for (int kk = 0; kk < 8; ++kk) {
        const unsigned key = hi ? L0[8 + kk] : L0[kk]; const float e = hi ? ex[8 + kk] : ex[kk];
        const int i = (key >> 4) & 15, j = key & 15;
        const int i1 = 127 - (int)(tk[i] & 127u), i2 = 127 - (int)(tk[16 + j] & 127u);
        ei[kk] = i1 * 128 + i2; gt[kk] = e * rden;
    }
    unsigned short* ep = F.EIDX + (t0 + r32) * 128 + hd * 16 + 8 * hi; float* gp = F.GATE + (t0 + r32) * 128 + hd * 16 + 8 * hi;
    *(GAS v4u*)ep = (v4u){(unsigned)ei[0] | ((unsigned)ei[1] << 16), (unsigned)ei[2] | ((unsigned)ei[3] << 16), (unsigned)ei[4] | ((unsigned)ei[5] << 16), (unsigned)ei[6] | ((unsigned)ei[7] << 16)};
    *(GAS f32x4*)gp = (f32x4){gt[0], gt[1], gt[2], gt[3]}; *(GAS f32x4*)(gp + 4) = (f32x4){gt[4], gt[5], gt[6], gt[7]};
    LDS_WAIT(); asm volatile("" ::: "memory");
}

__device__ __forceinline__ void p5_topk(Frame& F) {
    for (int i = F.tid; i < 2 * 128 * 16; i += NWAVES * 64) { const int row = i >> 4, ch = i & 15;
        *(LAS v4u*)(F.lds + row * 256 + ((ch ^ (row & 15)) << 4)) = *(const GAS v4u*)(F.SK + (size_t)row * 128 + ch * 8); }
    LDS_WAIT(); __syncthreads();
    pg8::StaticOrder S; S.init(TOK, QPW, F.G, (int)blockIdx.x);
    pg8::Unit u, un;
    bf16x8 qf[8];
    bool have = S.next(0, u);
    if (have) tk_load_q(F, (size_t)(u.pm * 8 + F.wave) * 32, u.pn, 0, F.lane & 31, F.lane >> 5, qf);
#pragma unroll 1
    for (int i = 0; have; ++i) {
        const bool hn = S.next(i + 1, un);
        topk_task(F, u.pm * 8 + F.wave, u.pn, qf, hn, un.pm * 8 + F.wave, un.pn);
        u = un; have = hn;
    }
    LDS_WAIT(); __syncthreads();
}

constexpr int PE_TPI = 16, PE_NITEM = TOK / PE_TPI;
constexpr int CW_QA = 8192, CW_QB = 8192 + 8 * 64;

template <int CTRL> __device__ __forceinline__ int dpp_i(int v) { return __builtin_amdgcn_update_dpp(0, v, CTRL, 0xf, 0xf, true); }
template <int CTRL> __device__ __forceinline__ float dpp_f(float v) { return __builtin_bit_cast(float, __builtin_amdgcn_update_dpp(0, __builtin_bit_cast(int, v), CTRL, 0xf, 0xf, true)); }
constexpr int DPP_XOR1 = 0xB1, DPP_XOR2 = 0x4E, DPP_HMIRROR = 0x141, DPP_ROR8 = 0x128;

__device__ __forceinline__ void pe_load_ix(Frame& F, int t, v4u (&ix)[2]) {
    const int gl = F.lane >> 3;
#pragma unroll
    for (int q = 0; q < 2; ++q) ix[q] = *(const GAS v4u*)(F.EIDX + (size_t)t * 128 + gl * 16 + 8 * q);
}
__device__ __forceinline__ void pe_load_rows(const void* TAB, const v4u (&ix)[2], int coloff, v4u (&w)[16]) {
#pragma unroll
    for (int i = 0; i < 16; ++i) { const unsigned pr = ix[i >> 3][(i >> 1) & 3]; const unsigned e = (i & 1) ? (pr >> 16) : (pr & 0xffffu);
        w[i] = *(const GAS v4u*)((const char*)TAB + (size_t)e * 128 + coloff); }
}
__device__ __forceinline__ v4u pe_quant16(const v4u& lo, const v4u& hi, float inv) {
    v4u o;
#pragma unroll
    for (int q = 0; q < 4; ++q) { const unsigned w0 = (q < 2) ? lo[2 * q] : hi[2 * q - 4], w1 = (q < 2) ? lo[2 * q + 1] : hi[2 * q - 3];
        const int b0 = (int)rintf(bf_lo(w0) * inv), b1 = (int)rintf(bf_hi(w0) * inv), b2 = (int)rintf(bf_lo(w1) * inv), b3 = (int)rintf(bf_hi(w1) * inv);
        o[q] = (unsigned)(b0 & 0xff) | ((unsigned)(b1 & 0xff) << 8) | ((unsigned)(b2 & 0xff) << 16) | ((unsigned)(b3 & 0xff) << 24); }
    return o;
}
__device__ __forceinline__ void peA_compute(Frame& F, int* PA, int j, int t, const v4u& hq, const v4u (&w)[16]) {
    const int gl = F.lane >> 3, sub = F.lane & 7;
    int r0 = 0, r1 = 0;
#pragma unroll
    for (int i = 0; i < 16; ++i) {
        int p = __builtin_amdgcn_sdot4((int)w[i].x, (int)hq.x, 0, false);
        p = __builtin_amdgcn_sdot4((int)w[i].y, (int)hq.y, p, false); p = __builtin_amdgcn_sdot4((int)w[i].z, (int)hq.z, p, false); p = __builtin_amdgcn_sdot4((int)w[i].w, (int)hq.w, p, false);
        p += dpp_i<DPP_XOR1>(p); p += dpp_i<DPP_XOR2>(p); p += dpp_i<DPP_HMIRROR>(p);
        if (i < 8) r0 = (sub == i) ? p : r0; else r1 = (sub == i - 8) ? p : r1;
    }
    const unsigned pk = ((unsigned)((r0 + 32) >> 6) & 0xffffu) | ((unsigned)((r1 + 32) >> 6) << 16);
    ((unsigned*)PA)[((size_t)j * TOK + t) * 64 + gl * 8 + sub] = pk;
}
__device__ __forceinline__ void peB_compute(Frame& F, int j, int t, const v4u& cq, float cs, const v4u (&w)[16]) {
    const int lane = F.lane, gl = lane >> 3, sub = lane & 7;
    typedef float f32x2_t __attribute__((ext_vector_type(2)));
    const int mycol = 128 * j + 2 * lane;
    const unsigned xw = *(const GAS unsigned*)(F.XB + (size_t)t * DM + mycol);
    f32x2_t xin; xin.x = bf_lo(xw); xin.y = bf_hi(xw);
    int acc[16];
#pragma unroll
    for (int c = 0; c < 16; ++c) acc[c] = 0;
#pragma unroll
    for (int m = 0; m < 4; ++m)
#pragma unroll
        for (int q = 0; q < 4; ++q) {
            const unsigned a0 = w[4 * m + 0][q], a1 = w[4 * m + 1][q], a2 = w[4 * m + 2][q], a3 = w[4 * m + 3][q];
            const unsigned t0 = __builtin_amdgcn_perm(a1, a0, 0x05010400u), t1 = __builtin_amdgcn_perm(a1, a0, 0x07030602u);
            const unsigned t2 = __builtin_amdgcn_perm(a3, a2, 0x05010400u), t3 = __builtin_amdgcn_perm(a3, a2, 0x07030602u);
            const unsigned o0 = __builtin_amdgcn_perm(t2, t0, 0x05040100u), o1 = __builtin_amdgcn_perm(t2, t0, 0x07060302u);
            const unsigned o2 = __builtin_amdgcn_perm(t3, t1, 0x05040100u), o3 = __builtin_amdgcn_perm(t3, t1, 0x07060302u);
            acc[4 * q + 0] = __builtin_amdgcn_sdot4((int)o0, (int)cq[m], acc[4 * q + 0], false); acc[4 * q + 1] = __builtin_amdgcn_sdot4((int)o1, (int)cq[m], acc[4 * q + 1], false);
            acc[4 * q + 2] = __builtin_amdgcn_sdot4((int)o2, (int)cq[m], acc[4 * q + 2], false); acc[4 * q + 3] = __builtin_amdgcn_sdot4((int)o3, (int)cq[m], acc[4 * q + 3], false);
        }
    int h8v[8];
#pragma unroll
    for (int c = 0; c < 8; ++c) { auto rr = __builtin_amdgcn_permlane32_swap((unsigned)acc[c], (unsigned)acc[c + 8], false, false);
        unsigned r0 = rr[0], r1 = rr[1]; asm volatile("" : "+v"(r0), "+v"(r1));
        h8v[c] = (int)r0 + (int)r1; }
    const bool b4 = (lane >> 4) & 1, b3 = (lane >> 3) & 1;
    int h4[4];
#pragma unroll
    for (int c = 0; c < 4; ++c) { const int keep = b4 ? h8v[c + 4] : h8v[c], give = b4 ? h8v[c] : h8v[c + 4]; h4[c] = keep + __builtin_amdgcn_ds_swizzle(give, 0x401F); }
    int h2[2];
#pragma unroll
    for (int c = 0; c < 2; ++c) { const int keep = b3 ? h4[c + 2] : h4[c], give = b3 ? h4[c] : h4[c + 2]; h2[c] = keep + dpp_i<DPP_ROR8>(give); }
    const int srcl = ((lane >> 3) + 8 * (lane & 1) + 16 * ((lane >> 1) & 1) + 32 * ((lane >> 2) & 1)) * 4;
    const int q0 = __builtin_amdgcn_ds_bpermute(srcl, h2[0]), q1 = __builtin_amdgcn_ds_bpermute(srcl, h2[1]);
    f32x2_t o; o.x = xin.x + cs * (float)q0; o.y = xin.y + cs * (float)q1;
    __builtin_nontemporal_store(o, (GAS f32x2_t*)(F.out + (size_t)t * DM + mycol));
}

template <bool PHASE_B> __device__ __forceinline__ void pe_item(Frame& F, int j, int t0) {
    const int sub = F.lane & 7, gl = F.lane >> 3, coloff = 128 * j + 16 * sub;
    const void* TAB = (const char*)(PHASE_B ? (const void*)F.V8 : (const void*)F.U8) + (size_t)j * NEXP * 128;
    const int rowoff = 16 * sub;
    v4u ixA[2], ixB[2], wA[16], wB[16], auxA, auxB, aux2A = {}, aux2B = {}; float csA = 0.f, csB = 0.f;
#define PE_AUX(t, aux, aux2, cs) do { if (PHASE_B) { aux = *(const GAS v4u*)(F.CQ + (size_t)(t) * 32 + gl * 4); cs = F.CS[t]; } \
        else { aux = *(const GAS v4u*)(F.XB + (size_t)(t) * DM + coloff); aux2 = *(const GAS v4u*)(F.XB + (size_t)(t) * DM + coloff + 8); cs = F.HINV[t]; } } while (0)
#define PE_COMPUTE(t, aux, aux2, cs, w) do { if (PHASE_B) peB_compute(F, j, (t), aux, cs, w); else peA_compute(F, F.PA, j, (t), pe_quant16(aux, aux2, cs), w); } while (0)
    pe_load_ix(F, t0, ixA); pe_load_rows(TAB, ixA, rowoff, wA); PE_AUX(t0, auxA, aux2A, csA); pe_load_ix(F, t0 + 1, ixB);
#pragma unroll 1
    for (int k = 0; k < PE_TPI - 2; k += 2) {
        pe_load_rows(TAB, ixB, rowoff, wB); PE_AUX(t0 + k + 1, auxB, aux2B, csB);
        pe_load_ix(F, t0 + k + 2, ixA);
        PE_COMPUTE(t0 + k, auxA, aux2A, csA, wA);
        pe_load_rows(TAB, ixA, rowoff, wA); PE_AUX(t0 + k + 2, auxA, aux2A, csA); pe_load_ix(F, t0 + k + 3, ixB);
        PE_COMPUTE(t0 + k + 1, auxB, aux2B, csB, wB);
    }
    pe_load_rows(TAB, ixB, rowoff, wB); PE_AUX(t0 + PE_TPI - 1, auxB, aux2B, csB);
    PE_COMPUTE(t0 + PE_TPI - 2, auxA, aux2A, csA, wA);
    PE_COMPUTE(t0 + PE_TPI - 1, auxB, aux2B, csB, wB);
#undef PE_AUX
#undef PE_COMPUTE
}

template <bool PHASE_B> __device__ __forceinline__ void p6_sliced(Frame& F) {
    const unsigned x = xb_xcc_id() & 7u;
    gu32* Q = F.ctl + (PHASE_B ? CW_QB : CW_QA);
    for (unsigned s = 0; s < 8; ++s) {
        const int j = (int)((x + s) & 7u);
        for (;;) {
            unsigned c = 0;
            if (F.lane == 0) c = __hip_atomic_fetch_add((unsigned*)(Q + 64 * j), 1u, __ATOMIC_RELAXED, __HIP_MEMORY_SCOPE_AGENT);
            c = (unsigned)__builtin_amdgcn_readfirstlane((int)c);
            if (c >= (unsigned)PE_NITEM) break;
            pe_item<PHASE_B>(F, j, (int)c * PE_TPI);
        }
    }
}

__device__ __forceinline__ void p6_reduce(Frame& F) {
    const int gw = F.vcu * NWAVES + F.wave, NGW = F.G * NWAVES, lane = F.lane;
    const int p0 = 16 * (lane >> 3) + (lane & 7);
    constexpr int NB = 4;
    for (int tb = gw * NB; tb < TOK; tb += NGW * NB) {
        int s[NB][2], e[NB][2]; float gt[NB][2], hs[NB];
#pragma unroll
        for (int b = 0; b < NB; ++b) {
            const int t = tb + b; hs[b] = F.HS[t];
            int a0 = 0, a1 = 0;
#pragma unroll
            for (int j = 0; j < 8; ++j) { const unsigned w = __builtin_nontemporal_load((const GAS unsigned*)F.PA + ((size_t)j * TOK + t) * 64 + lane); a0 += (int)(short)(w & 0xffffu); a1 += (int)w >> 16; }
            s[b][0] = a0; s[b][1] = a1;
#pragma unroll
            for (int hh = 0; hh < 2; ++hh) { const int p = p0 + 8 * hh; e[b][hh] = (int)F.EIDX[(size_t)t * 128 + p]; gt[b][hh] = F.GATE[(size_t)t * 128 + p]; }
        }
        float su[NB][2], sv[NB][2];
#pragma unroll
        for (int b = 0; b < NB; ++b)
#pragma unroll
            for (int hh = 0; hh < 2; ++hh) { su[b][hh] = ((const float*)(F.ws + WS_SCU))[e[b][hh]]; sv[b][hh] = ((const float*)(F.ws + WS_SCV))[e[b][hh]]; }
#pragma unroll
        for (int b = 0; b < NB; ++b) {
            const int t = tb + b;
            float cf[2]; float mx = 0.f;
#pragma unroll
            for (int hh = 0; hh < 2; ++hh) { const float a = hs[b] * su[b][hh] * (64.0f * (float)s[b][hh]);
                cf[hh] = gt[b][hh] * 0.5f * a * (1.0f + erff(a * 0.70710678118654752f)) * sv[b][hh]; mx = fmaxf(mx, fabsf(cf[hh])); }
#pragma unroll
            for (int o = 1; o < 64; o <<= 1) mx = fmaxf(mx, __shfl_xor(mx, o));
            const float sc = fmaxf(mx, 1e-30f) * (1.0f / 127.0f), inv = 1.0f / sc;
#pragma unroll
            for (int hh = 0; hh < 2; ++hh) {
                int v = ((int)rintf(cf[hh] * inv) & 0xff) << (8 * (lane & 3));
                v |= dpp_i<DPP_XOR1>(v); v |= dpp_i<DPP_XOR2>(v);
                if ((lane & 3) == 0) F.CQ[(size_t)t * 32 + ((p0 + 8 * hh) >> 2)] = (unsigned)v;
            }
            if (lane == 0) F.CS[t] = sc;
        }
    }
}

__device__ __forceinline__ void p5_scales(Frame& F) {
    const int gt = F.vcu * NWAVES * 64 + F.tid, NGT = F.G * NWAVES * 64;
    for (int t = gt; t < TOK; t += NGT) {
        float mx = 0.f, ss = 0.f;
#pragma unroll
        for (int q = 0; q < 4; ++q) { const f32x4 m = *(const GAS f32x4*)(F.MAXP + (size_t)t * 16 + 4 * q), p = *(const GAS f32x4*)(F.SSQ2P + (size_t)t * 16 + 4 * q);
            mx = fmaxf(mx, fmaxf(fmaxf(m[0], m[1]), fmaxf(m[2], m[3]))); ss += (p[0] + p[1]) + (p[2] + p[3]); }
        const float rstd2 = 1.0f / sqrtf(ss * (1.0f / DM) + pg8::EPS_F), sc = fmaxf(mx, 1e-20f) * (1.0f / 127.0f);
        F.HINV[t] = 1.0f / sc; F.HS[t] = sc * rstd2;
    }
}

#ifndef PROBE_REPEAT
#define PROBE_REPEAT -1
#endif
struct Args { const float* in[16]; float* out; unsigned char* ws; int ph_lo, ph_hi; };

template <class Sched> __device__ __forceinline__ void prep_tab_outproj(Frame& F, const Sched& S) {
    LAS float* tab = (LAS float*)(F.lds + TAB_OFF);
    pg8::Unit u;
    for (int i = 0; S.next(i, u) && i < 4; ++i) {
        if (F.tid < 256) {
            const int row = u.pm * 256 + F.tid;
            const f32x4 a0 = *(const GAS f32x4*)(F.SSQA + (size_t)row * 8), a1 = *(const GAS f32x4*)(F.SSQA + (size_t)row * 8 + 4);
            const f32x4 s0 = *(const GAS f32x4*)(F.SSQS + (size_t)row * 8), s1 = *(const GAS f32x4*)(F.SSQS + (size_t)row * 8 + 4);
            const float sa = ((a0[0] + a0[1]) + (a0[2] + a0[3])) + ((a1[0] + a1[1]) + (a1[2] + a1[3]));
            const float ss = ((s0[0] + s0[1]) + (s0[2] + s0[3])) + ((s1[0] + s1[1]) + (s1[2] + s1[3]));
            const float ra = 1.0f / sqrtf(sa * (1.0f / 512.0f) + pg8::EPS_F), rs = 1.0f / sqrtf(ss * (1.0f / 512.0f) + pg8::EPS_F);
            tab[(i * 256 + F.tid) * 2] = ra / rs; tab[(i * 256 + F.tid) * 2 + 1] = rs;
        }
    }
    LDS_WAIT(); __syncthreads();
}
template <class Sched> __device__ __forceinline__ void prep_tab_query(Frame& F, const Sched& S) {
    LAS float* tab = (LAS float*)(F.lds + TAB_OFF);
    pg8::Unit u;
    for (int i = 0; S.next(i, u) && i < 8; ++i) {
        if (F.tid < 256) {
            const int row = u.pm * 256 + F.tid; float s = 0.f;
#pragma unroll
            for (int j = 0; j < 4; ++j) { const f32x4 p = *(const GAS f32x4*)(F.SSQ2P + (size_t)row * 16 + 4 * j); s += (p[0] + p[1]) + (p[2] + p[3]); }
            tab[i * 256 + F.tid] = 1.0f / sqrtf(s * (1.0f / DM) + pg8::EPS_F);
        }
    }
    LDS_WAIT(); __syncthreads();
}

template <class Sched> __device__ __forceinline__ void prep_tab_inproj(Frame& F, const Sched& S) {
    LAS float* tab = (LAS float*)(F.lds + TAB_OFF);
    LAS float* gtab = (LAS float*)(F.lds + TAB_OFF + 8192);
    pg8::Unit u;
    for (int i = 0; S.next(i, u) && i < 8; ++i)
        if (F.tid < 256) tab[i * 256 + F.tid] = F.RSTD1[u.pm * 256 + F.tid];
    for (int i = F.tid; i < 640; i += NWAVES * 64) gtab[i] = (i < 64) ? F.q_norm_g[i] * pg8::QSCALE : (i < 128) ? F.k_norm_g[i - 64] : F.sgu_norm_g[i - 128];
    LDS_WAIT(); __syncthreads();
}
__device__ __forceinline__ void run_p1(Frame& F) {
    pg8::Gemm g{F.XB, F.Win_t, TOK, INW, DM}; pg8::StaticOrder S; S.init(TOK, INW, F.G, (int)blockIdx.x);
    prep_tab_inproj(F, S);
    pg8::EpiInProj E{(const LAS float*)(F.lds + TAB_OFF), (const LAS float*)(F.lds + TAB_OFF + 8192), F.Q, WS_TYPE_STRIDE / 2};
    pg8::gemm_phase<pg8::EpiInProj, pg8::StaticOrder, true, true>(F.lds + RING_OFF, g, S, E);
}
__device__ __forceinline__ void run_p3(Frame& F) {
    pg8::Gemm g{F.MIX, F.Wout_t, TOK, DM, DM}; pg8::StaticOrder S; S.init(TOK, DM, F.G, (int)blockIdx.x);
    prep_tab_outproj(F, S);
    pg8::EpiOutProj E{F.x, F.out, F.XB, F.SSQ2P, F.MAXP, (const LAS float*)(F.lds + TAB_OFF)};
    pg8::gemm_phase<pg8::EpiOutProj, pg8::StaticOrder, true, true>(F.lds + RING_OFF, g, S, E);
}
__device__ __forceinline__ void run_p4(Frame& F) {
    pg8::Gemm g{F.XB, F.Wq_t, TOK, QPW, DM}; pg8::StaticOrder S; S.init(TOK, QPW, F.G, (int)blockIdx.x);
    prep_tab_query(F, S);
    pg8::EpiQuery E{F.QP, (const LAS float*)(F.lds + TAB_OFF)};
    pg8::gemm_phase<pg8::EpiQuery, pg8::StaticOrder, true, true>(F.lds + RING_OFF, g, S, E);
}

__global__ void __launch_bounds__(NWAVES * 64, 2) hyb_fwd(Args args) {
    extern __shared__ __attribute__((aligned(16))) unsigned char lds[];
    Frame F;
    F.lds = (LAS unsigned char*)lds;
    F.MISC = (volatile LAS unsigned*)(F.lds + MISC_OFF);
    F.tid = threadIdx.x; F.lane = F.tid & 63; F.wave = __builtin_amdgcn_readfirstlane(F.tid >> 6);
    F.G = gridDim.x; { const int bx = blockIdx.x; F.vcu = (F.G % 8 == 0) ? (bx % 8) * (F.G / 8) + bx / 8 : bx; }
    unsigned char* ws = args.ws;
    F.ctl = (gu32*)(ws + WS_CTL);
    F.x = args.in[0]; F.norm1_g = args.in[1]; F.w_in = args.in[2]; F.q_norm_g = args.in[3]; F.k_norm_g = args.in[4]; F.sgu_norm_g = args.in[5]; F.sgu_w = args.in[6]; F.sgu_b = args.in[7];
    F.attn_out_g = args.in[8]; F.sgu_out_g = args.in[9]; F.w_out = args.in[10]; F.norm2_g = args.in[11]; F.w_query = args.in[12]; F.sub_keys = args.in[13]; F.expert_u = args.in[14]; F.expert_v = args.in[15];
    F.out = args.out;
    F.Win_t = (bf16*)(ws + WS_WIN); F.Wout_t = (bf16*)(ws + WS_WOUT); F.Wq_t = (bf16*)(ws + WS_WQ); F.SK = (bf16*)(ws + WS_SK); F.SGUW = (bf16*)(ws + WS_SGUW);
    F.U8 = (signed char*)(ws + WS_UB); F.V8 = (signed char*)(ws + WS_VB); F.ws = ws;
    F.H8 = (signed char*)(ws + WS_H8); F.MAXP = (float*)(ws + WS_MAXP); F.HINV = (float*)(ws + WS_HINV); F.HS = (float*)(ws + WS_HS); F.PA = (int*)(ws + WS_PA); F.CQ = (unsigned*)(ws + WS_COEF); F.CS = (float*)(ws + WS_COEF0);
    F.XB = (bf16*)(ws + WS_XB); F.Q = (bf16*)(ws + WS_Q); F.QP = (bf16*)(ws + WS_QP); F.MIX = (bf16*)(ws + WS_MIX);
    F.RSTD1 = (float*)(ws + WS_RSTD1); F.SSQA = (float*)(ws + WS_SSQA); F.SSQS = (float*)(ws + WS_SSQS); F.SSQ2P = (float*)(ws + WS_SSQ2P); F.GATE = (float*)(ws + WS_GATE); F.EIDX = (unsigned short*)(ws + WS_EIDX);
    for (int u = F.tid; u < (LDS_BYTES - LDSCTL_OFF) / 4; u += NWAVES * 64) ((LAS unsigned*)(F.lds + LDSCTL_OFF))[u] = 0u;
    __syncthreads();
    XcdBarrier bar; bar.bar = (unsigned*)(F.ctl + CW_BAR); bar.x = 0; bar.st = nullptr;
    const int lo = args.ph_lo, hi = args.ph_hi;
    if (hi - lo > 1) bar = xcd_barrier_post((unsigned*)(F.ctl + CW_BAR), F.MISC + 8);
#define IN(k) (lo <= (k) && (k) < hi)

#define SEAM(k) do { if (IN(k) && IN((k) + 1)) { xcd_barrier(bar); if (PROBE_REPEAT == 100 + (k)) { xcd_barrier(bar); xcd_barrier(bar); xcd_barrier(bar); xcd_barrier(bar); } } } while (0)

    if (IN(0)) { p0_prologue(F); if (PROBE_REPEAT == 0) { xcd_barrier(bar); p0_prologue(F); } } SEAM(0);
    if (IN(1)) { run_p1(F); if (PROBE_REPEAT == 1) { xcd_barrier(bar); run_p1(F); } } SEAM(1);
    if (IN(2)) { p2_mixers(F); if (PROBE_REPEAT == 2) { xcd_barrier(bar); p2_mixers(F); } } SEAM(2);
    if (IN(3)) { run_p3(F); if (PROBE_REPEAT == 3) { xcd_barrier(bar); run_p3(F); } } SEAM(3);
    if (IN(4)) { run_p4(F); if (PROBE_REPEAT == 4) { xcd_barrier(bar); run_p4(F); } }
    if (!(IN(4) && IN(5))) {   } else { asm volatile("s_waitcnt vmcnt(0)" ::: "memory"); __syncthreads(); }
    if (IN(5)) {
#pragma unroll 1
        for (int rep = 0; rep < (PROBE_REPEAT == 5 ? 2 : 1); ++rep) p5_topk(F);
#pragma unroll 1
        for (int rep = 0; rep < (PROBE_REPEAT == 15 ? 2 : 1); ++rep) p5_scales(F);
    } SEAM(5);
    if (IN(6)) {
#pragma unroll 1
        for (int rep = 0; rep < (PROBE_REPEAT == 6 ? 2 : 1); ++rep) {
            if (rep) { xcd_barrier(bar); if (blockIdx.x == 0 && F.tid < 8) __hip_atomic_store((unsigned*)(F.ctl + CW_QA + 64 * F.tid), 0u, __ATOMIC_RELAXED, __HIP_MEMORY_SCOPE_AGENT); xcd_barrier(bar); }
            p6_sliced<false>(F);
        }
        if (hi - lo > 1) xcd_barrier(bar);
#pragma unroll 1
        for (int rep = 0; rep < (PROBE_REPEAT == 7 ? 2 : 1); ++rep) p6_reduce(F);
        if (hi - lo > 1) xcd_barrier(bar);
#pragma unroll 1
        for (int rep = 0; rep < (PROBE_REPEAT == 8 ? 2 : 1); ++rep) {
            if (rep) { xcd_barrier(bar); if (blockIdx.x == 0 && F.tid < 8) __hip_atomic_store((unsigned*)(F.ctl + CW_QB + 64 * F.tid), 0u, __ATOMIC_RELAXED, __HIP_MEMORY_SCOPE_AGENT); xcd_barrier(bar); }
            p6_sliced<true>(F);
        }
    }
#undef IN
#undef SEAM
}

extern "C" void kernel_launch(void* const* d_in, const int* in_sizes, int n_in, void* d_out, int out_size, void* d_ws, size_t ws_size, hipStream_t stream) {
    static int grid = 0;
    if (grid == 0) {
        if (n_in != 16 || in_sizes[0] != TOK * DM || out_size != TOK * DM || ws_size < WS_END) { fprintf(stderr, "kernel_launch: unexpected shapes (n_in %d, in0 %d, out %d, ws %zu)\n", n_in, n_in > 0 ? in_sizes[0] : -1, out_size, ws_size); grid = -1; return; }
        int dev = 0, cus = 0, per_cu = 0;
        if (hipGetDevice(&dev) != hipSuccess || hipDeviceGetAttribute(&cus, hipDeviceAttributeMultiprocessorCount, dev) != hipSuccess) { fprintf(stderr, "kernel_launch: device query failed\n"); grid = -1; return; }
        if (hipFuncSetAttribute((const void*)hyb_fwd, hipFuncAttributeMaxDynamicSharedMemorySize, LDS_BYTES) != hipSuccess) { fprintf(stderr, "kernel_launch: hipFuncSetAttribute failed\n"); grid = -1; return; }
        if (hipOccupancyMaxActiveBlocksPerMultiprocessor(&per_cu, (const void*)hyb_fwd, NWAVES * 64, LDS_BYTES) != hipSuccess || per_cu < 1) { fprintf(stderr, "kernel_launch: occupancy query reports %d blocks per CU\n", per_cu); per_cu = 1; }
        (void)hipGetLastError();
        grid = cus;
        if (grid % 8 != 0) grid -= grid % 8;
    }
    if (grid < 0) return;
    (void)hipMemsetAsync((char*)d_ws + WS_CTL, 0, CTL_ZERO_BYTES, stream);
    Args a{};
    for (int i = 0; i < 16; ++i) a.in[i] = (const float*)d_in[i];
    a.out = (float*)d_out; a.ws = (unsigned char*)d_ws;
    if (N_LAUNCHES == 1) { a.ph_lo = 0; a.ph_hi = NPHASE; hipLaunchKernelGGL(hyb_fwd, dim3(grid), dim3(NWAVES * 64), LDS_BYTES, stream, a); }
    else for (int li = 0; li < NPHASE; ++li) { a.ph_lo = li; a.ph_hi = li + 1; hipLaunchKernelGGL(hyb_fwd, dim3(grid), dim3(NWAVES * 64), LDS_BYTES, stream, a); }
}
```

```cpp
#include <hip/hip_runtime.h>
#include <cstdio>
#include <cstdint>
#include <cmath>
namespace pg8 {
#define PG8_LAS __attribute__((address_space(3)))
typedef unsigned short bf16_t;
typedef short bf16x8 __attribute__((ext_vector_type(8)));
typedef float f32x4 __attribute__((ext_vector_type(4)));
typedef unsigned u32x4 __attribute__((ext_vector_type(4)));
constexpr int BM = 256, BK = 64, HALF = 128, HTB = HALF * BK * 2  , STAGE_BYTES = 8 * HTB, NXCD = 8, WGM = 8;

__host__ __device__ __forceinline__ int lds_byte(int r, int c) { const int st = (r >> 4) * 2 + (c >> 5), rr = r & 15, cc = c & 31, ob = rr * 64 + cc * 2; return st * 1024 + (ob ^ (((ob >> 9) & 1) << 5)); }
__host__ __device__ __forceinline__ void stage_rc(int b, int& R, int& C) { const int st = b / 1024, sb = b % 1024, swz = sb ^ (((sb >> 9) & 1) << 5); R = (st >> 1) * 16 + swz / 64; C = (st & 1) * 32 + (swz % 64) / 2; }
__host__ __device__ __forceinline__ int perm32(int rho) { const int n = rho >> 4, i = rho & 15; return 8 * (i >> 2) + 4 * n + (i & 3); }

struct Unit { int pm, pn; };
struct Gemm { const bf16_t* A; const bf16_t* Bt; int M, N, K; };

struct StaticOrder {
    int nM, nN, nwg, G, c;
    __host__ __device__ void init(int M, int N, int G_, int c_) { nM = M / BM; nN = N / BM; nwg = nM * nN; G = G_; c = c_; }
    __host__ __device__ bool next(int i, Unit& u) const {
        const long L = (long)i * G + c; if (L >= nwg) return false;
        int wgid = (int)L; { const int q = nwg / NXCD, r = nwg % NXCD, xcd = wgid % NXCD, off = wgid / NXCD; wgid = (xcd < r ? xcd * (q + 1) : r * (q + 1) + (xcd - r) * q) + off; }
        const int nig = WGM * nN, gid = wgid / nig, fm = gid * WGM, gsz = (nM - fm) < WGM ? (nM - fm) : WGM;
        u.pm = fm + ((wgid % nig) % gsz); u.pn = (wgid % nig) / gsz; return true;
    }
    __device__ __forceinline__ void a_ready(const Unit&) const {}
    __device__ __forceinline__ void done(const Unit&) const {}
};


__device__ __forceinline__ unsigned cvt_pk_bf16(float lo, float hi) { unsigned r; asm volatile("v_cvt_pk_bf16_f32 %0, %1, %2" : "=v"(r) : "v"(lo), "v"(hi)); return r; }

constexpr float EPS_F = 1e-6f;
constexpr float QSCALE = 0.125f * 1.4426950408889634f;

struct EpiInProj {
    static constexpr bool PERM = true; static constexpr int MID_T = 0;
    const PG8_LAS float* tab;
    const PG8_LAS float* gtab;
    bf16_t* out0; size_t type_stride;
    __device__ __forceinline__ void operator()(const f32x4 (&acc)[2][2][4][2], const Unit& u, int ui, int wr, int wc, int fr, int fq) const {
        const int type = u.pn >> 1, half = u.pn & 1;
        bf16_t* base = out0 + (size_t)type * type_stride;
        const int colb = 256 * half + 64 * wc + 8 * fq;
        const bool normed = (type == 0) || (type == 1) || (type == 4);
        const int goff = (type == 0) ? 8 * fq : (type == 1) ? 64 + 8 * fq : 128 + colb;
        float g[2][8];
#pragma unroll
        for (int bj = 0; bj < 2; ++bj) {
            const f32x4 g0 = *(const PG8_LAS f32x4*)(gtab + goff + 32 * bj), g1 = *(const PG8_LAS f32x4*)(gtab + goff + 32 * bj + 4);
#pragma unroll
            for (int e = 0; e < 4; ++e) { g[bj][e] = normed ? g0[e] : 1.f; g[bj][4 + e] = normed ? g1[e] : 1.f; }
        }
#pragma unroll
        for (int ai = 0; ai < 2; ++ai)
#pragma unroll
            for (int m = 0; m < 4; ++m) {
                const int lr = ai * HALF + wr * 64 + m * 16 + fr, row = u.pm * BM + lr;
                const float rs = tab[ui * 256 + lr];
                f32x4 v[2][2];
                float ss = 0.f;
#pragma unroll
                for (int bj = 0; bj < 2; ++bj)
#pragma unroll
                    for (int n = 0; n < 2; ++n) { v[bj][n] = acc[ai][bj][m][n] * rs; const f32x4 x = v[bj][n]; ss += (x[0] * x[0] + x[1] * x[1]) + (x[2] * x[2] + x[3] * x[3]); }
                float r = 1.f;
                if (normed) { ss += __shfl_xor(ss, 16); ss += __shfl_xor(ss, 32); r = 1.0f / sqrtf(ss * (1.0f / 64.0f) + EPS_F); }
                bf16_t* rowp = base + (size_t)row * 512 + colb;
#pragma unroll
                for (int bj = 0; bj < 2; ++bj) {
                    const f32x4 a = v[bj][0], b = v[bj][1];
                    u32x4 w;
                    w.x = cvt_pk_bf16(a[0] * r * g[bj][0], a[1] * r * g[bj][1]); w.y = cvt_pk_bf16(a[2] * r * g[bj][2], a[3] * r * g[bj][3]);
                    w.z = cvt_pk_bf16(b[0] * r * g[bj][4], b[1] * r * g[bj][5]); w.w = cvt_pk_bf16(b[2] * r * g[bj][6], b[3] * r * g[bj][7]);
                    *(u32x4*)(rowp + 32 * bj) = w;
                }
            }
    }
};

struct EpiOutProj {
    static constexpr bool PERM = true; static constexpr int MID_T = 8;
    const float* x; float* x1; bf16_t* x1b; float* ssq2p; float* maxp; const PG8_LAS float* tab;
    __device__ __forceinline__ void mid(f32x4 (&acc)[2][2][4][2], const Unit&, int ui, int wr, int, int fr, int) const {
#pragma unroll
        for (int ai = 0; ai < 2; ++ai)
#pragma unroll
            for (int m = 0; m < 4; ++m) {
                const float rt = tab[(ui * 256 + ai * HALF + wr * 64 + m * 16 + fr) * 2];
#pragma unroll
                for (int bj = 0; bj < 2; ++bj)
#pragma unroll
                    for (int n = 0; n < 2; ++n) acc[ai][bj][m][n] *= rt;
            }
    }
    __device__ __forceinline__ void operator()(const f32x4 (&acc)[2][2][4][2], const Unit& u, int ui, int wr, int wc, int fr, int fq) const {
        const size_t cbase = (size_t)u.pn * BM + wc * 32 + 8 * fq;
        u32x4 xn[2];
#define OP_LOADX(it_) do { const int r_ = u.pm * BM + ((it_) >> 2) * HALF + wr * 64 + ((it_) & 3) * 16 + fr; \
            _Pragma("unroll") for (int bj = 0; bj < 2; ++bj) xn[bj] = *(const u32x4*)(x1b + (size_t)r_ * 1024 + cbase + bj * HALF); } while (0)
        OP_LOADX(0);
#pragma unroll
        for (int it = 0; it < 8; ++it) {
            const int ai = it >> 2, m = it & 3;
            const int lr = ai * HALF + wr * 64 + m * 16 + fr, row = u.pm * BM + lr;
            const float rs = tab[(ui * 256 + lr) * 2 + 1];
            u32x4 xc[2];
#pragma unroll
            for (int bj = 0; bj < 2; ++bj) xc[bj] = xn[bj];
            if (it + 1 < 8) OP_LOADX(it + 1);
            float ss = 0.f, mx = 0.f;
#pragma unroll
            for (int bj = 0; bj < 2; ++bj) {
                const size_t off = (size_t)row * 1024 + cbase + bj * HALF;
                f32x4 xa, xb_; xa[0] = __builtin_bit_cast(float, xc[bj].x << 16); xa[1] = __builtin_bit_cast(float, xc[bj].x & 0xffff0000u); xa[2] = __builtin_bit_cast(float, xc[bj].y << 16); xa[3] = __builtin_bit_cast(float, xc[bj].y & 0xffff0000u);
                xb_[0] = __builtin_bit_cast(float, xc[bj].z << 16); xb_[1] = __builtin_bit_cast(float, xc[bj].z & 0xffff0000u); xb_[2] = __builtin_bit_cast(float, xc[bj].w << 16); xb_[3] = __builtin_bit_cast(float, xc[bj].w & 0xffff0000u);
                const f32x4 a = xa + acc[ai][bj][m][0] * rs, b = xb_ + acc[ai][bj][m][1] * rs;
                ss += (a[0] * a[0] + a[1] * a[1]) + (a[2] * a[2] + a[3] * a[3]) + (b[0] * b[0] + b[1] * b[1]) + (b[2] * b[2] + b[3] * b[3]);
                mx = fmaxf(mx, fmaxf(fmaxf(fmaxf(fabsf(a[0]), fabsf(a[1])), fmaxf(fabsf(a[2]), fabsf(a[3]))), fmaxf(fmaxf(fabsf(b[0]), fabsf(b[1])), fmaxf(fabsf(b[2]), fabsf(b[3])))));
                u32x4 w; w.x = cvt_pk_bf16(a[0], a[1]); w.y = cvt_pk_bf16(a[2], a[3]); w.z = cvt_pk_bf16(b[0], b[1]); w.w = cvt_pk_bf16(b[2], b[3]);
                *(u32x4*)(x1b + off) = w;
            }
            ss += __shfl_xor(ss, 16); ss += __shfl_xor(ss, 32); mx = fmaxf(mx, __shfl_xor(mx, 16)); mx = fmaxf(mx, __shfl_xor(mx, 32));
            if (fq == 0) { ssq2p[(size_t)row * 16 + u.pn * 4 + wc] = ss; maxp[(size_t)row * 16 + u.pn * 4 + wc] = mx; }
        }
#undef OP_LOADX
    }
};

struct EpiQuery {
    static constexpr bool PERM = true; static constexpr int MID_T = 0;
    bf16_t* qp; const PG8_LAS float* tab;
    __device__ __forceinline__ void operator()(const f32x4 (&acc)[2][2][4][2], const Unit& u, int ui, int wr, int wc, int fr, int fq) const {
#pragma unroll
        for (int ai = 0; ai < 2; ++ai)
#pragma unroll
            for (int m = 0; m < 4; ++m) {
                const int lr = ai * HALF + wr * 64 + m * 16 + fr, row = u.pm * BM + lr;
                const float rs = tab[ui * 256 + lr];
#pragma unroll
                for (int bj = 0; bj < 2; ++bj) {
                    const size_t off = ((((size_t)(row >> 5) * 8 + u.pn) * 2 + bj) * 8 + 2 * wc + (fq >> 1)) * 512 + (size_t)(32 * (fq & 1) + (row & 31)) * 8;
                    const f32x4 a = acc[ai][bj][m][0] * rs, b = acc[ai][bj][m][1] * rs;
                    u32x4 w; w.x = cvt_pk_bf16(a[0], a[1]); w.y = cvt_pk_bf16(a[2], a[3]); w.z = cvt_pk_bf16(b[0], b[1]); w.w = cvt_pk_bf16(b[2], b[3]);
                    *(u32x4*)(qp + off) = w;
                }
            }
    }
};

template <class Epi, class Sched, bool ALIGN_EPI = false, bool SP2 = false>
__device__ __forceinline__ void gemm_phase(PG8_LAS unsigned char* lds, const Gemm g, const Sched& S, const Epi& E) {
    const int tid = threadIdx.x, wid = __builtin_amdgcn_readfirstlane(tid >> 6), lane = tid & 63, wr = wid >> 2, wc = wid & 3, fr = lane & 15, fq = lane >> 4;
    const int K = g.K, nt = K / BK;
    unsigned voffA[2], voffB[2];
#pragma unroll
    for (int i = 0; i < 2; ++i) { int R, C; stage_rc(tid * 16 + i * 8192, R, C); const int Rb = Epi::PERM ? ((R & ~31) + perm32(R & 31)) : R;
        voffA[i] = (unsigned)(R * K + C) * 2u; voffB[i] = (unsigned)(Rb * K + C) * 2u; }
    const size_t kstep = (size_t)(BK * 2);
    const size_t hstep = (size_t)HALF * K * 2;
    const size_t tstep = 2 * hstep;
    const unsigned ldsw = (unsigned)wid * 1024u;
    const int aoff = lds_byte(wr * 64 + fr, fq * 8), boff = lds_byte(wc * 32 + fr, fq * 8);
#define PG8_SA(b, h) (((b) * 2 + (h)) * HTB)
#define PG8_SB(b, h) ((4 + (b) * 2 + (h)) * HTB)
#define PG8_STAGE(bufoff, gbase, voff) do { _Pragma("unroll") for (int _i = 0; _i < 2; ++_i) \
        __builtin_amdgcn_global_load_lds((const unsigned*)((const char*)(gbase) + (voff)[_i]), (PG8_LAS unsigned*)(lds + (bufoff) + ldsw + _i * 8192), 16, 0, 0); } while (0)
#define PG8_LDA(dst, b, h) do { _Pragma("unroll") for (int m = 0; m < 4; ++m) _Pragma("unroll") for (int k = 0; k < 2; ++k) dst[m][k] = *(const PG8_LAS bf16x8*)(lds + PG8_SA(b, h) + aoff + m * 2048 + k * 1024); } while (0)
#define PG8_LDB(dst, b, h) do { _Pragma("unroll") for (int n = 0; n < 2; ++n) _Pragma("unroll") for (int k = 0; k < 2; ++k) dst[n][k] = *(const PG8_LAS bf16x8*)(lds + PG8_SB(b, h) + boff + n * 2048 + k * 1024); } while (0)
#define PG8_MMA(ai, bj, At, Bt) do { __builtin_amdgcn_s_setprio(1); _Pragma("unroll") for (int m = 0; m < 4; ++m) _Pragma("unroll") for (int n = 0; n < 2; ++n) _Pragma("unroll") for (int k = 0; k < 2; ++k) \
        acc[ai][bj][m][n] = __builtin_amdgcn_mfma_f32_16x16x32_bf16(Bt[n][k], At[m][k], acc[ai][bj][m][n], 0, 0, 0); __builtin_amdgcn_s_setprio(0); } while (0)
#define PG8_WAIT_V(n) asm volatile("s_waitcnt vmcnt(" #n ")" ::: "memory")
#define PG8_WAIT_L(n) asm volatile("s_waitcnt lgkmcnt(" #n ")" ::: "memory")
#define PG8_BAR __builtin_amdgcn_s_barrier()
#define PG8_SCHED __builtin_amdgcn_sched_barrier(0)
    Unit cur, nxt; int ui = 0;
    if (!S.next(0, cur)) return;
    f32x4 acc[2][2][4][2];
#pragma unroll
    for (int a = 0; a < 2; ++a)
#pragma unroll
        for (int b = 0; b < 2; ++b)
#pragma unroll
            for (int m = 0; m < 4; ++m)
#pragma unroll
                for (int n = 0; n < 2; ++n) acc[a][b][m][n] = (f32x4){0.f, 0.f, 0.f, 0.f};
    bf16x8 At[4][2], B0[2][2], B1[2][2];
    const char* cA = (const char*)g.A + (size_t)cur.pm * tstep; const char* cB = (const char*)g.Bt + (size_t)cur.pn * tstep;
    S.a_ready(cur);
    if constexpr (SP2) {
        PG8_STAGE(PG8_SB(0, 0), cB, voffB); PG8_STAGE(PG8_SB(0, 1), cB + hstep, voffB); PG8_STAGE(PG8_SA(0, 0), cA, voffA); PG8_STAGE(PG8_SA(0, 1), cA + hstep, voffA);
        if (wr == 1) PG8_BAR;
        PG8_WAIT_V(2); PG8_BAR;
        PG8_STAGE(PG8_SB(1, 0), cB + kstep, voffB); PG8_STAGE(PG8_SA(1, 0), cA + kstep, voffA); PG8_STAGE(PG8_SB(1, 1), cB + hstep + kstep, voffB);
        PG8_WAIT_V(6); PG8_BAR;
    } else {
        PG8_STAGE(PG8_SB(0, 0), cB, voffB); PG8_STAGE(PG8_SA(0, 0), cA, voffA); PG8_STAGE(PG8_SB(0, 1), cB + hstep, voffB); PG8_STAGE(PG8_SA(0, 1), cA + hstep, voffA);
        if (wr == 1) PG8_BAR;
        PG8_WAIT_V(4); PG8_BAR;
        PG8_STAGE(PG8_SB(1, 0), cB + kstep, voffB); PG8_STAGE(PG8_SA(1, 0), cA + kstep, voffA); PG8_STAGE(PG8_SB(1, 1), cB + hstep + kstep, voffB);
        PG8_WAIT_V(6); PG8_BAR;
    }
    for (;;) {
        const bool has_next = S.next(ui + 1, nxt);
        const char* nA = has_next ? (const char*)g.A + (size_t)nxt.pm * tstep : cA; const char* nB = has_next ? (const char*)g.Bt + (size_t)nxt.pn * tstep : cB;
        for (int t = 0; t < nt; t += 2) {
            if constexpr (Epi::MID_T > 0) { if (t == Epi::MID_T) E.mid(acc, cur, ui, wr, wc, fr, fq); }
            const bool last = (t == nt - 2);
            const char* a1 = cA + (size_t)(t + 1) * kstep;
            const char* a2 = last ? nA : cA + (size_t)(t + 2) * kstep; const char* b2 = last ? nB : cB + (size_t)(t + 2) * kstep;
            const char* a3 = a2 + kstep; const char* b3 = b2 + kstep;
            if (last && has_next) S.a_ready(nxt);
            if constexpr (SP2) {
            PG8_LDB(B0, 0, 0); PG8_LDB(B1, 0, 1); PG8_SCHED; PG8_LDA(At, 0, 0); PG8_STAGE(PG8_SA(1, 1), a1 + hstep, voffA);
            PG8_WAIT_V(8); PG8_WAIT_L(0); PG8_BAR; PG8_MMA(0, 0, At, B0); PG8_MMA(0, 1, At, B1); PG8_BAR; PG8_SCHED;
            PG8_LDA(At, 0, 1); PG8_STAGE(PG8_SB(0, 0), b2, voffB); PG8_STAGE(PG8_SB(0, 1), b2 + hstep, voffB); PG8_STAGE(PG8_SA(0, 0), a2, voffA);
            PG8_WAIT_V(8); PG8_WAIT_L(0); PG8_BAR; PG8_MMA(1, 0, At, B0); PG8_MMA(1, 1, At, B1); PG8_BAR; PG8_SCHED;
            PG8_LDB(B0, 1, 0); PG8_LDB(B1, 1, 1); PG8_SCHED; PG8_LDA(At, 1, 0); PG8_STAGE(PG8_SA(0, 1), a2 + hstep, voffA);
            PG8_WAIT_V(8); PG8_WAIT_L(0); PG8_BAR; PG8_MMA(0, 0, At, B0); PG8_MMA(0, 1, At, B1); PG8_BAR; PG8_SCHED;
            PG8_LDA(At, 1, 1); PG8_STAGE(PG8_SB(1, 0), b3, voffB); PG8_STAGE(PG8_SB(1, 1), b3 + hstep, voffB); PG8_STAGE(PG8_SA(1, 0), a3, voffA);
            PG8_WAIT_V(8); PG8_WAIT_L(0); PG8_BAR; PG8_MMA(1, 0, At, B0); PG8_MMA(1, 1, At, B1); PG8_BAR; PG8_SCHED;
            } else {
            PG8_LDB(B0, 0, 0); PG8_SCHED; PG8_LDA(At, 0, 0); PG8_STAGE(PG8_SA(1, 1), a1 + hstep, voffA);
            PG8_WAIT_L(8); PG8_BAR; PG8_WAIT_L(0); PG8_MMA(0, 0, At, B0); PG8_BAR; PG8_SCHED;
            PG8_LDB(B1, 0, 1); PG8_STAGE(PG8_SB(0, 0), b2, voffB);
            PG8_BAR; PG8_WAIT_L(0); PG8_MMA(0, 1, At, B1); PG8_BAR;
            PG8_LDA(At, 0, 1); PG8_STAGE(PG8_SA(0, 0), a2, voffA);
            PG8_BAR; PG8_WAIT_L(0); PG8_MMA(1, 0, At, B0); PG8_BAR; PG8_SCHED;
            PG8_STAGE(PG8_SB(0, 1), b2 + hstep, voffB);
            PG8_WAIT_V(6); PG8_BAR; PG8_MMA(1, 1, At, B1); PG8_BAR;
            PG8_LDB(B0, 1, 0); PG8_SCHED; PG8_LDA(At, 1, 0); PG8_STAGE(PG8_SA(0, 1), a2 + hstep, voffA);
            PG8_WAIT_L(8); PG8_BAR; PG8_WAIT_L(0); PG8_MMA(0, 0, At, B0); PG8_BAR; PG8_SCHED;
            PG8_LDB(B1, 1, 1); PG8_STAGE(PG8_SB(1, 0), b3, voffB);
            PG8_BAR; PG8_WAIT_L(0); PG8_MMA(0, 1, At, B1); PG8_BAR;
            PG8_LDA(At, 1, 1); PG8_STAGE(PG8_SA(1, 0), a3, voffA);
            PG8_BAR; PG8_WAIT_L(0); PG8_MMA(1, 0, At, B0); PG8_BAR; PG8_SCHED;
            PG8_STAGE(PG8_SB(1, 1), b3 + hstep, voffB);
            PG8_WAIT_V(6); PG8_BAR; PG8_MMA(1, 1, At, B1); PG8_BAR;
            }
        }
        if constexpr (ALIGN_EPI) { if (wr == 0) PG8_BAR; }
        E(acc, cur, ui, wr, wc, fr, fq); S.done(cur);
        if (!has_next) break;
#pragma unroll
        for (int a = 0; a < 2; ++a)
#pragma unroll
            for (int b = 0; b < 2; ++b)
#pragma unroll
                for (int m = 0; m < 4; ++m)
#pragma unroll
                    for (int n = 0; n < 2; ++n) acc[a][b][m][n] = (f32x4){0.f, 0.f, 0.f, 0.f};
        cur = nxt; cA = nA; cB = nB; ++ui;
        if constexpr (ALIGN_EPI) { if (wr == 1) PG8_BAR; }
    }
    PG8_WAIT_V(0);
    if constexpr (!ALIGN_EPI) { if (wr == 0) PG8_BAR; }
    PG8_BAR;
#undef PG8_SA
#undef PG8_SB
#undef PG8_STAGE
#undef PG8_LDA
#undef PG8_LDB
#undef PG8_MMA
#undef PG8_WAIT_V
#undef PG8_WAIT_L
#undef PG8_BAR
#undef PG8_SCHED
}
}

constexpr int NWAVES = 8;
constexpr int DM = 1024, BATCH = 8, SEQ = 4096, TOK = BATCH * SEQ;
constexpr int AW = 512, INW = 2560, QPW = 2048, NEXP = 16384;
constexpr int NPHASE = 7;
#ifndef MK_N_LAUNCHES
#define MK_N_LAUNCHES 1
#endif
constexpr int N_LAUNCHES = MK_N_LAUNCHES;

constexpr size_t MiB = 1u << 20;
constexpr size_t WS_CTL = 0, CTL_ZERO_BYTES = 64 * 1024;
constexpr size_t WS_WIN = 2 * MiB, WS_WOUT = 8 * MiB, WS_WQ = 10 * MiB, WS_SK = 14 * MiB, WS_SGUW = 14 * MiB + 512 * 1024, WS_RSTD1 = 15 * MiB;
constexpr size_t WS_SCU = 15 * MiB + 256 * 1024, WS_SCV = 15 * MiB + 512 * 1024;
constexpr size_t WS_UB = 16 * MiB, WS_VB = 48 * MiB;
constexpr size_t WS_XB = 80 * MiB;
constexpr size_t WS_Q = 144 * MiB, WS_TYPE_STRIDE = 32 * MiB;
constexpr size_t WS_QP = 144 * MiB;
constexpr size_t WS_MIX = 304 * MiB;
constexpr size_t WS_SSQA = 368 * MiB, WS_SSQS = 369 * MiB, WS_SSQ2P = 370 * MiB, WS_MAXP = 372 * MiB, WS_HINV = 374 * MiB;
constexpr size_t WS_PA = 144 * MiB;
constexpr size_t WS_COEF = 304 * MiB, WS_COEF0 = 320 * MiB, WS_H8 = 324 * MiB, WS_HS = 356 * MiB;
constexpr size_t WS_EIDX = 376 * MiB, WS_GATE = 392 * MiB, WS_END = 408 * MiB;
constexpr int CW_BAR = 1024;

constexpr int RING_OFF = 0, RING_BYTES = 131072;
constexpr int TAB_OFF = RING_BYTES, TAB_BYTES = 8192;
constexpr int LDSCTL_OFF = 153600, MISC_OFF = LDSCTL_OFF + 64;
constexpr int LDS_BYTES = 155648;
static_assert(MISC_OFF + 128 <= LDS_BYTES, "LDS map");

#define GAS __attribute__((address_space(1)))
#define LAS __attribute__((address_space(3)))
typedef unsigned short bf16;
typedef unsigned v4u __attribute__((ext_vector_type(4)));
typedef unsigned v2u __attribute__((ext_vector_type(2)));
typedef float f32x4 __attribute__((ext_vector_type(4)));
typedef float f32x16 __attribute__((ext_vector_type(16)));
typedef short bf16x8 __attribute__((ext_vector_type(8)));
typedef short s16x4 __attribute__((ext_vector_type(4)));
typedef __bf16 bf16x2_t __attribute__((ext_vector_type(2)));
typedef GAS unsigned gu32;
#define RLX_AGENT __ATOMIC_RELAXED, __HIP_MEMORY_SCOPE_AGENT
#define LDS_WAIT() asm volatile("s_waitcnt lgkmcnt(0)" ::: "memory")
#define VM_WAIT() asm volatile("s_waitcnt vmcnt(0)" ::: "memory")
__device__ __forceinline__ unsigned f2bf(float f) { unsigned u = __builtin_bit_cast(unsigned, f); return (u + 0x7fffu + ((u >> 16) & 1u)) >> 16; }
__device__ __forceinline__ unsigned pk2(float lo, float hi) { return pg8::cvt_pk_bf16(lo, hi); }
__device__ __forceinline__ float bf_lo(unsigned w) { return __builtin_bit_cast(float, w << 16); }
__device__ __forceinline__ float bf_hi(unsigned w) { return __builtin_bit_cast(float, w & 0xffff0000u); }
__device__ __forceinline__ int crow(int r, int hi) { return (r & 3) + 8 * (r >> 2) + 4 * hi; }
#define XB_TMO      128
#define XB_XCNT(j)  (256  + 64 * (j))
#define XB_XSUB(j)  (1280 + 64 * (j))
#define XB_XGEN(j)  (2304 + 64 * (j))
#define XB_TOP      3328
#define XB_TOPGEN   3392
#define XCD_BAR_WORDS 3456
#define XB_SPIN_CAP (1u << 18)

__device__ __forceinline__ unsigned xb_ld(unsigned* p)              { return __hip_atomic_load(p, __ATOMIC_RELAXED, __HIP_MEMORY_SCOPE_AGENT); }
__device__ __forceinline__ unsigned xb_add(unsigned* p, unsigned v) { return __hip_atomic_fetch_add(p, v, __ATOMIC_RELAXED, __HIP_MEMORY_SCOPE_AGENT); }
__device__ __forceinline__ unsigned xb_xcc_id() { return (unsigned)__builtin_amdgcn_s_getreg((3 << 11) | 20) & 0xFu; }
#define XB_SPIN(cond, bar) do { unsigned _sp = 0; while (cond) { __builtin_amdgcn_s_sleep(1); \
    if ((++_sp & 255u) == 0u) { if (xb_ld(&(bar)[XB_TMO])) break; if (_sp > XB_SPIN_CAP) { atomicAdd(&(bar)[XB_TMO], 1u); break; } } } } while (0)

struct XcdBarrier {
    unsigned* bar; unsigned x;
    volatile LAS unsigned* st;
};

__device__ __forceinline__ XcdBarrier xcd_barrier_post(unsigned* bar, volatile LAS unsigned* st) {
    XcdBarrier b; b.bar = bar; b.x = xb_xcc_id(); b.st = st;
    if (threadIdx.x == 0) (void)xb_add(&bar[XB_XCNT(b.x)], 1u);
    return b;
}
__device__ __forceinline__ void xcd_barrier_complete(unsigned* bar, unsigned x, unsigned& nloc, unsigned& nx) {
    const unsigned G = gridDim.x * gridDim.y * gridDim.z;
    unsigned sum, cnt, mine, sp = 0u;
    for (;;) {
        sum = 0u; cnt = 0u; mine = 0u;
#pragma unroll
        for (unsigned j = 0; j < 16; ++j) { const unsigned c = xb_ld(&bar[XB_XCNT(j)]); sum += c; cnt += (c > 0u) ? 1u : 0u; mine = (j == x) ? c : mine; }
        if (sum == G) break;
        __builtin_amdgcn_s_sleep(1);
        if ((++sp & 255u) == 0u) { if (xb_ld(&bar[XB_TMO])) break; if (sp > XB_SPIN_CAP) { atomicAdd(&bar[XB_TMO], 1u); break; } }
    }
    nloc = mine > 0u ? mine : 1u; nx = cnt > 0u ? cnt : 1u;
}

__device__ __forceinline__ void xcd_barrier(const XcdBarrier& b) {
    asm volatile("s_waitcnt vmcnt(0)" ::: "memory");
    __syncthreads();
    if (threadIdx.x == 0) {
        unsigned* bar = b.bar;
        __builtin_amdgcn_s_waitcnt(0);
        unsigned nloc = b.st[0], nx = b.st[1];
        if (nloc == 0u) { xcd_barrier_complete(bar, b.x, nloc, nx); b.st[0] = nloc; b.st[1] = nx; }
        const unsigned old = xb_add(&bar[XB_XSUB(b.x)], 1u);
        const unsigned gen = old / nloc;
        if (old + 1u == (gen + 1u) * nloc) {
            __builtin_amdgcn_fence(__ATOMIC_RELEASE, "agent");
            asm volatile("s_waitcnt vmcnt(0)" ::: "memory");
            const unsigned og = xb_add(&bar[XB_TOP], 1u);
            const unsigned tg = og / nx;
            if (og + 1u == (tg + 1u) * nx) xb_add(&bar[XB_TOPGEN], 1u);
            else XB_SPIN(xb_ld(&bar[XB_TOPGEN]) == tg, bar);
            __builtin_amdgcn_fence(__ATOMIC_ACQUIRE, "agent");
            xb_add(&bar[XB_XGEN(b.x)], 1u);
            asm volatile("s_waitcnt vmcnt(0)" ::: "memory");
        } else {
            XB_SPIN(xb_ld(&bar[XB_XGEN(b.x)]) == gen, bar);
            __builtin_amdgcn_fence(__ATOMIC_ACQUIRE, "agent");
            asm volatile("s_waitcnt vmcnt(0)" ::: "memory");
        }
    }
    __syncthreads();
}

struct Frame {
    LAS unsigned char* lds;
    volatile LAS unsigned* MISC;
    gu32* ctl;
    int tid, lane, wave;
    int vcu, G;
    unsigned char* ws;
    const float *x, *norm1_g, *w_in, *q_norm_g, *k_norm_g, *sgu_norm_g, *sgu_w, *sgu_b, *attn_out_g, *sgu_out_g, *w_out, *norm2_g, *w_query, *sub_keys, *expert_u, *expert_v;
    float* out;
    bf16 *Win_t, *Wout_t, *Wq_t, *SK, *SGUW, *XB, *Q, *QP, *MIX;
    float *RSTD1, *SSQA, *SSQS, *SSQ2P, *GATE, *HS, *CS, *MAXP, *HINV;
    signed char *U8, *H8, *V8; int* PA; unsigned* CQ;
    unsigned short* EIDX;
};

__device__ __forceinline__ float wave_sum(float v) {
#pragma unroll
    for (int o = 1; o < 64; o <<= 1) v += __shfl_xor(v, o);
    return v;
}

__device__ __forceinline__ void p0_transpose_item(const float* W, int K, int N, bf16* WT, const float* gain_a, const float* gain_b, int gsplit, LAS float* scr, int item, int lane, bool permute) {
    const int nblk = N / 32, kb = item / nblk, nb = item % nblk, k0 = 64 * kb, n0 = 32 * nb;
#pragma unroll 8
    for (int i = 0; i < 32; ++i) { const int kk = 2 * i + (lane >> 5); const int k = k0 + kk; const float gv = (k < gsplit) ? gain_a[k] : gain_b[k - gsplit];
        scr[kk * 33 + (lane & 31)] = __builtin_nontemporal_load((const GAS float*)(W + (size_t)k * N + n0 + (lane & 31))) * gv; }
    LDS_WAIT(); asm volatile("" ::: "memory");
    int orow0 = n0;
    if (permute) { const int l = n0 & 255; orow0 = (n0 & ~255) + 128 * ((l >> 5) & 1) + 32 * (l >> 6); }
    const int c = lane & 7;
#pragma unroll
    for (int j = 0; j < 4; ++j) { const int n = (lane >> 3) + 8 * j; const LAS float* s = scr + (8 * c) * 33 + n;
        v4u o; o.x = pk2(s[0 * 33], s[1 * 33]); o.y = pk2(s[2 * 33], s[3 * 33]); o.z = pk2(s[4 * 33], s[5 * 33]); o.w = pk2(s[6 * 33], s[7 * 33]);
        *(GAS v4u*)(WT + (size_t)(orow0 + n) * K + k0 + 8 * c) = o; }
    LDS_WAIT(); asm volatile("" ::: "memory");
}

__device__ __forceinline__ float row_to_bf16(const float* src, bf16* dst, const float* gain, int lane) {
    float ss = 0.f;
    f32x4 v[4];
#pragma unroll
    for (int j = 0; j < 4; ++j) v[j] = __builtin_nontemporal_load((const GAS f32x4*)(src + 4 * lane + 256 * j));
#pragma unroll
    for (int j = 0; j < 4; ++j) {
        f32x4 a = v[j];
        ss += (a[0] * a[0] + a[1] * a[1]) + (a[2] * a[2] + a[3] * a[3]);
        if (gain) a = a * *(const GAS f32x4*)(gain + 4 * lane + 256 * j);
        v2u o; o.x = pk2(a[0], a[1]); o.y = pk2(a[2], a[3]);
        *(GAS v2u*)(dst + 4 * lane + 256 * j) = o;
    }
    return ss;
}

__device__ __forceinline__ void p0_prologue(Frame& F) {
    LAS float* scr = (LAS float*)(F.lds + RING_OFF + F.wave * 16384);
    const int gw = F.vcu * NWAVES + F.wave, NGW = F.G * NWAVES;
    constexpr int I_IN = (DM / 64) * (INW / 32), I_OUT = (DM / 64) * (DM / 32), I_Q = (DM / 64) * (QPW / 32);
    for (int it = gw; it < I_IN + I_OUT + I_Q; it += NGW) {
        int r = it;
        if (r < I_IN) { p0_transpose_item(F.w_in, DM, INW, F.Win_t, F.norm1_g, F.norm1_g, DM, scr, r, F.lane, true); continue; } r -= I_IN;
        if (r < I_OUT) { p0_transpose_item(F.w_out, DM, DM, F.Wout_t, F.attn_out_g, F.sgu_out_g, AW, scr, r, F.lane, false); continue; } r -= I_OUT;
        p0_transpose_item(F.w_query, DM, QPW, F.Wq_t, F.norm2_g, F.norm2_g, DM, scr, r, F.lane, false);
    }
    for (int m = 2 * gw; m < TOK; m += 2 * NGW) {
        const float s0 = row_to_bf16(F.x + (size_t)m * DM, F.XB + (size_t)m * DM, nullptr, F.lane);
        const float s1 = row_to_bf16(F.x + (size_t)(m + 1) * DM, F.XB + (size_t)(m + 1) * DM, nullptr, F.lane);
        const float ss0 = wave_sum(s0), ss1 = wave_sum(s1);
        if (F.lane == 0) { F.RSTD1[m] = 1.0f / sqrtf(ss0 * (1.0f / DM) + pg8::EPS_F); F.RSTD1[m + 1] = 1.0f / sqrtf(ss1 * (1.0f / DM) + pg8::EPS_F); }
    }
    for (int e0 = 2 * gw; e0 < 2 * NEXP; e0 += 2 * NGW) {
        const bool isu = e0 < NEXP; const int r0 = isu ? e0 : e0 - NEXP;
        f32x4 v[2][4]; float mx[2] = {0.f, 0.f};
#pragma unroll
        for (int b = 0; b < 2; ++b) {
            const float* src = (isu ? F.expert_u : F.expert_v) + (size_t)(r0 + b) * DM + 4 * F.lane;
#pragma unroll
            for (int q = 0; q < 4; ++q) v[b][q] = __builtin_nontemporal_load((const GAS f32x4*)(src + 256 * q));
        }
#pragma unroll
        for (int b = 0; b < 2; ++b) {
#pragma unroll
            for (int q = 0; q < 4; ++q) { if (isu) v[b][q] = v[b][q] * *(const GAS f32x4*)(F.norm2_g + 4 * F.lane + 256 * q);
                mx[b] = fmaxf(mx[b], fmaxf(fmaxf(fabsf(v[b][q][0]), fabsf(v[b][q][1])), fmaxf(fabsf(v[b][q][2]), fabsf(v[b][q][3])))); }
#pragma unroll
            for (int o = 1; o < 64; o <<= 1) mx[b] = fmaxf(mx[b], __shfl_xor(mx[b], o));
            const float sc = fmaxf(mx[b], 1e-30f) * (1.0f / 127.0f), inv = 1.0f / sc; const int r = r0 + b;
            signed char* tab = isu ? F.U8 : F.V8;
#pragma unroll
            for (int q = 0; q < 4; ++q) { const int b0 = (int)rintf(v[b][q][0] * inv), b1 = (int)rintf(v[b][q][1] * inv), b2 = (int)rintf(v[b][q][2] * inv), b3 = (int)rintf(v[b][q][3] * inv);
                const unsigned o = (unsigned)(b0 & 0xff) | ((unsigned)(b1 & 0xff) << 8) | ((unsigned)(b2 & 0xff) << 16) | ((unsigned)(b3 & 0xff) << 24);
                *(GAS unsigned*)(tab + ((size_t)(2 * q + (F.lane >> 5)) * NEXP + r) * 128 + 4 * (F.lane & 31)) = o; }
            if (F.lane == 0) { float* scp = (float*)(F.ws + (isu ? WS_SCU : WS_SCV)); scp[r] = sc; }
        }
    }
    const int gt = F.vcu * NWAVES * 64 + F.tid, NGT = F.G * NWAVES * 64;
    for (int i = gt; i < 8 * 128 * 128; i += NGT) { const int g = i >> 14, t = (i >> 7) & 127, s = i & 127;
        const int o = ((((g * 4 + (t >> 5)) * 8 + (s >> 4)) * 64) + 32 * ((s >> 3) & 1) + (t & 31)) * 8 + (s & 7);
        F.SGUW[o] = (bf16)f2bf(s <= t ? F.sgu_w[i] : 0.f); }
    for (int i = gt; i < 2 * 128 * 128; i += NGT) F.SK[i] = (bf16)f2bf(F.sub_keys[i]);
}

constexpr int AT_OPITCH = 136;
constexpr int AT_OACC = 0, AT_LACC = 512 * AT_OPITCH, AT_VS = AT_LACC + 2048, AT_VS_WAVE = 32 * 128;
constexpr int AT_KS = AT_VS + NWAVES * AT_VS_WAVE, AT_KS_WAVE = 32 * 128;
static_assert(AT_KS + NWAVES * AT_KS_WAVE <= LDSCTL_OFF, "attention LDS");
__device__ __forceinline__ int at_rowmap(int p) { return (p & ~15) | ((p ^ (p >> 4)) & 15); }
__device__ __forceinline__ s16x4 vtr(const LAS unsigned char* p) { typedef short v4i16_t __attribute__((ext_vector_type(4))); return __builtin_bit_cast(s16x4, __builtin_amdgcn_ds_read_tr16_b64_v4i16((LAS v4i16_t*)p)); }

struct AtDesc { int b, h, span, dil, res, a; };
__device__ __forceinline__ AtDesc at_desc(int u, int stage, int idx) {
    AtDesc d; const int bh = u >> 3; d.b = bh >> 3; d.h = bh & 7; d.span = u & 7;
    if (stage == 0) { d.dil = 16; d.res = idx; d.a = d.span; }
    else if (stage == 1) { d.dil = 4; d.res = idx & 3; d.a = 4 * d.span + 2 * (idx >> 2); }
    else { d.dil = 1; d.res = 0; d.a = 16 * d.span + 2 * idx; }
    return d;
}
__device__ __forceinline__ void at_dma(LAS unsigned char* ks, LAS unsigned char* vs, const char* kptr, const char* vptr, size_t vrow8) {
#pragma unroll
    for (int it = 0; it < 4; ++it) __builtin_amdgcn_global_load_lds((const unsigned*)(kptr + it * vrow8), (LAS unsigned*)(ks + it * 1024), 16, 0, 0);
#pragma unroll
    for (int it = 0; it < 4; ++it) __builtin_amdgcn_global_load_lds((const unsigned*)(vptr + it * vrow8), (LAS unsigned*)(vs + it * 1024), 16, 0, 0);
}
__device__ __forceinline__ size_t at_koff(int lane, int h) { return (size_t)h * 128 + (size_t)((((lane & 7) ^ (lane >> 3)) & 7) << 4); }
__device__ __forceinline__ size_t at_voff(int lane, int h) { return (size_t)h * 128 + (size_t)(((lane & 7) ^ (((lane >> 4) & 1) << 2)) << 4); }
__device__ __forceinline__ void at_start(Frame& F, const AtDesc& d, int nt, bf16x8 (&qn)[2][4]) {
    const int lane = F.lane, r32 = lane & 31, hi = lane >> 5;
    const int j0 = (d.a >= 4) ? 0 : 4 - d.a;
    const size_t krow = (size_t)d.b * SEQ + d.res + (size_t)d.dil * (32 * (d.a - 4 + j0) + (lane >> 3));
    const char* kp = (const char*)(F.Q + WS_TYPE_STRIDE / 2) + krow * 1024; const char* vp = (const char*)(F.Q + 2 * (WS_TYPE_STRIDE / 2)) + krow * 1024;
    at_dma(F.lds + AT_KS + F.wave * AT_KS_WAVE, F.lds + AT_VS + F.wave * AT_VS_WAVE, kp + at_koff(lane, d.h), vp + at_voff(lane, d.h), (size_t)d.dil * 8 * 1024);
#pragma unroll
    for (int t = 0; t < 2; ++t) {
        const size_t qrow = (size_t)d.b * SEQ + d.res + (size_t)d.dil * (32 * (d.a + (t ? nt - 1 : 0)) + r32);
        const bf16* qp = F.Q + qrow * 512 + d.h * 64 + hi * 8;
#pragma unroll
        for (int d0 = 0; d0 < 4; ++d0) qn[t][d0] = *(const GAS bf16x8*)(qp + 16 * d0);
    }
}

template <int STAGE, int NT>
__device__ __forceinline__ void attn_task(Frame& F, const AtDesc& d, float sl, float mlog2, bf16x8 (&qn)[2][4], const AtDesc& nd, int nnt) {
    const int lane = F.lane, r32 = lane & 31, hi = lane >> 5;
    const int b = d.b, h = d.h, span = d.span, dil = d.dil, res = d.res, a = d.a;
    const size_t tokbase = (size_t)b * SEQ;
    LAS unsigned char* vs = F.lds + AT_VS + F.wave * AT_VS_WAVE;
    LAS unsigned char* ks = F.lds + AT_KS + F.wave * AT_KS_WAVE;
    bf16x8 qf[NT][4];
#pragma unroll
    for (int t = 0; t < NT; ++t)
#pragma unroll
        for (int d0 = 0; d0 < 4; ++d0) qf[t][d0] = qn[t][d0];
    f32x16 o[NT][2];
    float lsum[NT];
#pragma unroll
    for (int t = 0; t < NT; ++t) { o[t][0] = f32x16{}; o[t][1] = f32x16{}; lsum[t] = 0.f; }
    const float base_i = -sl * (float)(128 + r32) - mlog2 + sl * (float)(4 * hi);
    const int G = lane >> 4, gi = lane & 15, gq4 = gi >> 2, gp = gi & 3;
    const int j0 = (a >= 4) ? 0 : 4 - a;
    const size_t cstride = (size_t)dil * 32 * 1024, vrow8 = (size_t)dil * 8 * 1024;
    const size_t krow1 = tokbase + res + (size_t)dil * (32 * (a - 3 + j0) + (lane >> 3));
    const char* kptr = (const char*)(F.Q + WS_TYPE_STRIDE / 2) + krow1 * 1024 + at_koff(lane, h);
    const char* vptr = (const char*)(F.Q + 2 * (WS_TYPE_STRIDE / 2)) + krow1 * 1024 + at_voff(lane, h);
    bf16x8 kf[4], va[2][2];
#define AT_TOP() do { \
        asm volatile("s_waitcnt vmcnt(0)" ::: "memory"); \
        _Pragma("unroll") for (int d0 = 0; d0 < 4; ++d0) kf[d0] = *(const LAS bf16x8*)(ks + r32 * 128 + (((2 * d0 + hi) ^ (r32 & 7)) << 4)); \
          \
        _Pragma("unroll") for (int d0 = 0; d0 < 2; ++d0) \
            _Pragma("unroll") for (int ks_ = 0; ks_ < 2; ++ks_) { \
                const LAS unsigned char* pa = vs + (16 * ks_ + 4 * (G >> 1) + gq4) * 128 + ((64 * d0 + 32 * (G & 1) + 8 * gp) ^ (((gq4 >> 1) & 1) << 6)); \
                const s16x4 lo = vtr(pa), hi4 = vtr(pa + 8 * 128); \
                va[d0][ks_] = (bf16x8){lo[0], lo[1], lo[2], lo[3], hi4[0], hi4[1], hi4[2], hi4[3]}; } \
        LDS_WAIT(); } while (0)
#define AT_MATH(t, c) do { \
        f32x16 s; \
        const float bc = base_i + sl * (float)(32 * (c)); \
        _Pragma("unroll") for (int r = 0; r < 16; ++r) s[r] = bc + sl * (float)((r & 3) + 8 * (r >> 2)); \
        _Pragma("unroll") for (int d0 = 0; d0 < 4; ++d0) s = __builtin_amdgcn_mfma_f32_32x32x16_bf16(kf[d0], qf[t][d0], s, 0, 0, 0); \
          \
        const int dbase = 128 - 32 * (c) + r32 - 4 * hi; \
        float ls_ = lsum[t]; \
        if (((c) == 0) || ((c) == 4)) { \
            _Pragma("unroll") for (int r = 0; r < 16; ++r) { float p = __builtin_amdgcn_exp2f(s[r]); p = ((unsigned)(dbase - ((r & 3) + 8 * (r >> 2))) <= 128u) ? p : 0.f; s[r] = p; ls_ += p; } \
        } else { \
            _Pragma("unroll") for (int r = 0; r < 16; ++r) { const float p = __builtin_amdgcn_exp2f(s[r]); s[r] = p; ls_ += p; } \
        } \
        lsum[t] = ls_; \
        bf16x8 pb[2]; \
        _Pragma("unroll") for (int ks_ = 0; ks_ < 2; ++ks_) { v4u w; w.x = pk2(s[8 * ks_ + 0], s[8 * ks_ + 1]); w.y = pk2(s[8 * ks_ + 2], s[8 * ks_ + 3]); w.z = pk2(s[8 * ks_ + 4], s[8 * ks_ + 5]); w.w = pk2(s[8 * ks_ + 6], s[8 * ks_ + 7]); pb[ks_] = __builtin_bit_cast(bf16x8, w); } \
          \
        _Pragma("unroll") for (int d0 = 0; d0 < 2; ++d0) \
            _Pragma("unroll") for (int ks_ = 0; ks_ < 2; ++ks_) o[t][d0] = __builtin_amdgcn_mfma_f32_32x32x16_bf16(va[d0][ks_], pb[ks_], o[t][d0], 0, 0, 0); \
    } while (0)
#pragma unroll 1
    for (int j = j0; j < 3 + NT; ++j) {
        AT_TOP();
        at_dma(ks, vs, kptr, vptr, vrow8); kptr += cstride; vptr += cstride;
        AT_MATH(0, j);
        if (NT == 2) { if (j >= 1) AT_MATH(NT - 1, j - 1); }
    }
    AT_TOP();
    at_start(F, nd, nnt, qn);
    AT_MATH(NT - 1, 4);
#undef AT_MATH
#undef AT_TOP
    LAS float* lacc = (LAS float*)(F.lds + AT_LACC);
#pragma unroll
    for (int t = 0; t < NT; ++t) {
        float ls = lsum[t];
        ls += __shfl_xor(ls, 32);
        const int posq = res + dil * (32 * (a + t) + r32);
        const int pl = posq - span * 512;
        LAS unsigned char* orow = F.lds + AT_OACC + at_rowmap(pl) * AT_OPITCH;
        if (STAGE > 0) {
            ls += lacc[pl];
#pragma unroll
            for (int d0 = 0; d0 < 2; ++d0)
#pragma unroll
                for (int g4 = 0; g4 < 4; ++g4) { const v2u w = *(LAS v2u*)(orow + (32 * d0 + 8 * g4 + 4 * hi) * 2);
                    o[t][d0][4 * g4 + 0] += bf_lo(w.x); o[t][d0][4 * g4 + 1] += bf_hi(w.x); o[t][d0][4 * g4 + 2] += bf_lo(w.y); o[t][d0][4 * g4 + 3] += bf_hi(w.y); }
        }
        if (STAGE < 2) {
            if (hi == 0) lacc[pl] = ls;
#pragma unroll
            for (int d0 = 0; d0 < 2; ++d0)
#pragma unroll
                for (int g4 = 0; g4 < 4; ++g4) { v2u w; w.x = pk2(o[t][d0][4 * g4 + 0], o[t][d0][4 * g4 + 1]); w.y = pk2(o[t][d0][4 * g4 + 2], o[t][d0][4 * g4 + 3]);
                    *(LAS v2u*)(orow + (32 * d0 + 8 * g4 + 4 * hi) * 2) = w; }
        } else {
            const float inv = 1.0f / ls;
            float ss = 0.f;
#pragma unroll
            for (int d0 = 0; d0 < 2; ++d0)
#pragma unroll
                for (int g4 = 0; g4 < 4; ++g4) { const float a0 = o[t][d0][4 * g4 + 0] * inv, a1 = o[t][d0][4 * g4 + 1] * inv, a2 = o[t][d0][4 * g4 + 2] * inv, a3 = o[t][d0][4 * g4 + 3] * inv;
                    ss += (a0 * a0 + a1 * a1) + (a2 * a2 + a3 * a3);
                    v2u w; w.x = pk2(a0, a1); w.y = pk2(a2, a3);
                    *(LAS v2u*)(orow + (32 * d0 + 8 * g4 + 4 * hi) * 2) = w; }
            ss += __shfl_xor(ss, 32);
            if (hi == 0) F.SSQA[(tokbase + posq) * 8 + h] = ss;
            LDS_WAIT(); asm volatile("" ::: "memory");
#pragma unroll
            for (int it = 0; it < 4; ++it) { const int row = (lane >> 3) + 8 * it;
                const LAS unsigned char* src = F.lds + AT_OACC + at_rowmap(res + dil * (32 * (a + t) + row) - span * 512) * AT_OPITCH + (lane & 7) * 16;
                const v2u lo = *(const LAS v2u*)src, hi2 = *(const LAS v2u*)(src + 8);
                v4u ov; ov.x = lo.x; ov.y = lo.y; ov.z = hi2.x; ov.w = hi2.y;
                *(GAS v4u*)(F.MIX + (tokbase + res + (size_t)dil * (32 * (a + t) + row)) * 1024 + h * 64 + (lane & 7) * 8) = ov; }
            LDS_WAIT(); asm volatile("" ::: "memory");
        }
    }
}

__device__ __forceinline__ void attn_unit(Frame& F, int u, int un, float mlog2, bf16x8 (&qn)[2][4]) {
    const int h = (u >> 3) & 7;
    const float slope = __builtin_amdgcn_exp2f(-(float)(h + 1)) * 1.4426950408889634f;
    const int w = F.wave;
#pragma unroll 1
    for (int k = 0; k < 2; ++k) attn_task<0, 1>(F, at_desc(u, 0, 2 * w + k), slope * 16.f, mlog2, qn, k ? at_desc(u, 1, w) : at_desc(u, 0, 2 * w + 1), 1 + k);
    LDS_WAIT(); __syncthreads();
    attn_task<1, 2>(F, at_desc(u, 1, w), slope * 4.f, mlog2, qn, at_desc(u, 2, w), 2);
    LDS_WAIT(); __syncthreads();
    attn_task<2, 2>(F, at_desc(u, 2, w), slope, mlog2, qn, at_desc(un, 0, 2 * w), 1);
    LDS_WAIT(); __syncthreads();
}

constexpr int SG_PITCH = 192, SG_TILE = 128 * SG_PITCH;
static_assert(4 * SG_TILE <= RING_BYTES, "SGU LDS");
struct SguPre { v4u tile[4]; v4u sul[4]; };
constexpr int SG_SU_OFF = 4 * SG_TILE, SG_SU_WAVE = 32 * 144;
static_assert(SG_SU_OFF + NWAVES * SG_SU_WAVE <= LDSCTL_OFF, "SGU LDS");
__device__ __forceinline__ void sgu_load(Frame& F, int u, SguPre& p) {
    const int gp = u & 3, ch = (u >> 2) & 31, b = u >> 7;
    const int lane = F.lane, r32 = lane & 31, hi = lane >> 5, w = F.wave, gsel = w >> 2, tb = w & 3, g = 2 * gp + gsel, t = 32 * tb + r32;
    const size_t tok0 = (size_t)b * SEQ + (size_t)ch * 128;
    const bf16* SVN = F.Q + 4 * (WS_TYPE_STRIDE / 2); const bf16* SU = F.Q + 3 * (WS_TYPE_STRIDE / 2);
#pragma unroll
    for (int gg = 0; gg < 2; ++gg)
#pragma unroll
        for (int it = 0; it < 2; ++it) { const int idx = F.tid + 512 * it, s_ = idx >> 3, c8 = idx & 7;
            p.tile[2 * gg + it] = __builtin_nontemporal_load((const GAS v4u*)(SVN + (tok0 + s_) * 512 + (2 * gp + gg) * 64 + c8 * 8)); }
#pragma unroll
    for (int i = 0; i < 4; ++i) p.sul[i] = __builtin_nontemporal_load((const GAS v4u*)(SU + (tok0 + 32 * tb + (lane >> 3) + 8 * i) * 512 + g * 64 + (lane & 7) * 8));
}
__device__ __forceinline__ void sgu_phase(Frame& F) {
    const int lane = F.lane, r32 = lane & 31, hi = lane >> 5, w = F.wave, gsel = w >> 2, tb = w & 3, t = 32 * tb + r32;
    const int G = lane >> 4, gi = lane & 15, gq4 = gi >> 2, gpp = gi & 3;
    constexpr int NU = BATCH * 32 * 4;
    int u = F.vcu; if (u >= NU) return;
    bf16x8 wb[8]; float bias;
    { const int g = 2 * (u & 3) + gsel;
      const bf16* Wg = F.SGUW + ((size_t)(g * 4 + tb) * 8 * 64 + lane) * 8;
#pragma unroll
      for (int ks = 0; ks < 8; ++ks) wb[ks] = *(const GAS bf16x8*)(Wg + ks * 512);
      bias = F.sgu_b[g * 128 + t]; }
    SguPre pre; sgu_load(F, u, pre);
    for (int it_ = 0; u < NU; u += F.G, ++it_) {
        LAS unsigned char* buf = F.lds + (it_ & 1) * (2 * SG_TILE);
#pragma unroll
        for (int gg = 0; gg < 2; ++gg)
#pragma unroll
            for (int it = 0; it < 2; ++it) { const int idx = F.tid + 512 * it, s_ = idx >> 3, c8 = idx & 7; *(LAS v4u*)(buf + gg * SG_TILE + s_ * SG_PITCH + c8 * 16) = pre.tile[2 * gg + it]; }
        LAS unsigned char* sus = F.lds + SG_SU_OFF + w * SG_SU_WAVE;
#pragma unroll
        for (int i = 0; i < 4; ++i) *(LAS v4u*)(sus + ((lane >> 3) + 8 * i) * 144 + (lane & 7) * 16) = pre.sul[i];
        LDS_WAIT(); __syncthreads();
        const int un = (u + F.G < NU) ? u + F.G : u;
        sgu_load(F, un, pre);
        const int gp = u & 3, ch = (u >> 2) & 31, b = u >> 7, g = 2 * gp + gsel;
        const size_t tok0 = (size_t)b * SEQ + (size_t)ch * 128;
        const LAS unsigned char* ts = buf + gsel * SG_TILE;
        f32x16 acc[2]; acc[0] = f32x16{}; acc[1] = f32x16{};
#pragma unroll
        for (int ks = 0; ks < 8; ++ks) {
#pragma unroll
            for (int eb = 0; eb < 2; ++eb) {
                const LAS unsigned char* pa = ts + (16 * ks + 8 * (G >> 1) + gq4) * SG_PITCH + (32 * eb + 16 * (G & 1) + 4 * gpp) * 2;
                const s16x4 lo = vtr(pa), hi4 = vtr(pa + 4 * SG_PITCH);
                const bf16x8 va = (bf16x8){lo[0], lo[1], lo[2], lo[3], hi4[0], hi4[1], hi4[2], hi4[3]};
                acc[eb] = __builtin_amdgcn_mfma_f32_32x32x16_bf16(va, wb[ks], acc[eb], 0, 0, 0);
            }
        }
        float ss = 0.f;
#pragma unroll
        for (int eb = 0; eb < 2; ++eb)
#pragma unroll
            for (int g4 = 0; g4 < 4; ++g4) { const int e = 32 * eb + 8 * g4 + 4 * hi;
                const v2u sw = *(const LAS v2u*)(sus + r32 * 144 + e * 2);
                const float a0 = bf_lo(sw.x) * (acc[eb][4 * g4 + 0] + bias), a1 = bf_hi(sw.x) * (acc[eb][4 * g4 + 1] + bias), a2 = bf_lo(sw.y) * (acc[eb][4 * g4 + 2] + bias), a3 = bf_hi(sw.y) * (acc[eb][4 * g4 + 3] + bias);
                ss += (a0 * a0 + a1 * a1) + (a2 * a2 + a3 * a3);
                v2u wv; wv.x = pk2(a0, a1); wv.y = pk2(a2, a3); *(LAS v2u*)(sus + r32 * 144 + e * 2) = wv; }
        ss += __shfl_xor(ss, 32);
        if (hi == 0) F.SSQS[(tok0 + t) * 8 + g] = ss;
        LDS_WAIT(); asm volatile("" ::: "memory");
#pragma unroll
        for (int i = 0; i < 4; ++i) { const int row = (lane >> 3) + 8 * i; const v4u ov = *(const LAS v4u*)(sus + row * 144 + (lane & 7) * 16);
            *(GAS v4u*)(F.MIX + (tok0 + 32 * tb + row) * 1024 + 512 + g * 64 + (lane & 7) * 8) = ov; }
        LDS_WAIT(); asm volatile("" ::: "memory");
    }
    LDS_WAIT(); __syncthreads();
}

#ifndef P2_VARIANT
#define P2_VARIANT 0
#endif
__device__ __forceinline__ void p2_mixers(Frame& F) {
    float mq = fabsf(F.q_norm_g[F.lane]), mk = fabsf(F.k_norm_g[F.lane]);
#pragma unroll
    for (int o = 1; o < 64; o <<= 1) { mq = fmaxf(mq, __shfl_xor(mq, o)); mk = fmaxf(mk, __shfl_xor(mk, o)); }
    const float mlog2 = 8.0f * mq * mk * 1.4426950408889634f;
    {
        constexpr int NU = BATCH * 8 * 8;
        bf16x8 qn[2][4];
        if (F.vcu < NU) at_start(F, at_desc(F.vcu, 0, 2 * F.wave), 1, qn);
#pragma unroll 1
        for (int u = F.vcu; u < NU; u += F.G) attn_unit(F, u, (u + F.G < NU) ? u + F.G : u, mlog2, qn);
        asm volatile("s_waitcnt vmcnt(0)" ::: "memory"); __syncthreads();
    }
#pragma unroll 1
    for (int rep = 0; rep < (P2_VARIANT == 2 ? 2 : 1); ++rep)
    sgu_phase(F);
}

__device__ __forceinline__ unsigned f2ord(float f) { const unsigned u = __builtin_bit_cast(unsigned, f); return u ^ ((unsigned)((int)u >> 31) | 0x80000000u); }
__device__ __forceinline__ float ord2f(unsigned k) { const unsigned u = (k & 0x80000000u) ? (k ^ 0x80000000u) : ~k; return __builtin_bit_cast(float, u); }
#define CE_DESC(a, b) do { const unsigned _mx = max((a), (b)), _mn = min((a), (b)); (a) = _mx; (b) = _mn; } while (0)
__device__ __forceinline__ void sort16(unsigned (&k)[16]) {
#pragma unroll
    for (int k2 = 2; k2 <= 16; k2 <<= 1)
#pragma unroll
        for (int j = k2 >> 1; j > 0; j >>= 1)
#pragma unroll
            for (int i = 0; i < 16; ++i) { const int l = i ^ j; if (l > i) { if ((i & k2) == 0) CE_DESC(k[i], k[l]); else CE_DESC(k[l], k[i]); } }
}
__device__ __forceinline__ void merge16(unsigned (&a)[16], const unsigned (&b)[16]) {
#pragma unroll
    for (int i = 0; i < 16; ++i) a[i] = max(a[i], b[15 - i]);
#pragma unroll
    for (int j = 8; j > 0; j >>= 1)
#pragma unroll
        for (int i = 0; i < 16; ++i) { const int l = i ^ j; if (l > i) CE_DESC(a[i], a[l]); }
}
__device__ __forceinline__ void swap16(const unsigned (&x)[16], const unsigned (&y)[16], unsigned (&xo)[16], unsigned (&yo)[16]) {
#pragma unroll
    for (int i = 0; i < 16; ++i) { auto rr = __builtin_amdgcn_permlane32_swap(x[i], y[i], false, false); xo[i] = rr[0]; yo[i] = rr[1]; }
}

__host__ __device__ constexpr int cand0(int q) { return q < 16 ? q : q < 21 ? 0x20 + (q - 16) : q < 24 ? 0x40 + (q - 21) : q < 26 ? 0x60 + (q - 24) : q == 26 ? 0x80 : q == 27 ? 0xa0 : q == 28 ? 0xc0 : q == 29 ? 0xe0 : 0xff; }
__host__ __device__ constexpr int cand1(int q) { return q < 8 ? 0x10 + q : q < 12 ? 0x30 + (q - 8) : q < 14 ? 0x50 + (q - 12) : q < 16 ? 0x70 + (q - 14) : q == 16 ? 0x90 : q == 17 ? 0xb0 : q == 18 ? 0xd0 : q == 19 ? 0xf0 : 0xff; }

constexpr int TK_SK_BYTES = 2 * 128 * 256;
constexpr int TK_LDS_WAVE = 32 * 32 * 4, TK_SCR_OFF = TK_SK_BYTES;
static_assert(TK_SCR_OFF + NWAVES * TK_LDS_WAVE <= RING_BYTES, "top-k LDS");
__device__ __forceinline__ void tk_load_q(Frame& F, size_t t0, int hd, int half, int r32, int hi, bf16x8 (&qf)[8]) {
#pragma unroll
    for (int i = 0; i < 8; ++i) qf[i] = __builtin_nontemporal_load((const GAS bf16x8*)(F.QP + ((((t0 >> 5) * 8 + hd) * 2 + half) * 8 + i) * 512 + (size_t)(32 * hi + r32) * 8));
}
template <int HALF_> __device__ __forceinline__ void half_top16(Frame& F, const bf16x8 (&qf)[8], int r32, int hi, unsigned (&best)[16]) {
#pragma unroll
    for (int nb = 0; nb < 4; ++nb) {
        f32x16 acc;
#pragma unroll
        for (int r = 0; r < 16; ++r) acc[r] = 64.0f;
        const int row = HALF_ * 128 + 32 * nb + r32;
#pragma unroll
        for (int ks = 0; ks < 8; ++ks) { const bf16x8 a = *(const LAS bf16x8*)(F.lds + row * 256 + (((2 * ks + hi) ^ (row & 15)) << 4));
            acc = __builtin_amdgcn_mfma_f32_32x32x16_bf16(a, qf[ks], acc, 0, 0, 0); }
        unsigned k[16];
#pragma unroll
        for (int r = 0; r < 16; ++r) { const int n = 32 * nb + (r & 3) + 8 * (r >> 2) + 4 * hi; k[r] = (__builtin_bit_cast(unsigned, __builtin_amdgcn_fmed3f(acc[r], 4.0f, 124.0f)) & ~127u) | (unsigned)(127 - n); }
        sort16(k);
        if (nb == 0) {
#pragma unroll
            for (int i = 0; i < 16; ++i) best[i] = k[i];
        } else merge16(best, k);
    }
}

__device__ __forceinline__ void topk_task(Frame& F, int tb, int hd, bf16x8 (&qa)[8], bool has_next, int tb_next, int hd_next) {
    const int lane = F.lane, r32 = lane & 31, hi = lane >> 5;
    const size_t t0 = (size_t)tb * 32;
    unsigned bk[2][16];
    bf16x8 qb[8];
    tk_load_q(F, t0, hd, 1, r32, hi, qb);
    half_top16<0>(F, qa, r32, hi, bk[0]);
    if (has_next) tk_load_q(F, (size_t)tb_next * 32, hd_next, 0, r32, hi, qa);
    half_top16<1>(F, qb, r32, hi, bk[1]);
    unsigned xa[16], ya[16];
    swap16(bk[0], bk[1], xa, ya);
    merge16(xa, ya);
    unsigned A[16], B[16];
    swap16(xa, xa, A, B);
    LAS unsigned* tk = (LAS unsigned*)(F.lds + TK_SCR_OFF + F.wave * TK_LDS_WAVE) + r32 * 32;
#pragma unroll
    for (int i = 0; i < 16; ++i) tk[16 * hi + i] = hi ? B[i] : A[i];
    float v1[16], v2[16];
#pragma unroll
    for (int i = 0; i < 16; ++i) { v1[i] = __builtin_bit_cast(float, A[i] & ~127u); v2[i] = __builtin_bit_cast(float, B[i] & ~127u); }
    unsigned c0[16], c1[16];
#pragma unroll
    for (int q = 0; q < 32; ++q) {
        const int ij0 = cand0(q), ij1 = cand1(q);
        const float s0 = (ij0 == 0xff) ? 0.0f : v1[ij0 >> 4] + v2[ij0 & 15];
        const float s1 = (ij1 == 0xff) ? 0.0f : v1[ij1 >> 4] + v2[ij1 & 15];
        const unsigned k0 = (__builtin_bit_cast(unsigned, s0) & ~255u) | (unsigned)(ij0 & 255), k1 = (__builtin_bit_cast(unsigned, s1) & ~255u) | (unsigned)(ij1 & 255);
        const unsigned kk = hi ? k1 : k0;
        if (q < 16) c0[q] = kk; else c1[q - 16] = kk;
    }
    sort16(c0); sort16(c1); merge16(c0, c1);
    unsigned L0[16], L1[16];
    swap16(c0, c0, L0, L1);
    merge16(L0, L1);
    const float mx = __builtin_bit_cast(float, L0[0] & ~255u);
    float ex[16], den = 0.f;
#pragma unroll
    for (int i = 0; i < 16; ++i) { ex[i] = __expf(__builtin_bit_cast(float, L0[i] & ~255u) - mx); den += ex[i]; }
    const float rden = 1.0f / den;
    LDS_WAIT(); asm volatile("" ::: "memory");
    int ei[8]; float gt[8];
#pragma unroll
    for (int kk = 0; kk < 8; ++kk) {
        const unsigned key = hi ? L0[8 + kk] : L0[kk]; const float e = hi ? ex[8 + kk] : ex[kk];
        const int i = (key >> 4) & 15, j = key & 15;
        const int i1 = 127 - (int)(tk[i] & 127u), i2 = 127 - (int)(tk[16 + j] & 127u);
        ei[kk] = i1 * 128 + i2; gt[kk] = e * rden;
    }
    unsigned short* ep = F.EIDX + (t0 + r32) * 128 + hd * 16 + 8 * hi; float* gp = F.GATE + (t0 + r32) * 128 + hd * 16 + 8 * hi;
    *(GAS v4u*)ep = (v4u){(unsigned)ei[0] | ((unsigned)ei[1] << 16), (unsigned)ei[2] | ((unsigned)ei[3] << 16), (unsigned)ei[4] | ((unsigned)ei[5] << 16), (unsigned)ei[6] | ((unsigned)ei[7] << 16)};
    *(GAS f32x4*)gp = (f32x4){gt[0], gt[1], gt[2], gt[3]}; *(GAS f32x4*)(gp + 4) = (f32x4){gt[4], gt[5], gt[6], gt[7]};
    LDS_WAIT(); asm volatile("" ::: "memory");
}

__device__ __forceinline__ void p5_topk(Frame& F) {
    for (int i = F.tid; i < 2 * 128 * 16; i += NWAVES * 64) { const int row = i >> 4, ch = i & 15;
        *(LAS v4u*)(F.lds + row * 256 + ((ch ^ (row & 15)) << 4)) = *(const GAS v4u*)(F.SK + (size_t)row * 128 + ch * 8); }
    LDS_WAIT(); __syncthreads();
    pg8::StaticOrder S; S.init(TOK, QPW, F.G, (int)blockIdx.x);
    pg8::Unit u, un;
    bf16x8 qf[8];
    bool have = S.next(0, u);
    if (have) tk_load_q(F, (size_t)(u.pm * 8 + F.wave) * 32, u.pn, 0, F.lane & 31, F.lane >> 5, qf);
#pragma unroll 1
    for (int i = 0; have; ++i) {
        const bool hn = S.next(i + 1, un);
        topk_task(F, u.pm * 8 + F.wave, u.pn, qf, hn, un.pm * 8 + F.wave, un.pn);
        u = un; have = hn;
    }
    LDS_WAIT(); __syncthreads();
}

constexpr int PE_TPI = 16, PE_NITEM = TOK / PE_TPI;
constexpr int CW_QA = 8192, CW_QB = 8192 + 8 * 64;

template <int CTRL> __device__ __forceinline__ int dpp_i(int v) { return __builtin_amdgcn_update_dpp(0, v, CTRL, 0xf, 0xf, true); }
template <int CTRL> __device__ __forceinline__ float dpp_f(float v) { return __builtin_bit_cast(float, __builtin_amdgcn_update_dpp(0, __builtin_bit_cast(int, v), CTRL, 0xf, 0xf, true)); }
constexpr int DPP_XOR1 = 0xB1, DPP_XOR2 = 0x4E, DPP_HMIRROR = 0x141, DPP_ROR8 = 0x128;

__device__ __forceinline__ void pe_load_ix(Frame& F, int t, v4u (&ix)[2]) {
    const int gl = F.lane >> 3;
#pragma unroll
    for (int q = 0; q < 2; ++q) ix[q] = *(const GAS v4u*)(F.EIDX + (size_t)t * 128 + gl * 16 + 8 * q);
}
__device__ __forceinline__ void pe_load_rows(const void* TAB, const v4u (&ix)[2], int coloff, v4u (&w)[16]) {
#pragma unroll
    for (int i = 0; i < 16; ++i) { const unsigned pr = ix[i >> 3][(i >> 1) & 3]; const unsigned e = (i & 1) ? (pr >> 16) : (pr & 0xffffu);
        w[i] = *(const GAS v4u*)((const char*)TAB + (size_t)e * 128 + coloff); }
}
__device__ __forceinline__ v4u pe_quant16(const v4u& lo, const v4u& hi, float inv) {
    v4u o;
#pragma unroll
    for (int q = 0; q < 4; ++q) { const unsigned w0 = (q < 2) ? lo[2 * q] : hi[2 * q - 4], w1 = (q < 2) ? lo[2 * q + 1] : hi[2 * q - 3];
        const int b0 = (int)rintf(bf_lo(w0) * inv), b1 = (int)rintf(bf_hi(w0) * inv), b2 = (int)rintf(bf_lo(w1) * inv), b3 = (int)rintf(bf_hi(w1) * inv);
        o[q] = (unsigned)(b0 & 0xff) | ((unsigned)(b1 & 0xff) << 8) | ((unsigned)(b2 & 0xff) << 16) | ((unsigned)(b3 & 0xff) << 24); }
    return o;
}
__device__ __forceinline__ void peA_compute(Frame& F, int* PA, int j, int t, const v4u& hq, const v4u (&w)[16]) {
    const int gl = F.lane >> 3, sub = F.lane & 7;
    int r0 = 0, r1 = 0;
#pragma unroll
    for (int i = 0; i < 16; ++i) {
        int p = __builtin_amdgcn_sdot4((int)w[i].x, (int)hq.x, 0, false);
        p = __builtin_amdgcn_sdot4((int)w[i].y, (int)hq.y, p, false); p = __builtin_amdgcn_sdot4((int)w[i].z, (int)hq.z, p, false); p = __builtin_amdgcn_sdot4((int)w[i].w, (int)hq.w, p, false);
        p += dpp_i<DPP_XOR1>(p); p += dpp_i<DPP_XOR2>(p); p += dpp_i<DPP_HMIRROR>(p);
        if (i < 8) r0 = (sub == i) ? p : r0; else r1 = (sub == i - 8) ? p : r1;
    }
    const unsigned pk = ((unsigned)((r0 + 32) >> 6) & 0xffffu) | ((unsigned)((r1 + 32) >> 6) << 16);
    ((unsigned*)PA)[((size_t)j * TOK + t) * 64 + gl * 8 + sub] = pk;
}
__device__ __forceinline__ void peB_compute(Frame& F, int j, int t, const v4u& cq, float cs, const v4u (&w)[16]) {
    const int lane = F.lane, gl = lane >> 3, sub = lane & 7;
    typedef float f32x2_t __attribute__((ext_vector_type(2)));
    const int mycol = 128 * j + 2 * lane;
    const unsigned xw = *(const GAS unsigned*)(F.XB + (size_t)t * DM + mycol);
    f32x2_t xin; xin.x = bf_lo(xw); xin.y = bf_hi(xw);
    int acc[16];
#pragma unroll
    for (int c = 0; c < 16; ++c) acc[c] = 0;
#pragma unroll
    for (int m = 0; m < 4; ++m)
#pragma unroll
        for (int q = 0; q < 4; ++q) {
            const unsigned a0 = w[4 * m + 0][q], a1 = w[4 * m + 1][q], a2 = w[4 * m + 2][q], a3 = w[4 * m + 3][q];
            const unsigned t0 = __builtin_amdgcn_perm(a1, a0, 0x05010400u), t1 = __builtin_amdgcn_perm(a1, a0, 0x07030602u);
            const unsigned t2 = __builtin_amdgcn_perm(a3, a2, 0x05010400u), t3 = __builtin_amdgcn_perm(a3, a2, 0x07030602u);
            const unsigned o0 = __builtin_amdgcn_perm(t2, t0, 0x05040100u), o1 = __builtin_amdgcn_perm(t2, t0, 0x07060302u);
            const unsigned o2 = __builtin_amdgcn_perm(t3, t1, 0x05040100u), o3 = __builtin_amdgcn_perm(t3, t1, 0x07060302u);
            acc[4 * q + 0] = __builtin_amdgcn_sdot4((int)o0, (int)cq[m], acc[4 * q + 0], false); acc[4 * q + 1] = __builtin_amdgcn_sdot4((int)o1, (int)cq[m], acc[4 * q + 1], false);
            acc[4 * q + 2] = __builtin_amdgcn_sdot4((int)o2, (int)cq[m], acc[4 * q + 2], false); acc[4 * q + 3] = __builtin_amdgcn_sdot4((int)o3, (int)cq[m], acc[4 * q + 3], false);
        }
    int h8v[8];
#pragma unroll
    for (int c = 0; c < 8; ++c) { auto rr = __builtin_amdgcn_permlane32_swap((unsigned)acc[c], (unsigned)acc[c + 8], false, false);
        unsigned r0 = rr[0], r1 = rr[1]; asm volatile("" : "+v"(r0), "+v"(r1));
        h8v[c] = (int)r0 + (int)r1; }
    const bool b4 = (lane >> 4) & 1, b3 = (lane >> 3) & 1;
    int h4[4];
#pragma unroll
    for (int c = 0; c < 4; ++c) { const int keep = b4 ? h8v[c + 4] : h8v[c], give = b4 ? h8v[c] : h8v[c + 4]; h4[c] = keep + __builtin_amdgcn_ds_swizzle(give, 0x401F); }
    int h2[2];
#pragma unroll
    for (int c = 0; c < 2; ++c) { const int keep = b3 ? h4[c + 2] : h4[c], give = b3 ? h4[c] : h4[c + 2]; h2[c] = keep + dpp_i<DPP_ROR8>(give); }
    const int srcl = ((lane >> 3) + 8 * (lane & 1) + 16 * ((lane >> 1) & 1) + 32 * ((lane >> 2) & 1)) * 4;
    const int q0 = __builtin_amdgcn_ds_bpermute(srcl, h2[0]), q1 = __builtin_amdgcn_ds_bpermute(srcl, h2[1]);
    f32x2_t o; o.x = xin.x + cs * (float)q0; o.y = xin.y + cs * (float)q1;
    __builtin_nontemporal_store(o, (GAS f32x2_t*)(F.out + (size_t)t * DM + mycol));
}

template <bool PHASE_B> __device__ __forceinline__ void pe_item(Frame& F, int j, int t0) {
    const int sub = F.lane & 7, gl = F.lane >> 3, coloff = 128 * j + 16 * sub;
    const void* TAB = (const char*)(PHASE_B ? (const void*)F.V8 : (const void*)F.U8) + (size_t)j * NEXP * 128;
    const int rowoff = 16 * sub;
    v4u ixA[2], ixB[2], wA[16], wB[16], auxA, auxB, aux2A = {}, aux2B = {}; float csA = 0.f, csB = 0.f;
#define PE_AUX(t, aux, aux2, cs) do { if (PHASE_B) { aux = *(const GAS v4u*)(F.CQ + (size_t)(t) * 32 + gl * 4); cs = F.CS[t]; } \
        else { aux = *(const GAS v4u*)(F.XB + (size_t)(t) * DM + coloff); aux2 = *(const GAS v4u*)(F.XB + (size_t)(t) * DM + coloff + 8); cs = F.HINV[t]; } } while (0)
#define PE_COMPUTE(t, aux, aux2, cs, w) do { if (PHASE_B) peB_compute(F, j, (t), aux, cs, w); else peA_compute(F, F.PA, j, (t), pe_quant16(aux, aux2, cs), w); } while (0)
    pe_load_ix(F, t0, ixA); pe_load_rows(TAB, ixA, rowoff, wA); PE_AUX(t0, auxA, aux2A, csA); pe_load_ix(F, t0 + 1, ixB);
#pragma unroll 1
    for (int k = 0; k < PE_TPI - 2; k += 2) {
        pe_load_rows(TAB, ixB, rowoff, wB); PE_AUX(t0 + k + 1, auxB, aux2B, csB);
        pe_load_ix(F, t0 + k + 2, ixA);
        PE_COMPUTE(t0 + k, auxA, aux2A, csA, wA);
        pe_load_rows(TAB, ixA, rowoff, wA); PE_AUX(t0 + k + 2, auxA, aux2A, csA); pe_load_ix(F, t0 + k + 3, ixB);
        PE_COMPUTE(t0 + k + 1, auxB, aux2B, csB, wB);
    }
    pe_load_rows(TAB, ixB, rowoff, wB); PE_AUX(t0 + PE_TPI - 1, auxB, aux2B, csB);
    PE_COMPUTE(t0 + PE_TPI - 2, auxA, aux2A, csA, wA);
    PE_COMPUTE(t0 + PE_TPI - 1, auxB, aux2B, csB, wB);
#undef PE_AUX
#undef PE_COMPUTE
}

template <bool PHASE_B> __device__ __forceinline__ void p6_sliced(Frame& F) {
    const unsigned x = xb_xcc_id() & 7u;
    gu32* Q = F.ctl + (PHASE_B ? CW_QB : CW_QA);
    for (unsigned s = 0; s < 8; ++s) {
        const int j = (int)((x + s) & 7u);
        for (;;) {
            unsigned c = 0;
            if (F.lane == 0) c = __hip_atomic_fetch_add((unsigned*)(Q + 64 * j), 1u, __ATOMIC_RELAXED, __HIP_MEMORY_SCOPE_AGENT);
            c = (unsigned)__builtin_amdgcn_readfirstlane((int)c);
            if (c >= (unsigned)PE_NITEM) break;
            pe_item<PHASE_B>(F, j, (int)c * PE_TPI);
        }
    }
}

__device__ __forceinline__ void p6_fill_scales(Frame& F) {
    const char* src = (const char*)F.ws + (F.wave < 4 ? (size_t)WS_SCU + (size_t)F.wave * 16384 : (size_t)WS_SCV + (size_t)(F.wave - 4) * 16384) + F.lane * 16;
    LAS unsigned char* dst = F.lds + F.wave * 16384;
#pragma unroll
    for (int i = 0; i < 16; ++i) __builtin_amdgcn_global_load_lds((const unsigned*)(src + i * 1024), (LAS unsigned*)(dst + i * 1024), 16, 0, 0);
}
__device__ __forceinline__ void p6_reduce(Frame& F) {
    const int gw = F.vcu * NWAVES + F.wave, NGW = F.G * NWAVES, lane = F.lane;
    const int p0 = 16 * (lane >> 3) + (lane & 7);
    constexpr int NB = 4;
    asm volatile("s_waitcnt vmcnt(0)" ::: "memory"); __syncthreads();
    const LAS float* lscu = (const LAS float*)F.lds; const LAS float* lscv = (const LAS float*)(F.lds + 65536);
    for (int tb = gw * NB; tb < TOK; tb += NGW * NB) {
        int s[NB][2], e[NB][2]; float gt[NB][2], hs[NB];
#pragma unroll
        for (int b = 0; b < NB; ++b) {
            const int t = tb + b; hs[b] = F.HS[t];
            int a0 = 0, a1 = 0;
#pragma unroll
            for (int j = 0; j < 8; ++j) { const unsigned w = __builtin_nontemporal_load((const GAS unsigned*)F.PA + ((size_t)j * TOK + t) * 64 + lane); a0 += (int)(short)(w & 0xffffu); a1 += (int)w >> 16; }
            s[b][0] = a0; s[b][1] = a1;
#pragma unroll
            for (int hh = 0; hh < 2; ++hh) { const int p = p0 + 8 * hh; e[b][hh] = (int)F.EIDX[(size_t)t * 128 + p]; gt[b][hh] = F.GATE[(size_t)t * 128 + p]; }
        }
        float su[NB][2], sv[NB][2];
#pragma unroll
        for (int b = 0; b < NB; ++b)
#pragma unroll
            for (int hh = 0; hh < 2; ++hh) { su[b][hh] = lscu[e[b][hh]]; sv[b][hh] = lscv[e[b][hh]]; }
#pragma unroll
        for (int b = 0; b < NB; ++b) {
            const int t = tb + b;
            float cf[2]; float mx = 0.f;
#pragma unroll
            for (int hh = 0; hh < 2; ++hh) { const float a = hs[b] * su[b][hh] * (64.0f * (float)s[b][hh]);
                cf[hh] = gt[b][hh] * 0.5f * a * (1.0f + erff(a * 0.70710678118654752f)) * sv[b][hh]; mx = fmaxf(mx, fabsf(cf[hh])); }
#pragma unroll
            for (int o = 1; o < 64; o <<= 1) mx = fmaxf(mx, __shfl_xor(mx, o));
            const float sc = fmaxf(mx, 1e-30f) * (1.0f / 127.0f), inv = 1.0f / sc;
#pragma unroll
            for (int hh = 0; hh < 2; ++hh) {
                int v = ((int)rintf(cf[hh] * inv) & 0xff) << (8 * (lane & 3));
                v |= dpp_i<DPP_XOR1>(v); v |= dpp_i<DPP_XOR2>(v);
                if ((lane & 3) == 0) F.CQ[(size_t)t * 32 + ((p0 + 8 * hh) >> 2)] = (unsigned)v;
            }
            if (lane == 0) F.CS[t] = sc;
        }
    }
}

__device__ __forceinline__ void p5_scales(Frame& F) {
    const int gt = F.vcu * NWAVES * 64 + F.tid, NGT = F.G * NWAVES * 64;
    for (int t = gt; t < TOK; t += NGT) {
        float mx = 0.f, ss = 0.f;
#pragma unroll
        for (int q = 0; q < 4; ++q) { const f32x4 m = *(const GAS f32x4*)(F.MAXP + (size_t)t * 16 + 4 * q), p = *(const GAS f32x4*)(F.SSQ2P + (size_t)t * 16 + 4 * q);
            mx = fmaxf(mx, fmaxf(fmaxf(m[0], m[1]), fmaxf(m[2], m[3]))); ss += (p[0] + p[1]) + (p[2] + p[3]); }
        const float rstd2 = 1.0f / sqrtf(ss * (1.0f / DM) + pg8::EPS_F), sc = fmaxf(mx, 1e-20f) * (1.0f / 127.0f);
        F.HINV[t] = 1.0f / sc; F.HS[t] = sc * rstd2;
    }
}

#ifndef PROBE_REPEAT
#define PROBE_REPEAT -1
#endif
struct Args { const float* in[16]; float* out; unsigned char* ws; int ph_lo, ph_hi; };

template <class Sched> __device__ __forceinline__ void prep_tab_outproj(Frame& F, const Sched& S) {
    LAS float* tab = (LAS float*)(F.lds + TAB_OFF);
    pg8::Unit u;
    for (int i = 0; S.next(i, u) && i < 4; ++i) {
        if (F.tid < 256) {
            const int row = u.pm * 256 + F.tid;
            const f32x4 a0 = *(const GAS f32x4*)(F.SSQA + (size_t)row * 8), a1 = *(const GAS f32x4*)(F.SSQA + (size_t)row * 8 + 4);
            const f32x4 s0 = *(const GAS f32x4*)(F.SSQS + (size_t)row * 8), s1 = *(const GAS f32x4*)(F.SSQS + (size_t)row * 8 + 4);
            const float sa = ((a0[0] + a0[1]) + (a0[2] + a0[3])) + ((a1[0] + a1[1]) + (a1[2] + a1[3]));
            const float ss = ((s0[0] + s0[1]) + (s0[2] + s0[3])) + ((s1[0] + s1[1]) + (s1[2] + s1[3]));
            const float ra = 1.0f / sqrtf(sa * (1.0f / 512.0f) + pg8::EPS_F), rs = 1.0f / sqrtf(ss * (1.0f / 512.0f) + pg8::EPS_F);
            tab[(i * 256 + F.tid) * 2] = ra / rs; tab[(i * 256 + F.tid) * 2 + 1] = rs;
        }
    }
    LDS_WAIT(); __syncthreads();
}
template <class Sched> __device__ __forceinline__ void prep_tab_query(Frame& F, const Sched& S) {
    LAS float* tab = (LAS float*)(F.lds + TAB_OFF);
    pg8::Unit u;
    for (int i = 0; S.next(i, u) && i < 8; ++i) {
        if (F.tid < 256) {
            const int row = u.pm * 256 + F.tid; float s = 0.f;
#pragma unroll
            for (int j = 0; j < 4; ++j) { const f32x4 p = *(const GAS f32x4*)(F.SSQ2P + (size_t)row * 16 + 4 * j); s += (p[0] + p[1]) + (p[2] + p[3]); }
            tab[i * 256 + F.tid] = 1.0f / sqrtf(s * (1.0f / DM) + pg8::EPS_F);
        }
    }
    LDS_WAIT(); __syncthreads();
}

template <class Sched> __device__ __forceinline__ void prep_tab_inproj(Frame& F, const Sched& S) {
    LAS float* tab = (LAS float*)(F.lds + TAB_OFF);
    LAS float* gtab = (LAS float*)(F.lds + TAB_OFF + 8192);
    pg8::Unit u;
    for (int i = 0; S.next(i, u) && i < 8; ++i)
        if (F.tid < 256) tab[i * 256 + F.tid] = F.RSTD1[u.pm * 256 + F.tid];
    for (int i = F.tid; i < 640; i += NWAVES * 64) gtab[i] = (i < 64) ? F.q_norm_g[i] * pg8::QSCALE : (i < 128) ? F.k_norm_g[i - 64] : F.sgu_norm_g[i - 128];
    LDS_WAIT(); __syncthreads();
}
__device__ __forceinline__ void run_p1(Frame& F) {
    pg8::Gemm g{F.XB, F.Win_t, TOK, INW, DM}; pg8::StaticOrder S; S.init(TOK, INW, F.G, (int)blockIdx.x);
    prep_tab_inproj(F, S);
    pg8::EpiInProj E{(const LAS float*)(F.lds + TAB_OFF), (const LAS float*)(F.lds + TAB_OFF + 8192), F.Q, WS_TYPE_STRIDE / 2};
    pg8::gemm_phase<pg8::EpiInProj, pg8::StaticOrder, true, true>(F.lds + RING_OFF, g, S, E);
}
__device__ __forceinline__ void run_p3(Frame& F) {
    pg8::Gemm g{F.MIX, F.Wout_t, TOK, DM, DM}; pg8::StaticOrder S; S.init(TOK, DM, F.G, (int)blockIdx.x);
    prep_tab_outproj(F, S);
    pg8::EpiOutProj E{F.x, F.out, F.XB, F.SSQ2P, F.MAXP, (const LAS float*)(F.lds + TAB_OFF)};
    pg8::gemm_phase<pg8::EpiOutProj, pg8::StaticOrder, true, true>(F.lds + RING_OFF, g, S, E);
}
__device__ __forceinline__ void run_p4(Frame& F) {
    pg8::Gemm g{F.XB, F.Wq_t, TOK, QPW, DM}; pg8::StaticOrder S; S.init(TOK, QPW, F.G, (int)blockIdx.x);
    prep_tab_query(F, S);
    pg8::EpiQuery E{F.QP, (const LAS float*)(F.lds + TAB_OFF)};
    pg8::gemm_phase<pg8::EpiQuery, pg8::StaticOrder, true, true>(F.lds + RING_OFF, g, S, E);
}

__global__ void __launch_bounds__(NWAVES * 64, 2) hyb_fwd(Args args) {
    extern __shared__ __attribute__((aligned(16))) unsigned char lds[];
    Frame F;
    F.lds = (LAS unsigned char*)lds;
    F.MISC = (volatile LAS unsigned*)(F.lds + MISC_OFF);
    F.tid = threadIdx.x; F.lane = F.tid & 63; F.wave = __builtin_amdgcn_readfirstlane(F.tid >> 6);
    F.G = gridDim.x; { const int bx = blockIdx.x; F.vcu = (F.G % 8 == 0) ? (bx % 8) * (F.G / 8) + bx / 8 : bx; }
    unsigned char* ws = args.ws;
    F.ctl = (gu32*)(ws + WS_CTL);
    F.x = args.in[0]; F.norm1_g = args.in[1]; F.w_in = args.in[2]; F.q_norm_g = args.in[3]; F.k_norm_g = args.in[4]; F.sgu_norm_g = args.in[5]; F.sgu_w = args.in[6]; F.sgu_b = args.in[7];
    F.attn_out_g = args.in[8]; F.sgu_out_g = args.in[9]; F.w_out = args.in[10]; F.norm2_g = args.in[11]; F.w_query = args.in[12]; F.sub_keys = args.in[13]; F.expert_u = args.in[14]; F.expert_v = args.in[15];
    F.out = args.out;
    F.Win_t = (bf16*)(ws + WS_WIN); F.Wout_t = (bf16*)(ws + WS_WOUT); F.Wq_t = (bf16*)(ws + WS_WQ); F.SK = (bf16*)(ws + WS_SK); F.SGUW = (bf16*)(ws + WS_SGUW);
    F.U8 = (signed char*)(ws + WS_UB); F.V8 = (signed char*)(ws + WS_VB); F.ws = ws;
    F.H8 = (signed char*)(ws + WS_H8); F.MAXP = (float*)(ws + WS_MAXP); F.HINV = (float*)(ws + WS_HINV); F.HS = (float*)(ws + WS_HS); F.PA = (int*)(ws + WS_PA); F.CQ = (unsigned*)(ws + WS_COEF); F.CS = (float*)(ws + WS_COEF0);
    F.XB = (bf16*)(ws + WS_XB); F.Q = (bf16*)(ws + WS_Q); F.QP = (bf16*)(ws + WS_QP); F.MIX = (bf16*)(ws + WS_MIX);
    F.RSTD1 = (float*)(ws + WS_RSTD1); F.SSQA = (float*)(ws + WS_SSQA); F.SSQS = (float*)(ws + WS_SSQS); F.SSQ2P = (float*)(ws + WS_SSQ2P); F.GATE = (float*)(ws + WS_GATE); F.EIDX = (unsigned short*)(ws + WS_EIDX);
    for (int u = F.tid; u < (LDS_BYTES - LDSCTL_OFF) / 4; u += NWAVES * 64) ((LAS unsigned*)(F.lds + LDSCTL_OFF))[u] = 0u;
    __syncthreads();
    XcdBarrier bar; bar.bar = (unsigned*)(F.ctl + CW_BAR); bar.x = 0; bar.st = nullptr;
    const int lo = args.ph_lo, hi = args.ph_hi;
    if (hi - lo > 1) bar = xcd_barrier_post((unsigned*)(F.ctl + CW_BAR), F.MISC + 8);
#define IN(k) (lo <= (k) && (k) < hi)

#define SEAM(k) do { if (IN(k) && IN((k) + 1)) { xcd_barrier(bar); if (PROBE_REPEAT == 100 + (k)) { xcd_barrier(bar); xcd_barrier(bar); xcd_barrier(bar); xcd_barrier(bar); } } } while (0)

    if (IN(0)) { p0_prologue(F); if (PROBE_REPEAT == 0) { xcd_barrier(bar); p0_prologue(F); } } SEAM(0);
    if (IN(1)) { run_p1(F); if (PROBE_REPEAT == 1) { xcd_barrier(bar); run_p1(F); } } SEAM(1);
    if (IN(2)) { p2_mixers(F); if (PROBE_REPEAT == 2) { xcd_barrier(bar); p2_mixers(F); } } SEAM(2);
    if (IN(3)) { run_p3(F); if (PROBE_REPEAT == 3) { xcd_barrier(bar); run_p3(F); } } SEAM(3);
    if (IN(4)) { run_p4(F); if (PROBE_REPEAT == 4) { xcd_barrier(bar); run_p4(F); } }
    if (!(IN(4) && IN(5))) {   } else { asm volatile("s_waitcnt vmcnt(0)" ::: "memory"); __syncthreads(); }
    if (IN(5)) {
#pragma unroll 1
        for (int rep = 0; rep < (PROBE_REPEAT == 5 ? 2 : 1); ++rep) p5_topk(F);
#pragma unroll 1
        for (int rep = 0; rep < (PROBE_REPEAT == 15 ? 2 : 1); ++rep) p5_scales(F);
    } SEAM(5);
    if (IN(6)) {
        p6_fill_scales(F);
#pragma unroll 1
        for (int rep = 0; rep < (PROBE_REPEAT == 6 ? 2 : 1); ++rep) {
            if (rep) { xcd_barrier(bar); if (blockIdx.x == 0 && F.tid < 8) __hip_atomic_store((unsigned*)(F.ctl + CW_QA + 64 * F.tid), 0u, __ATOMIC_RELAXED, __HIP_MEMORY_SCOPE_AGENT); xcd_barrier(bar); }
            p6_sliced<false>(F);
        }
        if (hi - lo > 1) xcd_barrier(bar);
#pragma unroll 1
        for (int rep = 0; rep < (PROBE_REPEAT == 7 ? 2 : 1); ++rep) p6_reduce(F);
        if (hi - lo > 1) xcd_barrier(bar);
#pragma unroll 1
        for (int rep = 0; rep < (PROBE_REPEAT == 8 ? 2 : 1); ++rep) {
            if (rep) { xcd_barrier(bar); if (blockIdx.x == 0 && F.tid < 8) __hip_atomic_store((unsigned*)(F.ctl + CW_QB + 64 * F.tid), 0u, __ATOMIC_RELAXED, __HIP_MEMORY_SCOPE_AGENT); xcd_barrier(bar); }
            p6_sliced<true>(F);
        }
    }
#undef IN
#undef SEAM
}

extern "C" void kernel_launch(void* const* d_in, const int* in_sizes, int n_in, void* d_out, int out_size, void* d_ws, size_t ws_size, hipStream_t stream) {
    static int grid = 0;
    if (grid == 0) {
        if (n_in != 16 || in_sizes[0] != TOK * DM || out_size != TOK * DM || ws_size < WS_END) { fprintf(stderr, "kernel_launch: unexpected shapes (n_in %d, in0 %d, out %d, ws %zu)\n", n_in, n_in > 0 ? in_sizes[0] : -1, out_size, ws_size); grid = -1; return; }
        int dev = 0, cus = 0, per_cu = 0;
        if (hipGetDevice(&dev) != hipSuccess || hipDeviceGetAttribute(&cus, hipDeviceAttributeMultiprocessorCount, dev) != hipSuccess) { fprintf(stderr, "kernel_launch: device query failed\n"); grid = -1; return; }
        if (hipFuncSetAttribute((const void*)hyb_fwd, hipFuncAttributeMaxDynamicSharedMemorySize, LDS_BYTES) != hipSuccess) { fprintf(stderr, "kernel_launch: hipFuncSetAttribute failed\n"); grid = -1; return; }
        if (hipOccupancyMaxActiveBlocksPerMultiprocessor(&per_cu, (const void*)hyb_fwd, NWAVES * 64, LDS_BYTES) != hipSuccess || per_cu < 1) { fprintf(stderr, "kernel_launch: occupancy query reports %d blocks per CU\n", per_cu); per_cu = 1; }
        (void)hipGetLastError();
        grid = cus;
        if (grid % 8 != 0) grid -= grid % 8;
    }
    if (grid < 0) return;
    (void)hipMemsetAsync((char*)d_ws + WS_CTL, 0, CTL_ZERO_BYTES, stream);
    Args a{};
    for (int i = 0; i < 16; ++i) a.in[i] = (const float*)d_in[i];
    a.out = (float*)d_out; a.ws = (unsigned char*)d_ws;
    if (N_LAUNCHES == 1) { a.ph_lo = 0; a.ph_hi = NPHASE; hipLaunchKernelGGL(hyb_fwd, dim3(grid), dim3(NWAVES * 64), LDS_BYTES, stream, a); }
    else for (int li = 0; li < NPHASE; ++li) { a.ph_lo = li; a.ph_hi = li + 1; hipLaunchKernelGGL(hyb_fwd, dim3(grid), dim3(NWAVES * 64), LDS_BYTES, stream, a); }
}
```

```cpp
#include <hip/hip_runtime.h>
#include <cstdio>
#include <cstdint>
#include <cmath>
namespace pg8 {
#define PG8_LAS __attribute__((address_space(3)))
typedef unsigned short bf16_t;
typedef short bf16x8 __attribute__((ext_vector_type(8)));
typedef float f32x4 __attribute__((ext_vector_type(4)));
typedef unsigned u32x4 __attribute__((ext_vector_type(4)));
constexpr int BM = 256, BK = 64, HALF = 128, HTB = HALF * BK * 2  , STAGE_BYTES = 8 * HTB, NXCD = 8, WGM = 8;

__host__ __device__ __forceinline__ int lds_byte(int r, int c) { const int st = (r >> 4) * 2 + (c >> 5), rr = r & 15, cc = c & 31, ob = rr * 64 + cc * 2; return st * 1024 + (ob ^ (((ob >> 9) & 1) << 5)); }
__host__ __device__ __forceinline__ void stage_rc(int b, int& R, int& C) { const int st = b / 1024, sb = b % 1024, swz = sb ^ (((sb >> 9) & 1) << 5); R = (st >> 1) * 16 + swz / 64; C = (st & 1) * 32 + (swz % 64) / 2; }
__host__ __device__ __forceinline__ int perm32(int rho) { const int n = rho >> 4, i = rho & 15; return 8 * (i >> 2) + 4 * n + (i & 3); }

struct Unit { int pm, pn; };
struct Gemm { const bf16_t* A; const bf16_t* Bt; int M, N, K; };

struct StaticOrder {
    int nM, nN, nwg, G, c;
    __host__ __device__ void init(int M, int N, int G_, int c_) { nM = M / BM; nN = N / BM; nwg = nM * nN; G = G_; c = c_; }
    __host__ __device__ bool next(int i, Unit& u) const {
        const long L = (long)i * G + c; if (L >= nwg) return false;
        int wgid = (int)L; { const int q = nwg / NXCD, r = nwg % NXCD, xcd = wgid % NXCD, off = wgid / NXCD; wgid = (xcd < r ? xcd * (q + 1) : r * (q + 1) + (xcd - r) * q) + off; }
        const int nig = WGM * nN, gid = wgid / nig, fm = gid * WGM, gsz = (nM - fm) < WGM ? (nM - fm) : WGM;
        u.pm = fm + ((wgid % nig) % gsz); u.pn = (wgid % nig) / gsz; return true;
    }
    __device__ __forceinline__ void a_ready(const Unit&) const {}
    __device__ __forceinline__ void done(const Unit&) const {}
};


__device__ __forceinline__ unsigned cvt_pk_bf16(float lo, float hi) { unsigned r; asm volatile("v_cvt_pk_bf16_f32 %0, %1, %2" : "=v"(r) : "v"(lo), "v"(hi)); return r; }

constexpr float EPS_F = 1e-6f;
constexpr float QSCALE = 0.125f * 1.4426950408889634f;

struct EpiInProj {
    static constexpr bool PERM = true; static constexpr int MID_T = 0;
    const PG8_LAS float* tab;
    const PG8_LAS float* gtab;
    bf16_t* out0; size_t type_stride;
    __device__ __forceinline__ void operator()(const f32x4 (&acc)[2][2][4][2], const Unit& u, int ui, int wr, int wc, int fr, int fq) const {
        const int type = u.pn >> 1, half = u.pn & 1;
        bf16_t* base = out0 + (size_t)type * type_stride;
        const int colb = 256 * half + 64 * wc + 8 * fq;
        const bool normed = (type == 0) || (type == 1) || (type == 4);
        const int goff = (type == 0) ? 8 * fq : (type == 1) ? 64 + 8 * fq : 128 + colb;
        float g[2][8];
#pragma unroll
        for (int bj = 0; bj < 2; ++bj) {
            const f32x4 g0 = *(const PG8_LAS f32x4*)(gtab + goff + 32 * bj), g1 = *(const PG8_LAS f32x4*)(gtab + goff + 32 * bj + 4);
#pragma unroll
            for (int e = 0; e < 4; ++e) { g[bj][e] = normed ? g0[e] : 1.f; g[bj][4 + e] = normed ? g1[e] : 1.f; }
        }
#pragma unroll
        for (int ai = 0; ai < 2; ++ai)
#pragma unroll
            for (int m = 0; m < 4; ++m) {
                const int lr = ai * HALF + wr * 64 + m * 16 + fr, row = u.pm * BM + lr;
                const float rs = tab[ui * 256 + lr];
                f32x4 v[2][2];
                float ss = 0.f;
#pragma unroll
                for (int bj = 0; bj < 2; ++bj)
#pragma unroll
                    for (int n = 0; n < 2; ++n) { v[bj][n] = acc[ai][bj][m][n] * rs; const f32x4 x = v[bj][n]; ss += (x[0] * x[0] + x[1] * x[1]) + (x[2] * x[2] + x[3] * x[3]); }
                float r = 1.f;
                if (normed) { ss += __shfl_xor(ss, 16); ss += __shfl_xor(ss, 32); r = 1.0f / sqrtf(ss * (1.0f / 64.0f) + EPS_F); }
                bf16_t* rowp = base + (size_t)row * 512 + colb;
#pragma unroll
                for (int bj = 0; bj < 2; ++bj) {
                    const f32x4 a = v[bj][0], b = v[bj][1];
                    u32x4 w;
                    w.x = cvt_pk_bf16(a[0] * r * g[bj][0], a[1] * r * g[bj][1]); w.y = cvt_pk_bf16(a[2] * r * g[bj][2], a[3] * r * g[bj][3]);
                    w.z = cvt_pk_bf16(b[0] * r * g[bj][4], b[1] * r * g[bj][5]); w.w = cvt_pk_bf16(b[2] * r * g[bj][6], b[3] * r * g[bj][7]);
                    *(u32x4*)(rowp + 32 * bj) = w;
                }
            }
    }
};

struct EpiOutProj {
    static constexpr bool PERM = true; static constexpr int MID_T = 8;
    const float* x; float* x1; bf16_t* x1b; float* ssq2p; float* maxp; const PG8_LAS float* tab;
    __device__ __forceinline__ void mid(f32x4 (&acc)[2][2][4][2], const Unit&, int ui, int wr, int, int fr, int) const {
#pragma unroll
        for (int ai = 0; ai < 2; ++ai)
#pragma unroll
            for (int m = 0; m < 4; ++m) {
                const float rt = tab[(ui * 256 + ai * HALF + wr * 64 + m * 16 + fr) * 2];
#pragma unroll
                for (int bj = 0; bj < 2; ++bj)
#pragma unroll
                    for (int n = 0; n < 2; ++n) acc[ai][bj][m][n] *= rt;
            }
    }
    __device__ __forceinline__ void operator()(const f32x4 (&acc)[2][2][4][2], const Unit& u, int ui, int wr, int wc, int fr, int fq) const {
        const size_t cbase = (size_t)u.pn * BM + wc * 32 + 8 * fq;
        u32x4 xn[2];
#define OP_LOADX(it_) do { const int r_ = u.pm * BM + ((it_) >> 2) * HALF + wr * 64 + ((it_) & 3) * 16 + fr; \
            _Pragma("unroll") for (int bj = 0; bj < 2; ++bj) xn[bj] = *(const u32x4*)(x1b + (size_t)r_ * 1024 + cbase + bj * HALF); } while (0)
        OP_LOADX(0);
#pragma unroll
        for (int it = 0; it < 8; ++it) {
            const int ai = it >> 2, m = it & 3;
            const int lr = ai * HALF + wr * 64 + m * 16 + fr, row = u.pm * BM + lr;
            const float rs = tab[(ui * 256 + lr) * 2 + 1];
            u32x4 xc[2];
#pragma unroll
            for (int bj = 0; bj < 2; ++bj) xc[bj] = xn[bj];
            if (it + 1 < 8) OP_LOADX(it + 1);
            float ss = 0.f, mx = 0.f;
#pragma unroll
            for (int bj = 0; bj < 2; ++bj) {
                const size_t off = (size_t)row * 1024 + cbase + bj * HALF;
                f32x4 xa, xb_; xa[0] = __builtin_bit_cast(float, xc[bj].x << 16); xa[1] = __builtin_bit_cast(float, xc[bj].x & 0xffff0000u); xa[2] = __builtin_bit_cast(float, xc[bj].y << 16); xa[3] = __builtin_bit_cast(float, xc[bj].y & 0xffff0000u);
                xb_[0] = __builtin_bit_cast(float, xc[bj].z << 16); xb_[1] = __builtin_bit_cast(float, xc[bj].z & 0xffff0000u); xb_[2] = __builtin_bit_cast(float, xc[bj].w << 16); xb_[3] = __builtin_bit_cast(float, xc[bj].w & 0xffff0000u);
                const f32x4 a = xa + acc[ai][bj][m][0] * rs, b = xb_ + acc[ai][bj][m][1] * rs;
                ss += (a[0] * a[0] + a[1] * a[1]) + (a[2] * a[2] + a[3] * a[3]) + (b[0] * b[0] + b[1] * b[1]) + (b[2] * b[2] + b[3] * b[3]);
                mx = fmaxf(mx, fmaxf(fmaxf(fmaxf(fabsf(a[0]), fabsf(a[1])), fmaxf(fabsf(a[2]), fabsf(a[3]))), fmaxf(fmaxf(fabsf(b[0]), fabsf(b[1])), fmaxf(fabsf(b[2]), fabsf(b[3])))));
                u32x4 w; w.x = cvt_pk_bf16(a[0], a[1]); w.y = cvt_pk_bf16(a[2], a[3]); w.z = cvt_pk_bf16(b[0], b[1]); w.w = cvt_pk_bf16(b[2], b[3]);
                *(u32x4*)(x1b + off) = w;
            }
            ss += __shfl_xor(ss, 16); ss += __shfl_xor(ss, 32); mx = fmaxf(mx, __shfl_xor(mx, 16)); mx = fmaxf(mx, __shfl_xor(mx, 32));
            if (fq == 0) { ssq2p[(size_t)row * 16 + u.pn * 4 + wc] = ss; maxp[(size_t)row * 16 + u.pn * 4 + wc] = mx; }
        }
#undef OP_LOADX
    }
};

struct EpiQuery {
    static constexpr bool PERM = true; static constexpr int MID_T = 0;
    bf16_t* qp; const PG8_LAS float* tab;
    __device__ __forceinline__ void operator()(const f32x4 (&acc)[2][2][4][2], const Unit& u, int ui, int wr, int wc, int fr, int fq) const {
#pragma unroll
        for (int ai = 0; ai < 2; ++ai)
#pragma unroll
            for (int m = 0; m < 4; ++m) {
                const int lr = ai * HALF + wr * 64 + m * 16 + fr, row = u.pm * BM + lr;
                const float rs = tab[ui * 256 + lr];
#pragma unroll
                for (int bj = 0; bj < 2; ++bj) {
                    const size_t off = ((((size_t)(row >> 5) * 8 + u.pn) * 2 + bj) * 8 + 2 * wc + (fq >> 1)) * 512 + (size_t)(32 * (fq & 1) + (row & 31)) * 8;
                    const f32x4 a = acc[ai][bj][m][0] * rs, b = acc[ai][bj][m][1] * rs;
                    u32x4 w; w.x = cvt_pk_bf16(a[0], a[1]); w.y = cvt_pk_bf16(a[2], a[3]); w.z = cvt_pk_bf16(b[0], b[1]); w.w = cvt_pk_bf16(b[2], b[3]);
                    *(u32x4*)(qp + off) = w;
                }
            }
    }
};

template <class Epi, class Sched, bool ALIGN_EPI = false, bool SP2 = false>
__device__ __forceinline__ void gemm_phase(PG8_LAS unsigned char* lds, const Gemm g, const Sched& S, const Epi& E) {
    const int tid = threadIdx.x, wid = __builtin_amdgcn_readfirstlane(tid >> 6), lane = tid & 63, wr = wid >> 2, wc = wid & 3, fr = lane & 15, fq = lane >> 4;
    const int K = g.K, nt = K / BK;
    unsigned voffA[2], voffB[2];
#pragma unroll
    for (int i = 0; i < 2; ++i) { int R, C; stage_rc(tid * 16 + i * 8192, R, C); const int Rb = Epi::PERM ? ((R & ~31) + perm32(R & 31)) : R;
        voffA[i] = (unsigned)(R * K + C) * 2u; voffB[i] = (unsigned)(Rb * K + C) * 2u; }
    const size_t kstep = (size_t)(BK * 2);
    const size_t hstep = (size_t)HALF * K * 2;
    const size_t tstep = 2 * hstep;
    const unsigned ldsw = (unsigned)wid * 1024u;
    const int aoff = lds_byte(wr * 64 + fr, fq * 8), boff = lds_byte(wc * 32 + fr, fq * 8);
#define PG8_SA(b, h) (((b) * 2 + (h)) * HTB)
#define PG8_SB(b, h) ((4 + (b) * 2 + (h)) * HTB)
#define PG8_STAGE(bufoff, gbase, voff) do { _Pragma("unroll") for (int _i = 0; _i < 2; ++_i) \
        __builtin_amdgcn_global_load_lds((const unsigned*)((const char*)(gbase) + (voff)[_i]), (PG8_LAS unsigned*)(lds + (bufoff) + ldsw + _i * 8192), 16, 0, 0); } while (0)
#define PG8_LDA(dst, b, h) do { _Pragma("unroll") for (int m = 0; m < 4; ++m) _Pragma("unroll") for (int k = 0; k < 2; ++k) dst[m][k] = *(const PG8_LAS bf16x8*)(lds + PG8_SA(b, h) + aoff + m * 2048 + k * 1024); } while (0)
#define PG8_LDB(dst, b, h) do { _Pragma("unroll") for (int n = 0; n < 2; ++n) _Pragma("unroll") for (int k = 0; k < 2; ++k) dst[n][k] = *(const PG8_LAS bf16x8*)(lds + PG8_SB(b, h) + boff + n * 2048 + k * 1024); } while (0)
#define PG8_MMA(ai, bj, At, Bt) do { __builtin_amdgcn_s_setprio(1); _Pragma("unroll") for (int m = 0; m < 4; ++m) _Pragma("unroll") for (int n = 0; n < 2; ++n) _Pragma("unroll") for (int k = 0; k < 2; ++k) \
        acc[ai][bj][m][n] = __builtin_amdgcn_mfma_f32_16x16x32_bf16(Bt[n][k], At[m][k], acc[ai][bj][m][n], 0, 0, 0); __builtin_amdgcn_s_setprio(0); } while (0)
#define PG8_WAIT_V(n) asm volatile("s_waitcnt vmcnt(" #n ")" ::: "memory")
#define PG8_WAIT_L(n) asm volatile("s_waitcnt lgkmcnt(" #n ")" ::: "memory")
#define PG8_BAR __builtin_amdgcn_s_barrier()
#define PG8_SCHED __builtin_amdgcn_sched_barrier(0)
    Unit cur, nxt; int ui = 0;
    if (!S.next(0, cur)) return;
    f32x4 acc[2][2][4][2];
#pragma unroll
    for (int a = 0; a < 2; ++a)
#pragma unroll
        for (int b = 0; b < 2; ++b)
#pragma unroll
            for (int m = 0; m < 4; ++m)
#pragma unroll
                for (int n = 0; n < 2; ++n) acc[a][b][m][n] = (f32x4){0.f, 0.f, 0.f, 0.f};
    bf16x8 At[4][2], B0[2][2], B1[2][2];
    const char* cA = (const char*)g.A + (size_t)cur.pm * tstep; const char* cB = (const char*)g.Bt + (size_t)cur.pn * tstep;
    S.a_ready(cur);
    if constexpr (SP2) {
        PG8_STAGE(PG8_SB(0, 0), cB, voffB); PG8_STAGE(PG8_SB(0, 1), cB + hstep, voffB); PG8_STAGE(PG8_SA(0, 0), cA, voffA); PG8_STAGE(PG8_SA(0, 1), cA + hstep, voffA);
        if (wr == 1) PG8_BAR;
        PG8_WAIT_V(2); PG8_BAR;
        PG8_STAGE(PG8_SB(1, 0), cB + kstep, voffB); PG8_STAGE(PG8_SA(1, 0), cA + kstep, voffA); PG8_STAGE(PG8_SB(1, 1), cB + hstep + kstep, voffB);
        PG8_WAIT_V(6); PG8_BAR;
    } else {
        PG8_STAGE(PG8_SB(0, 0), cB, voffB); PG8_STAGE(PG8_SA(0, 0), cA, voffA); PG8_STAGE(PG8_SB(0, 1), cB + hstep, voffB); PG8_STAGE(PG8_SA(0, 1), cA + hstep, voffA);
        if (wr == 1) PG8_BAR;
        PG8_WAIT_V(4); PG8_BAR;
        PG8_STAGE(PG8_SB(1, 0), cB + kstep, voffB); PG8_STAGE(PG8_SA(1, 0), cA + kstep, voffA); PG8_STAGE(PG8_SB(1, 1), cB + hstep + kstep, voffB);
        PG8_WAIT_V(6); PG8_BAR;
    }
    for (;;) {
        const bool has_next = S.next(ui + 1, nxt);
        const char* nA = has_next ? (const char*)g.A + (size_t)nxt.pm * tstep : cA; const char* nB = has_next ? (const char*)g.Bt + (size_t)nxt.pn * tstep : cB;
        for (int t = 0; t < nt; t += 2) {
            if constexpr (Epi::MID_T > 0) { if (t == Epi::MID_T) E.mid(acc, cur, ui, wr, wc, fr, fq); }
            const bool last = (t == nt - 2);
            const char* a1 = cA + (size_t)(t + 1) * kstep;
            const char* a2 = last ? nA : cA + (size_t)(t + 2) * kstep; const char* b2 = last ? nB : cB + (size_t)(t + 2) * kstep;
            const char* a3 = a2 + kstep; const char* b3 = b2 + kstep;
            if (last && has_next) S.a_ready(nxt);
            if constexpr (SP2) {
            PG8_LDB(B0, 0, 0); PG8_LDB(B1, 0, 1); PG8_SCHED; PG8_LDA(At, 0, 0); PG8_STAGE(PG8_SA(1, 1), a1 + hstep, voffA);
            PG8_WAIT_V(8); PG8_WAIT_L(0); PG8_BAR; PG8_MMA(0, 0, At, B0); PG8_MMA(0, 1, At, B1); PG8_BAR; PG8_SCHED;
            PG8_LDA(At, 0, 1); PG8_STAGE(PG8_SB(0, 0), b2, voffB); PG8_STAGE(PG8_SB(0, 1), b2 + hstep, voffB); PG8_STAGE(PG8_SA(0, 0), a2, voffA);
            PG8_WAIT_V(8); PG8_WAIT_L(0); PG8_BAR; PG8_MMA(1, 0, At, B0); PG8_MMA(1, 1, At, B1); PG8_BAR; PG8_SCHED;
            PG8_LDB(B0, 1, 0); PG8_LDB(B1, 1, 1); PG8_SCHED; PG8_LDA(At, 1, 0); PG8_STAGE(PG8_SA(0, 1), a2 + hstep, voffA);
            PG8_WAIT_V(8); PG8_WAIT_L(0); PG8_BAR; PG8_MMA(0, 0, At, B0); PG8_MMA(0, 1, At, B1); PG8_BAR; PG8_SCHED;
            PG8_LDA(At, 1, 1); PG8_STAGE(PG8_SB(1, 0), b3, voffB); PG8_STAGE(PG8_SB(1, 1), b3 + hstep, voffB); PG8_STAGE(PG8_SA(1, 0), a3, voffA);
            PG8_WAIT_V(8); PG8_WAIT_L(0); PG8_BAR; PG8_MMA(1, 0, At, B0); PG8_MMA(1, 1, At, B1); PG8_BAR; PG8_SCHED;
            } else {
            PG8_LDB(B0, 0, 0); PG8_SCHED; PG8_LDA(At, 0, 0); PG8_STAGE(PG8_SA(1, 1), a1 + hstep, voffA);
            PG8_WAIT_L(8); PG8_BAR; PG8_WAIT_L(0); PG8_MMA(0, 0, At, B0); PG8_BAR; PG8_SCHED;
            PG8_LDB(B1, 0, 1); PG8_STAGE(PG8_SB(0, 0), b2, voffB);
            PG8_BAR; PG8_WAIT_L(0); PG8_MMA(0, 1, At, B1); PG8_BAR;
            PG8_LDA(At, 0, 1); PG8_STAGE(PG8_SA(0, 0), a2, voffA);
            PG8_BAR; PG8_WAIT_L(0); PG8_MMA(1, 0, At, B0); PG8_BAR; PG8_SCHED;
            PG8_STAGE(PG8_SB(0, 1), b2 + hstep, voffB);
            PG8_WAIT_V(6); PG8_BAR; PG8_MMA(1, 1, At, B1); PG8_BAR;
            PG8_LDB(B0, 1, 0); PG8_SCHED; PG8_LDA(At, 1, 0); PG8_STAGE(PG8_SA(0, 1), a2 + hstep, voffA);
            PG8_WAIT_L(8); PG8_BAR; PG8_WAIT_L(0); PG8_MMA(0, 0, At, B0); PG8_BAR; PG8_SCHED;
            PG8_LDB(B1, 1, 1); PG8_STAGE(PG8_SB(1, 0), b3, voffB);
            PG8_BAR; PG8_WAIT_L(0); PG8_MMA(0, 1, At, B1); PG8_BAR;
            PG8_LDA(At, 1, 1); PG8_STAGE(PG8_SA(1, 0), a3, voffA);
            PG8_BAR; PG8_WAIT_L(0); PG8_MMA(1, 0, At, B0); PG8_BAR; PG8_SCHED;
            PG8_STAGE(PG8_SB(1, 1), b3 + hstep, voffB);
            PG8_WAIT_V(6); PG8_BAR; PG8_MMA(1, 1, At, B1); PG8_BAR;
            }
        }
        if constexpr (ALIGN_EPI) { if (wr == 0) PG8_BAR; }
        E(acc, cur, ui, wr, wc, fr, fq); S.done(cur);
        if (!has_next) break;
#pragma unroll
        for (int a = 0; a < 2; ++a)
#pragma unroll
            for (int b = 0; b < 2; ++b)
#pragma unroll
                for (int m = 0; m < 4; ++m)
#pragma unroll
                    for (int n = 0; n < 2; ++n) acc[a][b][m][n] = (f32x4){0.f, 0.f, 0.f, 0.f};
        cur = nxt; cA = nA; cB = nB; ++ui;
        if constexpr (ALIGN_EPI) { if (wr == 1) PG8_BAR; }
    }
    PG8_WAIT_V(0);
    if constexpr (!ALIGN_EPI) { if (wr == 0) PG8_BAR; }
    PG8_BAR;
#undef PG8_SA
#undef PG8_SB
#undef PG8_STAGE
#undef PG8_LDA
#undef PG8_LDB
#undef PG8_MMA
#undef PG8_WAIT_V
#undef PG8_WAIT_L
#undef PG8_BAR
#undef PG8_SCHED
}
}

constexpr int NWAVES = 8;
constexpr int DM = 1024, BATCH = 8, SEQ = 4096, TOK = BATCH * SEQ;
constexpr int AW = 512, INW = 2560, QPW = 2048, NEXP = 16384;
constexpr int NPHASE = 7;
#ifndef MK_N_LAUNCHES
#define MK_N_LAUNCHES 1
#endif
constexpr int N_LAUNCHES = MK_N_LAUNCHES;

constexpr size_t MiB = 1u << 20;
constexpr size_t WS_CTL = 0, CTL_ZERO_BYTES = 64 * 1024;
constexpr size_t WS_WIN = 2 * MiB, WS_WOUT = 8 * MiB, WS_WQ = 10 * MiB, WS_SK = 14 * MiB, WS_SGUW = 14 * MiB + 512 * 1024, WS_RSTD1 = 15 * MiB;
constexpr size_t WS_SCU = 15 * MiB + 256 * 1024, WS_SCV = 15 * MiB + 512 * 1024;
constexpr size_t WS_UB = 16 * MiB, WS_VB = 48 * MiB;
constexpr size_t WS_XB = 80 * MiB;
constexpr size_t WS_Q = 144 * MiB, WS_TYPE_STRIDE = 32 * MiB;
constexpr size_t WS_QP = 144 * MiB;
constexpr size_t WS_MIX = 304 * MiB;
constexpr size_t WS_SSQA = 368 * MiB, WS_SSQS = 369 * MiB, WS_SSQ2P = 370 * MiB, WS_MAXP = 372 * MiB, WS_HINV = 374 * MiB;
constexpr size_t WS_PA = 144 * MiB;
constexpr size_t WS_COEF = 304 * MiB, WS_COEF0 = 320 * MiB, WS_H8 = 324 * MiB, WS_HS = 356 * MiB;
constexpr size_t WS_EIDX = 376 * MiB, WS_GATE = 392 * MiB, WS_END = 408 * MiB;
constexpr int CW_BAR = 1024;

constexpr int RING_OFF = 0, RING_BYTES = 131072;
constexpr int TAB_OFF = RING_BYTES, TAB_BYTES = 8192;
constexpr int LDSCTL_OFF = 153600, MISC_OFF = LDSCTL_OFF + 64;
constexpr int LDS_BYTES = 155648;
static_assert(MISC_OFF + 128 <= LDS_BYTES, "LDS map");

#define GAS __attribute__((address_space(1)))
#define LAS __attribute__((address_space(3)))
typedef unsigned short bf16;
typedef unsigned v4u __attribute__((ext_vector_type(4)));
typedef unsigned v2u __attribute__((ext_vector_type(2)));
typedef float f32x4 __attribute__((ext_vector_type(4)));
typedef float f32x16 __attribute__((ext_vector_type(16)));
typedef short bf16x8 __attribute__((ext_vector_type(8)));
typedef short s16x4 __attribute__((ext_vector_type(4)));
typedef __bf16 bf16x2_t __attribute__((ext_vector_type(2)));
typedef GAS unsigned gu32;
#define RLX_AGENT __ATOMIC_RELAXED, __HIP_MEMORY_SCOPE_AGENT
#define LDS_WAIT() asm volatile("s_waitcnt lgkmcnt(0)" ::: "memory")
#define VM_WAIT() asm volatile("s_waitcnt vmcnt(0)" ::: "memory")
__device__ __forceinline__ unsigned f2bf(float f) { unsigned u = __builtin_bit_cast(unsigned, f); return (u + 0x7fffu + ((u >> 16) & 1u)) >> 16; }
__device__ __forceinline__ unsigned pk2(float lo, float hi) { return pg8::cvt_pk_bf16(lo, hi); }
__device__ __forceinline__ float bf_lo(unsigned w) { return __builtin_bit_cast(float, w << 16); }
__device__ __forceinline__ float bf_hi(unsigned w) { return __builtin_bit_cast(float, w & 0xffff0000u); }
__device__ __forceinline__ int crow(int r, int hi) { return (r & 3) + 8 * (r >> 2) + 4 * hi; }
#define XB_TMO      128
#define XB_XCNT(j)  (256  + 64 * (j))
#define XB_XSUB(j)  (1280 + 64 * (j))
#define XB_XGEN(j)  (2304 + 64 * (j))
#define XB_TOP      3328
#define XB_TOPGEN   3392
#define XCD_BAR_WORDS 3456
#define XB_SPIN_CAP (1u << 18)

__device__ __forceinline__ unsigned xb_ld(unsigned* p)              { return __hip_atomic_load(p, __ATOMIC_RELAXED, __HIP_MEMORY_SCOPE_AGENT); }
__device__ __forceinline__ unsigned xb_add(unsigned* p, unsigned v) { return __hip_atomic_fetch_add(p, v, __ATOMIC_RELAXED, __HIP_MEMORY_SCOPE_AGENT); }
__device__ __forceinline__ unsigned xb_xcc_id() { return (unsigned)__builtin_amdgcn_s_getreg((3 << 11) | 20) & 0xFu; }
#define XB_SPIN(cond, bar) do { unsigned _sp = 0; while (cond) { __builtin_amdgcn_s_sleep(1); \
    if ((++_sp & 255u) == 0u) { if (xb_ld(&(bar)[XB_TMO])) break; if (_sp > XB_SPIN_CAP) { atomicAdd(&(bar)[XB_TMO], 1u); break; } } } } while (0)

struct XcdBarrier {
    unsigned* bar; unsigned x;
    volatile LAS unsigned* st;
};

__device__ __forceinline__ XcdBarrier xcd_barrier_post(unsigned* bar, volatile LAS unsigned* st) {
    XcdBarrier b; b.bar = bar; b.x = xb_xcc_id(); b.st = st;
    if (threadIdx.x == 0) (void)xb_add(&bar[XB_XCNT(b.x)], 1u);
    return b;
}
__device__ __forceinline__ void xcd_barrier_complete(unsigned* bar, unsigned x, unsigned& nloc, unsigned& nx) {
    const unsigned G = gridDim.x * gridDim.y * gridDim.z;
    unsigned sum, cnt, mine, sp = 0u;
    for (;;) {
        sum = 0u; cnt = 0u; mine = 0u;
#pragma unroll
        for (unsigned j = 0; j < 16; ++j) { const unsigned c = xb_ld(&bar[XB_XCNT(j)]); sum += c; cnt += (c > 0u) ? 1u : 0u; mine = (j == x) ? c : mine; }
        if (sum == G) break;
        __builtin_amdgcn_s_sleep(1);
        if ((++sp & 255u) == 0u) { if (xb_ld(&bar[XB_TMO])) break; if (sp > XB_SPIN_CAP) { atomicAdd(&bar[XB_TMO], 1u); break; } }
    }
    nloc = mine > 0u ? mine : 1u; nx = cnt > 0u ? cnt : 1u;
}

__device__ __forceinline__ void xcd_barrier(const XcdBarrier& b) {
    asm volatile("s_waitcnt vmcnt(0)" ::: "memory");
    __syncthreads();
    if (threadIdx.x == 0) {
        unsigned* bar = b.bar;
        __builtin_amdgcn_s_waitcnt(0);
        unsigned nloc = b.st[0], nx = b.st[1];
        if (nloc == 0u) { xcd_barrier_complete(bar, b.x, nloc, nx); b.st[0] = nloc; b.st[1] = nx; }
        const unsigned old = xb_add(&bar[XB_XSUB(b.x)], 1u);
        const unsigned gen = old / nloc;
        if (old + 1u == (gen + 1u) * nloc) {
            __builtin_amdgcn_fence(__ATOMIC_RELEASE, "agent");
            asm volatile("s_waitcnt vmcnt(0)" ::: "memory");
            const unsigned og = xb_add(&bar[XB_TOP], 1u);
            const unsigned tg = og / nx;
            if (og + 1u == (tg + 1u) * nx) xb_add(&bar[XB_TOPGEN], 1u);
            else XB_SPIN(xb_ld(&bar[XB_TOPGEN]) == tg, bar);
            __builtin_amdgcn_fence(__ATOMIC_ACQUIRE, "agent");
            xb_add(&bar[XB_XGEN(b.x)], 1u);
            asm volatile("s_waitcnt vmcnt(0)" ::: "memory");
        } else {
            XB_SPIN(xb_ld(&bar[XB_XGEN(b.x)]) == gen, bar);
            __builtin_amdgcn_fence(__ATOMIC_ACQUIRE, "agent");
            asm volatile("s_waitcnt vmcnt(0)" ::: "memory");
        }
    }
    __syncthreads();
}

struct Frame {
    LAS unsigned char* lds;
    volatile LAS unsigned* MISC;
    gu32* ctl;
    int tid, lane, wave;
    int vcu, G;
    unsigned char* ws;
    const float *x, *norm1_g, *w_in, *q_norm_g, *k_norm_g, *sgu_norm_g, *sgu_w, *sgu_b, *attn_out_g, *sgu_out_g, *w_out, *norm2_g, *w_query, *sub_keys, *expert_u, *expert_v;
    float* out;
    bf16 *Win_t, *Wout_t, *Wq_t, *SK, *SGUW, *XB, *Q, *QP, *MIX;
    float *RSTD1, *SSQA, *SSQS, *SSQ2P, *GATE, *HS, *CS, *MAXP, *HINV;
    signed char *U8, *H8, *V8; int* PA; unsigned* CQ;
    unsigned short* EIDX;
};

__device__ __forceinline__ float wave_sum(float v) {
#pragma unroll
    for (int o = 1; o < 64; o <<= 1) v += __shfl_xor(v, o);
    return v;
}

__device__ __forceinline__ void p0_transpose_item(const float* W, int K, int N, bf16* WT, const float* gain_a, const float* gain_b, int gsplit, LAS float* scr, int item, int lane, bool permute) {
    const int nblk = N / 32, kb = item / nblk, nb = item % nblk, k0 = 64 * kb, n0 = 32 * nb;
#pragma unroll 8
    for (int i = 0; i < 32; ++i) { const int kk = 2 * i + (lane >> 5); const int k = k0 + kk; const float gv = (k < gsplit) ? gain_a[k] : gain_b[k - gsplit];
        scr[kk * 33 + (lane & 31)] = __builtin_nontemporal_load((const GAS float*)(W + (size_t)k * N + n0 + (lane & 31))) * gv; }
    LDS_WAIT(); asm volatile("" ::: "memory");
    int orow0 = n0;
    if (permute) { const int l = n0 & 255; orow0 = (n0 & ~255) + 128 * ((l >> 5) & 1) + 32 * (l >> 6); }
    const int c = lane & 7;
#pragma unroll
    for (int j = 0; j < 4; ++j) { const int n = (lane >> 3) + 8 * j; const LAS float* s = scr + (8 * c) * 33 + n;
        v4u o; o.x = pk2(s[0 * 33], s[1 * 33]); o.y = pk2(s[2 * 33], s[3 * 33]); o.z = pk2(s[4 * 33], s[5 * 33]); o.w = pk2(s[6 * 33], s[7 * 33]);
        *(GAS v4u*)(WT + (size_t)(orow0 + n) * K + k0 + 8 * c) = o; }
    LDS_WAIT(); asm volatile("" ::: "memory");
}

__device__ __forceinline__ float row_to_bf16(const float* src, bf16* dst, const float* gain, int lane) {
    float ss = 0.f;
    f32x4 v[4];
#pragma unroll
    for (int j = 0; j < 4; ++j) v[j] = __builtin_nontemporal_load((const GAS f32x4*)(src + 4 * lane + 256 * j));
#pragma unroll
    for (int j = 0; j < 4; ++j) {
        f32x4 a = v[j];
        ss += (a[0] * a[0] + a[1] * a[1]) + (a[2] * a[2] + a[3] * a[3]);
        if (gain) a = a * *(const GAS f32x4*)(gain + 4 * lane + 256 * j);
        v2u o; o.x = pk2(a[0], a[1]); o.y = pk2(a[2], a[3]);
        *(GAS v2u*)(dst + 4 * lane + 256 * j) = o;
    }
    return ss;
}

__device__ __forceinline__ void p0_prologue(Frame& F) {
    LAS float* scr = (LAS float*)(F.lds + RING_OFF + F.wave * 16384);
    const int gw = F.vcu * NWAVES + F.wave, NGW = F.G * NWAVES;
    constexpr int I_IN = (DM / 64) * (INW / 32), I_OUT = (DM / 64) * (DM / 32), I_Q = (DM / 64) * (QPW / 32);
    for (int it = gw; it < I_IN + I_OUT + I_Q; it += NGW) {
        int r = it;
        if (r < I_IN) { p0_transpose_item(F.w_in, DM, INW, F.Win_t, F.norm1_g, F.norm1_g, DM, scr, r, F.lane, true); continue; } r -= I_IN;
        if (r < I_OUT) { p0_transpose_item(F.w_out, DM, DM, F.Wout_t, F.attn_out_g, F.sgu_out_g, AW, scr, r, F.lane, false); continue; } r -= I_OUT;
        p0_transpose_item(F.w_query, DM, QPW, F.Wq_t, F.norm2_g, F.norm2_g, DM, scr, r, F.lane, false);
    }
    for (int m = 2 * gw; m < TOK; m += 2 * NGW) {
        const float s0 = row_to_bf16(F.x + (size_t)m * DM, F.XB + (size_t)m * DM, nullptr, F.lane);
        const float s1 = row_to_bf16(F.x + (size_t)(m + 1) * DM, F.XB + (size_t)(m + 1) * DM, nullptr, F.lane);
        const float ss0 = wave_sum(s0), ss1 = wave_sum(s1);
        if (F.lane == 0) { F.RSTD1[m] = 1.0f / sqrtf(ss0 * (1.0f / DM) + pg8::EPS_F); F.RSTD1[m + 1] = 1.0f / sqrtf(ss1 * (1.0f / DM) + pg8::EPS_F); }
    }
    for (int e0 = 2 * gw; e0 < 2 * NEXP; e0 += 2 * NGW) {
        const bool isu = e0 < NEXP; const int r0 = isu ? e0 : e0 - NEXP;
        f32x4 v[2][4]; float mx[2] = {0.f, 0.f};
#pragma unroll
        for (int b = 0; b < 2; ++b) {
            const float* src = (isu ? F.expert_u : F.expert_v) + (size_t)(r0 + b) * DM + 4 * F.lane;
#pragma unroll
            for (int q = 0; q < 4; ++q) v[b][q] = __builtin_nontemporal_load((const GAS f32x4*)(src + 256 * q));
        }
#pragma unroll
        for (int b = 0; b < 2; ++b) {
#pragma unroll
            for (int q = 0; q < 4; ++q) { if (isu) v[b][q] = v[b][q] * *(const GAS f32x4*)(F.norm2_g + 4 * F.lane + 256 * q);
                mx[b] = fmaxf(mx[b], fmaxf(fmaxf(fabsf(v[b][q][0]), fabsf(v[b][q][1])), fmaxf(fabsf(v[b][q][2]), fabsf(v[b][q][3])))); }
#pragma unroll
            for (int o = 1; o < 64; o <<= 1) mx[b] = fmaxf(mx[b], __shfl_xor(mx[b], o));
            const float sc = fmaxf(mx[b], 1e-30f) * (1.0f / 127.0f), inv = 1.0f / sc; const int r = r0 + b;
            signed char* tab = isu ? F.U8 : F.V8;
#pragma unroll
            for (int q = 0; q < 4; ++q) { const int b0 = (int)rintf(v[b][q][0] * inv), b1 = (int)rintf(v[b][q][1] * inv), b2 = (int)rintf(v[b][q][2] * inv), b3 = (int)rintf(v[b][q][3] * inv);
                const unsigned o = (unsigned)(b0 & 0xff) | ((unsigned)(b1 & 0xff) << 8) | ((unsigned)(b2 & 0xff) << 16) | ((unsigned)(b3 & 0xff) << 24);
                *(GAS unsigned*)(tab + ((size_t)(2 * q + (F.lane >> 5)) * NEXP + r) * 128 + 4 * (F.lane & 31)) = o; }
            if (F.lane == 0) { float* scp = (float*)(F.ws + (isu ? WS_SCU : WS_SCV)); scp[r] = sc; }
        }
    }
    const int gt = F.vcu * NWAVES * 64 + F.tid, NGT = F.G * NWAVES * 64;
    for (int i = gt; i < 8 * 128 * 128; i += NGT) { const int g = i >> 14, t = (i >> 7) & 127, s = i & 127;
        const int o = ((((g * 4 + (t >> 5)) * 8 + (s >> 4)) * 64) + 32 * ((s >> 3) & 1) + (t & 31)) * 8 + (s & 7);
        F.SGUW[o] = (bf16)f2bf(s <= t ? F.sgu_w[i] : 0.f); }
    for (int i = gt; i < 2 * 128 * 128; i += NGT) F.SK[i] = (bf16)f2bf(F.sub_keys[i]);
}

constexpr int AT_OPITCH = 136;
constexpr int AT_OACC = 0, AT_LACC = 512 * AT_OPITCH, AT_VS = AT_LACC + 2048, AT_VS_WAVE = 32 * 128;
constexpr int AT_KS = AT_VS + NWAVES * AT_VS_WAVE, AT_KS_WAVE = 32 * 128;
static_assert(AT_KS + NWAVES * AT_KS_WAVE <= LDSCTL_OFF, "attention LDS");
__device__ __forceinline__ int at_rowmap(int p) { return (p & ~15) | ((p ^ (p >> 4)) & 15); }
__device__ __forceinline__ s16x4 vtr(const LAS unsigned char* p) { typedef short v4i16_t __attribute__((ext_vector_type(4))); return __builtin_bit_cast(s16x4, __builtin_amdgcn_ds_read_tr16_b64_v4i16((LAS v4i16_t*)p)); }

struct AtDesc { int b, h, span, dil, res, a; };
__device__ __forceinline__ AtDesc at_desc(int u, int stage, int idx) {
    AtDesc d; const int bh = u >> 3; d.b = bh >> 3; d.h = bh & 7; d.span = u & 7;
    if (stage == 0) { d.dil = 16; d.res = idx; d.a = d.span; }
    else if (stage == 1) { d.dil = 4; d.res = idx & 3; d.a = 4 * d.span + 2 * (idx >> 2); }
    else { d.dil = 1; d.res = 0; d.a = 16 * d.span + 2 * idx; }
    return d;
}
__device__ __forceinline__ void at_dma(LAS unsigned char* ks, LAS unsigned char* vs, const char* kptr, const char* vptr, size_t vrow8) {
#pragma unroll
    for (int it = 0; it < 4; ++it) __builtin_amdgcn_global_load_lds((const unsigned*)(kptr + it * vrow8), (LAS unsigned*)(ks + it * 1024), 16, 0, 0);
#pragma unroll
    for (int it = 0; it < 4; ++it) __builtin_amdgcn_global_load_lds((const unsigned*)(vptr + it * vrow8), (LAS unsigned*)(vs + it * 1024), 16, 0, 0);
}
__device__ __forceinline__ size_t at_koff(int lane, int h) { return (size_t)h * 128 + (size_t)((((lane & 7) ^ (lane >> 3)) & 7) << 4); }
__device__ __forceinline__ size_t at_voff(int lane, int h) { return (size_t)h * 128 + (size_t)(((lane & 7) ^ (((lane >> 4) & 1) << 2)) << 4); }
__device__ __forceinline__ void at_start(Frame& F, const AtDesc& d, int nt, bf16x8 (&qn)[2][4]) {
    const int lane = F.lane, r32 = lane & 31, hi = lane >> 5;
    const int j0 = (d.a >= 4) ? 0 : 4 - d.a;
    const size_t krow = (size_t)d.b * SEQ + d.res + (size_t)d.dil * (32 * (d.a - 4 + j0) + (lane >> 3));
    const char* kp = (const char*)(F.Q + WS_TYPE_STRIDE / 2) + krow * 1024; const char* vp = (const char*)(F.Q + 2 * (WS_TYPE_STRIDE / 2)) + krow * 1024;
    at_dma(F.lds + AT_KS + F.wave * AT_KS_WAVE, F.lds + AT_VS + F.wave * AT_VS_WAVE, kp + at_koff(lane, d.h), vp + at_voff(lane, d.h), (size_t)d.dil * 8 * 1024);
#pragma unroll
    for (int t = 0; t < 2; ++t) {
        const size_t qrow = (size_t)d.b * SEQ + d.res + (size_t)d.dil * (32 * (d.a + (t ? nt - 1 : 0)) + r32);
        const bf16* qp = F.Q + qrow * 512 + d.h * 64 + hi * 8;
#pragma unroll
        for (int d0 = 0; d0 < 4; ++d0) qn[t][d0] = *(const GAS bf16x8*)(qp + 16 * d0);
    }
}

template <int STAGE, int NT>
__device__ __forceinline__ void attn_task(Frame& F, const AtDesc& d, float sl, float mlog2, bf16x8 (&qn)[2][4], const AtDesc& nd, int nnt) {
    const int lane = F.lane, r32 = lane & 31, hi = lane >> 5;
    const int b = d.b, h = d.h, span = d.span, dil = d.dil, res = d.res, a = d.a;
    const size_t tokbase = (size_t)b * SEQ;
    LAS unsigned char* vs = F.lds + AT_VS + F.wave * AT_VS_WAVE;
    LAS unsigned char* ks = F.lds + AT_KS + F.wave * AT_KS_WAVE;
    bf16x8 qf[NT][4];
#pragma unroll
    for (int t = 0; t < NT; ++t)
#pragma unroll
        for (int d0 = 0; d0 < 4; ++d0) qf[t][d0] = qn[t][d0];
    f32x16 o[NT][2];
    float lsum[NT];
#pragma unroll
    for (int t = 0; t < NT; ++t) { o[t][0] = f32x16{}; o[t][1] = f32x16{}; lsum[t] = 0.f; }
    const float base_i = -sl * (float)(128 + r32) - mlog2 + sl * (float)(4 * hi);
    const int G = lane >> 4, gi = lane & 15, gq4 = gi >> 2, gp = gi & 3;
    const int j0 = (a >= 4) ? 0 : 4 - a;
    const size_t cstride = (size_t)dil * 32 * 1024, vrow8 = (size_t)dil * 8 * 1024;
    const size_t krow1 = tokbase + res + (size_t)dil * (32 * (a - 3 + j0) + (lane >> 3));
    const char* kptr = (const char*)(F.Q + WS_TYPE_STRIDE / 2) + krow1 * 1024 + at_koff(lane, h);
    const char* vptr = (const char*)(F.Q + 2 * (WS_TYPE_STRIDE / 2)) + krow1 * 1024 + at_voff(lane, h);
    bf16x8 kf[4], va[2][2];
#define AT_TOP() do { \
        asm volatile("s_waitcnt vmcnt(0)" ::: "memory"); \
        _Pragma("unroll") for (int d0 = 0; d0 < 4; ++d0) kf[d0] = *(const LAS bf16x8*)(ks + r32 * 128 + (((2 * d0 + hi) ^ (r32 & 7)) << 4)); \
          \
        _Pragma("unroll") for (int d0 = 0; d0 < 2; ++d0) \
            _Pragma("unroll") for (int ks_ = 0; ks_ < 2; ++ks_) { \
                const LAS unsigned char* pa = vs + (16 * ks_ + 4 * (G >> 1) + gq4) * 128 + ((64 * d0 + 32 * (G & 1) + 8 * gp) ^ (((gq4 >> 1) & 1) << 6)); \
                const s16x4 lo = vtr(pa), hi4 = vtr(pa + 8 * 128); \
                va[d0][ks_] = (bf16x8){lo[0], lo[1], lo[2], lo[3], hi4[0], hi4[1], hi4[2], hi4[3]}; } \
        LDS_WAIT(); } while (0)
#define AT_MATH(t, c) do { \
        f32x16 s; \
        const float bc = base_i + sl * (float)(32 * (c)); \
        _Pragma("unroll") for (int r = 0; r < 16; ++r) s[r] = bc + sl * (float)((r & 3) + 8 * (r >> 2)); \
        _Pragma("unroll") for (int d0 = 0; d0 < 4; ++d0) s = __builtin_amdgcn_mfma_f32_32x32x16_bf16(kf[d0], qf[t][d0], s, 0, 0, 0); \
          \
        const int dbase = 128 - 32 * (c) + r32 - 4 * hi; \
        float ls_ = lsum[t]; \
        if (((c) == 0) || ((c) == 4)) { \
            _Pragma("unroll") for (int r = 0; r < 16; ++r) { float p = __builtin_amdgcn_exp2f(s[r]); p = ((unsigned)(dbase - ((r & 3) + 8 * (r >> 2))) <= 128u) ? p : 0.f; s[r] = p; ls_ += p; } \
        } else { \
            _Pragma("unroll") for (int r = 0; r < 16; ++r) { const float p = __builtin_amdgcn_exp2f(s[r]); s[r] = p; ls_ += p; } \
        } \
        lsum[t] = ls_; \
        bf16x8 pb[2]; \
        _Pragma("unroll") for (int ks_ = 0; ks_ < 2; ++ks_) { v4u w; w.x = pk2(s[8 * ks_ + 0], s[8 * ks_ + 1]); w.y = pk2(s[8 * ks_ + 2], s[8 * ks_ + 3]); w.z = pk2(s[8 * ks_ + 4], s[8 * ks_ + 5]); w.w = pk2(s[8 * ks_ + 6], s[8 * ks_ + 7]); pb[ks_] = __builtin_bit_cast(bf16x8, w); } \
          \
        _Pragma("unroll") for (int d0 = 0; d0 < 2; ++d0) \
            _Pragma("unroll") for (int ks_ = 0; ks_ < 2; ++ks_) o[t][d0] = __builtin_amdgcn_mfma_f32_32x32x16_bf16(va[d0][ks_], pb[ks_], o[t][d0], 0, 0, 0); \
    } while (0)
#pragma unroll 1
    for (int j = j0; j < 3 + NT; ++j) {
        AT_TOP();
        at_dma(ks, vs, kptr, vptr, vrow8); kptr += cstride; vptr += cstride;
        AT_MATH(0, j);
        if (NT == 2) { if (j >= 1) AT_MATH(NT - 1, j - 1); }
    }
    AT_TOP();
    at_start(F, nd, nnt, qn);
    AT_MATH(NT - 1, 4);
#undef AT_MATH
#undef AT_TOP
    LAS float* lacc = (LAS float*)(F.lds + AT_LACC);
#pragma unroll
    for (int t = 0; t < NT; ++t) {
        float ls = lsum[t];
        ls += __shfl_xor(ls, 32);
        const int posq = res + dil * (32 * (a + t) + r32);
        const int pl = posq - span * 512;
        LAS unsigned char* orow = F.lds + AT_OACC + at_rowmap(pl) * AT_OPITCH;
        if (STAGE > 0) {
            ls += lacc[pl];
#pragma unroll
            for (int d0 = 0; d0 < 2; ++d0)
#pragma unroll
                for (int g4 = 0; g4 < 4; ++g4) { const v2u w = *(LAS v2u*)(orow + (32 * d0 + 8 * g4 + 4 * hi) * 2);
                    o[t][d0][4 * g4 + 0] += bf_lo(w.x); o[t][d0][4 * g4 + 1] += bf_hi(w.x); o[t][d0][4 * g4 + 2] += bf_lo(w.y); o[t][d0][4 * g4 + 3] += bf_hi(w.y); }
        }
        if (STAGE < 2) {
            if (hi == 0) lacc[pl] = ls;
#pragma unroll
            for (int d0 = 0; d0 < 2; ++d0)
#pragma unroll
                for (int g4 = 0; g4 < 4; ++g4) { v2u w; w.x = pk2(o[t][d0][4 * g4 + 0], o[t][d0][4 * g4 + 1]); w.y = pk2(o[t][d0][4 * g4 + 2], o[t][d0][4 * g4 + 3]);
                    *(LAS v2u*)(orow + (32 * d0 + 8 * g4 + 4 * hi) * 2) = w; }
        } else {
            const float inv = 1.0f / ls;
            float ss = 0.f;
#pragma unroll
            for (int d0 = 0; d0 < 2; ++d0)
#pragma unroll
                for (int g4 = 0; g4 < 4; ++g4) { const float a0 = o[t][d0][4 * g4 + 0] * inv, a1 = o[t][d0][4 * g4 + 1] * inv, a2 = o[t][d0][4 * g4 + 2] * inv, a3 = o[t][d0][4 * g4 + 3] * inv;
                    ss += (a0 * a0 + a1 * a1) + (a2 * a2 + a3 * a3);
                    v2u w; w.x = pk2(a0, a1); w.y = pk2(a2, a3);
                    *(LAS v2u*)(orow + (32 * d0 + 8 * g4 + 4 * hi) * 2) = w; }
            ss += __shfl_xor(ss, 32);
            if (hi == 0) F.SSQA[(tokbase + posq) * 8 + h] = ss;
            LDS_WAIT(); asm volatile("" ::: "memory");
#pragma unroll
            for (int it = 0; it < 4; ++it) { const int row = (lane >> 3) + 8 * it;
                const LAS unsigned char* src = F.lds + AT_OACC + at_rowmap(res + dil * (32 * (a + t) + row) - span * 512) * AT_OPITCH + (lane & 7) * 16;
                const v2u lo = *(const LAS v2u*)src, hi2 = *(const LAS v2u*)(src + 8);
                v4u ov; ov.x = lo.x; ov.y = lo.y; ov.z = hi2.x; ov.w = hi2.y;
                *(GAS v4u*)(F.MIX + (tokbase + res + (size_t)dil * (32 * (a + t) + row)) * 1024 + h * 64 + (lane & 7) * 8) = ov; }
            LDS_WAIT(); asm volatile("" ::: "memory");
        }
    }
}

__device__ __forceinline__ void attn_unit(Frame& F, int u, int un, float mlog2, bf16x8 (&qn)[2][4]) {
    const int h = (u >> 3) & 7;
    const float slope = __builtin_amdgcn_exp2f(-(float)(h + 1)) * 1.4426950408889634f;
    const int w = F.wave;
#pragma unroll 1
    for (int k = 0; k < 2; ++k) attn_task<0, 1>(F, at_desc(u, 0, 2 * w + k), slope * 16.f, mlog2, qn, k ? at_desc(u, 1, w) : at_desc(u, 0, 2 * w + 1), 1 + k);
    LDS_WAIT(); __syncthreads();
    attn_task<1, 2>(F, at_desc(u, 1, w), slope * 4.f, mlog2, qn, at_desc(u, 2, w), 2);
    LDS_WAIT(); __syncthreads();
    attn_task<2, 2>(F, at_desc(u, 2, w), slope, mlog2, qn, at_desc(un, 0, 2 * w), 1);
    LDS_WAIT(); __syncthreads();
}

constexpr int SG_PITCH = 192, SG_TILE = 128 * SG_PITCH;
static_assert(4 * SG_TILE <= RING_BYTES, "SGU LDS");
struct SguPre { v4u tile[4]; v4u sul[4]; };
constexpr int SG_SU_OFF = 4 * SG_TILE, SG_SU_WAVE = 32 * 144;
static_assert(SG_SU_OFF + NWAVES * SG_SU_WAVE <= LDSCTL_OFF, "SGU LDS");
__device__ __forceinline__ void sgu_load(Frame& F, int u, SguPre& p) {
    const int gp = u & 3, ch = (u >> 2) & 31, b = u >> 7;
    const int lane = F.lane, r32 = lane & 31, hi = lane >> 5, w = F.wave, gsel = w >> 2, tb = w & 3, g = 2 * gp + gsel, t = 32 * tb + r32;
    const size_t tok0 = (size_t)b * SEQ + (size_t)ch * 128;
    const bf16* SVN = F.Q + 4 * (WS_TYPE_STRIDE / 2); const bf16* SU = F.Q + 3 * (WS_TYPE_STRIDE / 2);
#pragma unroll
    for (int gg = 0; gg < 2; ++gg)
#pragma unroll
        for (int it = 0; it < 2; ++it) { const int idx = F.tid + 512 * it, s_ = idx >> 3, c8 = idx & 7;
            p.tile[2 * gg + it] = __builtin_nontemporal_load((const GAS v4u*)(SVN + (tok0 + s_) * 512 + (2 * gp + gg) * 64 + c8 * 8)); }
#pragma unroll
    for (int i = 0; i < 4; ++i) p.sul[i] = __builtin_nontemporal_load((const GAS v4u*)(SU + (tok0 + 32 * tb + (lane >> 3) + 8 * i) * 512 + g * 64 + (lane & 7) * 8));
}
__device__ __forceinline__ void sgu_phase(Frame& F) {
    const int lane = F.lane, r32 = lane & 31, hi = lane >> 5, w = F.wave, gsel = w >> 2, tb = w & 3, t = 32 * tb + r32;
    const int G = lane >> 4, gi = lane & 15, gq4 = gi >> 2, gpp = gi & 3;
    constexpr int NU = BATCH * 32 * 4;
    int u = F.vcu; if (u >= NU) return;
    bf16x8 wb[8]; float bias;
    { const int g = 2 * (u & 3) + gsel;
      const bf16* Wg = F.SGUW + ((size_t)(g * 4 + tb) * 8 * 64 + lane) * 8;
#pragma unroll
      for (int ks = 0; ks < 8; ++ks) wb[ks] = *(const GAS bf16x8*)(Wg + ks * 512);
      bias = F.sgu_b[g * 128 + t]; }
    SguPre pre; sgu_load(F, u, pre);
    for (int it_ = 0; u < NU; u += F.G, ++it_) {
        LAS unsigned char* buf = F.lds + (it_ & 1) * (2 * SG_TILE);
#pragma unroll
        for (int gg = 0; gg < 2; ++gg)
#pragma unroll
            for (int it = 0; it < 2; ++it) { const int idx = F.tid + 512 * it, s_ = idx >> 3, c8 = idx & 7; *(LAS v4u*)(buf + gg * SG_TILE + s_ * SG_PITCH + c8 * 16) = pre.tile[2 * gg + it]; }
        LAS unsigned char* sus = F.lds + SG_SU_OFF + w * SG_SU_WAVE;
#pragma unroll
        for (int i = 0; i < 4; ++i) *(LAS v4u*)(sus + ((lane >> 3) + 8 * i) * 144 + (lane & 7) * 16) = pre.sul[i];
        LDS_WAIT(); __syncthreads();
        const int un = (u + F.G < NU) ? u + F.G : u;
        sgu_load(F, un, pre);
        const int gp = u & 3, ch = (u >> 2) & 31, b = u >> 7, g = 2 * gp + gsel;
        const size_t tok0 = (size_t)b * SEQ + (size_t)ch * 128;
        const LAS unsigned char* ts = buf + gsel * SG_TILE;
        f32x16 acc[2]; acc[0] = f32x16{}; acc[1] = f32x16{};
#pragma unroll
        for (int ks = 0; ks < 8; ++ks) {
#pragma unroll
            for (int eb = 0; eb < 2; ++eb) {
                const LAS unsigned char* pa = ts + (16 * ks + 8 * (G >> 1) + gq4) * SG_PITCH + (32 * eb + 16 * (G & 1) + 4 * gpp) * 2;
                const s16x4 lo = vtr(pa), hi4 = vtr(pa + 4 * SG_PITCH);
                const bf16x8 va = (bf16x8){lo[0], lo[1], lo[2], lo[3], hi4[0], hi4[1], hi4[2], hi4[3]};
                acc[eb] = __builtin_amdgcn_mfma_f32_32x32x16_bf16(va, wb[ks], acc[eb], 0, 0, 0);
            }
        }
        float ss = 0.f;
#pragma unroll
        for (int eb = 0; eb < 2; ++eb)
#pragma unroll
            for (int g4 = 0; g4 < 4; ++g4) { const int e = 32 * eb + 8 * g4 + 4 * hi;
                const v2u sw = *(const LAS v2u*)(sus + r32 * 144 + e * 2);
                const float a0 = bf_lo(sw.x) * (acc[eb][4 * g4 + 0] + bias), a1 = bf_hi(sw.x) * (acc[eb][4 * g4 + 1] + bias), a2 = bf_lo(sw.y) * (acc[eb][4 * g4 + 2] + bias), a3 = bf_hi(sw.y) * (acc[eb][4 * g4 + 3] + bias);
                ss += (a0 * a0 + a1 * a1) + (a2 * a2 + a3 * a3);
                v2u wv; wv.x = pk2(a0, a1); wv.y = pk2(a2, a3); *(LAS v2u*)(sus + r32 * 144 + e * 2) = wv; }
        ss += __shfl_xor(ss, 32);
        if (hi == 0) F.SSQS[(tok0 + t) * 8 + g] = ss;
        LDS_WAIT(); asm volatile("" ::: "memory");
#pragma unroll
        for (int i = 0; i < 4; ++i) { const int row = (lane >> 3) + 8 * i; const v4u ov = *(const LAS v4u*)(sus + row * 144 + (lane & 7) * 16);
            *(GAS v4u*)(F.MIX + (tok0 + 32 * tb + row) * 1024 + 512 + g * 64 + (lane & 7) * 8) = ov; }
        LDS_WAIT(); asm volatile("" ::: "memory");
    }
    LDS_WAIT(); __syncthreads();
}

#ifndef P2_VARIANT
#define P2_VARIANT 0
#endif
__device__ __forceinline__ void p2_mixers(Frame& F) {
    float mq = fabsf(F.q_norm_g[F.lane]), mk = fabsf(F.k_norm_g[F.lane]);
#pragma unroll
    for (int o = 1; o < 64; o <<= 1) { mq = fmaxf(mq, __shfl_xor(mq, o)); mk = fmaxf(mk, __shfl_xor(mk, o)); }
    const float mlog2 = 8.0f * mq * mk * 1.4426950408889634f;
    {
        constexpr int NU = BATCH * 8 * 8;
        bf16x8 qn[2][4];
        if (F.vcu < NU) at_start(F, at_desc(F.vcu, 0, 2 * F.wave), 1, qn);
#pragma unroll 1
        for (int u = F.vcu; u < NU; u += F.G) attn_unit(F, u, (u + F.G < NU) ? u + F.G : u, mlog2, qn);
        asm volatile("s_waitcnt vmcnt(0)" ::: "memory"); __syncthreads();
    }
#pragma unroll 1
    for (int rep = 0; rep < (P2_VARIANT == 2 ? 2 : 1); ++rep)
    sgu_phase(F);
}

__device__ __forceinline__ unsigned f2ord(float f) { const unsigned u = __builtin_bit_cast(unsigned, f); return u ^ ((unsigned)((int)u >> 31) | 0x80000000u); }
__device__ __forceinline__ float ord2f(unsigned k) { const unsigned u = (k & 0x80000000u) ? (k ^ 0x80000000u) : ~k; return __builtin_bit_cast(float, u); }
#define CE_DESC(a, b) do { const unsigned _mx = max((a), (b)), _mn = min((a), (b)); (a) = _mx; (b) = _mn; } while (0)
__device__ __forceinline__ void sort16(unsigned (&k)[16]) {
#pragma unroll
    for (int k2 = 2; k2 <= 16; k2 <<= 1)
#pragma unroll
        for (int j = k2 >> 1; j > 0; j >>= 1)
#pragma unroll
            for (int i = 0; i < 16; ++i) { const int l = i ^ j; if (l > i) { if ((i & k2) == 0) CE_DESC(k[i], k[l]); else CE_DESC(k[l], k[i]); } }
}
__device__ __forceinline__ void merge16(unsigned (&a)[16], const unsigned (&b)[16]) {
#pragma unroll
    for (int i = 0; i < 16; ++i) a[i] = max(a[i], b[15 - i]);
#pragma unroll
    for (int j = 8; j > 0; j >>= 1)
#pragma unroll
        for (int i = 0; i < 16; ++i) { const int l = i ^ j; if (l > i) CE_DESC(a[i], a[l]); }
}
__device__ __forceinline__ void swap16(const unsigned (&x)[16], const unsigned (&y)[16], unsigned (&xo)[16], unsigned (&yo)[16]) {
#pragma unroll
    for (int i = 0; i < 16; ++i) { auto rr = __builtin_amdgcn_permlane32_swap(x[i], y[i], false, false); xo[i] = rr[0]; yo[i] = rr[1]; }
}

__host__ __device__ constexpr int cand0(int q) { return q < 16 ? q : q < 21 ? 0x20 + (q - 16) : q < 24 ? 0x40 + (q - 21) : q < 26 ? 0x60 + (q - 24) : q == 26 ? 0x80 : q == 27 ? 0xa0 : q == 28 ? 0xc0 : q == 29 ? 0xe0 : 0xff; }
__host__ __device__ constexpr int cand1(int q) { return q < 8 ? 0x10 + q : q < 12 ? 0x30 + (q - 8) : q < 14 ? 0x50 + (q - 12) : q < 16 ? 0x70 + (q - 14) : q == 16 ? 0x90 : q == 17 ? 0xb0 : q == 18 ? 0xd0 : q == 19 ? 0xf0 : 0xff; }

constexpr int TK_SK_BYTES = 2 * 128 * 256;
constexpr int TK_LDS_WAVE = 32 * 32 * 4, TK_SCR_OFF = TK_SK_BYTES;
static_assert(TK_SCR_OFF + NWAVES * TK_LDS_WAVE <= RING_BYTES, "top-k LDS");
__device__ __forceinline__ void tk_load_q(Frame& F, size_t t0, int hd, int half, int r32, int hi, bf16x8 (&qf)[8]) {
#pragma unroll
    for (int i = 0; i < 8; ++i) qf[i] = __builtin_nontemporal_load((const GAS bf16x8*)(F.QP + ((((t0 >> 5) * 8 + hd) * 2 + half) * 8 + i) * 512 + (size_t)(32 * hi + r32) * 8));
}
template <int HALF_> __device__ __forceinline__ void half_top16(Frame& F, const bf16x8 (&qf)[8], int r32, int hi, unsigned (&best)[16]) {
#pragma unroll
    for (int nb = 0; nb < 4; ++nb) {
        f32x16 acc;
#pragma unroll
        for (int r = 0; r < 16; ++r) acc[r] = 64.0f;
        const int row = HALF_ * 128 + 32 * nb + r32;
#pragma unroll
        for (int ks = 0; ks < 8; ++ks) { const bf16x8 a = *(const LAS bf16x8*)(F.lds + row * 256 + (((2 * ks + hi) ^ (row & 15)) << 4));
            acc = __builtin_amdgcn_mfma_f32_32x32x16_bf16(a, qf[ks], acc, 0, 0, 0); }
        unsigned k[16];
#pragma unroll
        for (int r = 0; r < 16; ++r) { const int n = 32 * nb + (r & 3) + 8 * (r >> 2) + 4 * hi; k[r] = (__builtin_bit_cast(unsigned, __builtin_amdgcn_fmed3f(acc[r], 4.0f, 124.0f)) & ~127u) | (unsigned)(127 - n); }
        sort16(k);
        if (nb == 0) {
#pragma unroll
            for (int i = 0; i < 16; ++i) best[i] = k[i];
        } else merge16(best, k);
    }
}

__device__ __forceinline__ void topk_task(Frame& F, int tb, int hd, bf16x8 (&qa)[8], bool has_next, int tb_next, int hd_next) {
    const int lane = F.lane, r32 = lane & 31, hi = lane >> 5;
    const size_t t0 = (size_t)tb * 32;
    unsigned bk[2][16];
    bf16x8 qb[8];
    tk_load_q(F, t0, hd, 1, r32, hi, qb);
    half_top16<0>(F, qa, r32, hi, bk[0]);
    if (has_next) tk_load_q(F, (size_t)tb_next * 32, hd_next, 0, r32, hi, qa);
    half_top16<1>(F, qb, r32, hi, bk[1]);
    unsigned xa[16], ya[16];
    swap16(bk[0], bk[1], xa, ya);
    merge16(xa, ya);
    unsigned A[16], B[16];
    swap16(xa, xa, A, B);
    LAS unsigned* tk = (LAS unsigned*)(F.lds + TK_SCR_OFF + F.wave * TK_LDS_WAVE) + r32 * 32;
#pragma unroll
    for (int i = 0; i < 16; ++i) tk[16 * hi + i] = hi ? B[i] : A[i];
    float v1[16], v2[16];
#pragma unroll
    for (int i = 0; i < 16; ++i) { v1[i] = __builtin_bit_cast(float, A[i] & ~127u); v2[i] = __builtin_bit_cast(float, B[i] & ~127u); }
    unsigned c0[16], c1[16];
#pragma unroll
    for (int q = 0; q < 32; ++q) {
        const int ij0 = cand0(q), ij1 = cand1(q);
        const float s0 = (ij0 == 0xff) ? 0.0f : v1[ij0 >> 4] + v2[ij0 & 15];
        const float s1 = (ij1 == 0xff) ? 0.0f : v1[ij1 >> 4] + v2[ij1 & 15];
        const unsigned k0 = (__builtin_bit_cast(unsigned, s0) & ~255u) | (unsigned)(ij0 & 255), k1 = (__builtin_bit_cast(unsigned, s1) & ~255u) | (unsigned)(ij1 & 255);
        const unsigned kk = hi ? k1 : k0;
        if (q < 16) c0[q] = kk; else c1[q - 16] = kk;
    }
    sort16(c0); sort16(c1); merge16(c0, c1);
    unsigned L0[16], L1[16];
    swap16(c0, c0, L0, L1);
    merge16(L0, L1);
    const float mx = __builtin_bit_cast(float, L0[0] & ~255u);
    float ex[16], den = 0.f;
#pragma unroll
    for (int i = 0; i < 16; ++i) { ex[i] = __expf(__builtin_bit_cast(float, L0[i] & ~255u) - mx); den += ex[i]; }
    const float rden = 1.0f / den;
    LDS_WAIT(); asm volatile("" ::: "memory");
    int ei[8]; float gt[8];
#pragma unroll
    for (int kk = 0; kk < 8; ++kk) {
        const unsigned key = hi ? L0[8 + kk] : L0[kk]; const float e = hi ? ex[8 + kk] : ex[kk];
        const int i = (key >> 4) & 15, j = key & 15;
        const int i1 = 127 - (int)(tk[i] & 127u), i2 = 127 - (int)(tk[16 + j] & 127u);
        ei[kk] = i1 * 128 + i2; gt[kk] = e * rden;
    }
    unsigned short* ep = F.EIDX + (t0 + r32) * 128 + hd * 16 + 8 * hi; float* gp = F.GATE + (t0 + r32) * 128 + hd * 16 + 8 * hi;
    *(GAS v4u*)ep = (v4u){(unsigned)ei[0] | ((unsigned)ei[1] << 16), (unsigned)ei[2] | ((unsigned)ei[3] << 16), (unsigned)ei[4] | ((unsigned)ei[5] << 16), (unsigned)ei[6] | ((unsigned)ei[7] << 16)};
    *(GAS f32x4*)gp = (f32x4){gt[0], gt[1], gt[2], gt[3]}; *(GAS f32x4*)(gp + 4) = (f32x4){gt[4], gt[5], gt[6], gt[7]};
    LDS_WAIT(); asm volatile("" ::: "memory");
}

__device__ __forceinline__ void p5_topk(Frame& F) {
    for (int i = F.tid; i < 2 * 128 * 16; i += NWAVES * 64) { const int row = i >> 4, ch = i & 15;
        *(LAS v4u*)(F.lds + row * 256 + ((ch ^ (row & 15)) << 4)) = *(const GAS v4u*)(F.SK + (size_t)row * 128 + ch * 8); }
    LDS_WAIT(); __syncthreads();
    pg8::StaticOrder S; S.init(TOK, QPW, F.G, (int)blockIdx.x);
    pg8::Unit u, un;
    bf16x8 qf[8];
    bool have = S.next(0, u);
    if (have) tk_load_q(F, (size_t)(u.pm * 8 + F.wave) * 32, u.pn, 0, F.lane & 31, F.lane >> 5, qf);
#pragma unroll 1
    for (int i = 0; have; ++i) {
        const bool hn = S.next(i + 1, un);
        topk_task(F, u.pm * 8 + F.wave, u.pn, qf, hn, un.pm * 8 + F.wave, un.pn);
        u = un; have = hn;
    }
    LDS_WAIT(); __syncthreads();
}

constexpr int PE_TPI = 32, PE_NITEM = TOK / PE_TPI;
constexpr int CW_QA = 8192, CW_QB = 8192 + 8 * 64;

template <int CTRL> __device__ __forceinline__ int dpp_i(int v) { return __builtin_amdgcn_update_dpp(0, v, CTRL, 0xf, 0xf, true); }
template <int CTRL> __device__ __forceinline__ float dpp_f(float v) { return __builtin_bit_cast(float, __builtin_amdgcn_update_dpp(0, __builtin_bit_cast(int, v), CTRL, 0xf, 0xf, true)); }
constexpr int DPP_XOR1 = 0xB1, DPP_XOR2 = 0x4E, DPP_HMIRROR = 0x141, DPP_ROR8 = 0x128;

__device__ __forceinline__ void pe_load_ix(Frame& F, int t, v4u (&ix)[2]) {
    const int gl = F.lane >> 3;
#pragma unroll
    for (int q = 0; q < 2; ++q) ix[q] = *(const GAS v4u*)(F.EIDX + (size_t)t * 128 + gl * 16 + 8 * q);
}
__device__ __forceinline__ void pe_load_rows(const void* TAB, const v4u (&ix)[2], int coloff, v4u (&w)[16]) {
#pragma unroll
    for (int i = 0; i < 16; ++i) { const unsigned pr = ix[i >> 3][(i >> 1) & 3]; const unsigned e = (i & 1) ? (pr >> 16) : (pr & 0xffffu);
        w[i] = *(const GAS v4u*)((const char*)TAB + (size_t)e * 128 + coloff); }
}
__device__ __forceinline__ v4u pe_quant16(const v4u& lo, const v4u& hi, float inv) {
    v4u o;
#pragma unroll
    for (int q = 0; q < 4; ++q) { const unsigned w0 = (q < 2) ? lo[2 * q] : hi[2 * q - 4], w1 = (q < 2) ? lo[2 * q + 1] : hi[2 * q - 3];
        const int b0 = (int)rintf(bf_lo(w0) * inv), b1 = (int)rintf(bf_hi(w0) * inv), b2 = (int)rintf(bf_lo(w1) * inv), b3 = (int)rintf(bf_hi(w1) * inv);
        o[q] = (unsigned)(b0 & 0xff) | ((unsigned)(b1 & 0xff) << 8) | ((unsigned)(b2 & 0xff) << 16) | ((unsigned)(b3 & 0xff) << 24); }
    return o;
}
__device__ __forceinline__ void peA_compute(Frame& F, int* PA, int j, int t, const v4u& hq, const v4u (&w)[16]) {
    const int gl = F.lane >> 3, sub = F.lane & 7;
    int r0 = 0, r1 = 0;
#pragma unroll
    for (int i = 0; i < 16; ++i) {
        int p = __builtin_amdgcn_sdot4((int)w[i].x, (int)hq.x, 0, false);
        p = __builtin_amdgcn_sdot4((int)w[i].y, (int)hq.y, p, false); p = __builtin_amdgcn_sdot4((int)w[i].z, (int)hq.z, p, false); p = __builtin_amdgcn_sdot4((int)w[i].w, (int)hq.w, p, false);
        p += dpp_i<DPP_XOR1>(p); p += dpp_i<DPP_XOR2>(p); p += dpp_i<DPP_HMIRROR>(p);
        if (i < 8) r0 = (sub == i) ? p : r0; else r1 = (sub == i - 8) ? p : r1;
    }
    const unsigned pk = ((unsigned)((r0 + 32) >> 6) & 0xffffu) | ((unsigned)((r1 + 32) >> 6) << 16);
    ((unsigned*)PA)[((size_t)j * TOK + t) * 64 + gl * 8 + sub] = pk;
}
__device__ __forceinline__ void peB_compute(Frame& F, int j, int t, const v4u& cq, float cs, const v4u (&w)[16]) {
    const int lane = F.lane, gl = lane >> 3, sub = lane & 7;
    typedef float f32x2_t __attribute__((ext_vector_type(2)));
    const int mycol = 128 * j + 2 * lane;
    const unsigned xw = *(const GAS unsigned*)(F.XB + (size_t)t * DM + mycol);
    f32x2_t xin; xin.x = bf_lo(xw); xin.y = bf_hi(xw);
    int acc[16];
#pragma unroll
    for (int c = 0; c < 16; ++c) acc[c] = 0;
#pragma unroll
    for (int m = 0; m < 4; ++m)
#pragma unroll
        for (int q = 0; q < 4; ++q) {
            const unsigned a0 = w[4 * m + 0][q], a1 = w[4 * m + 1][q], a2 = w[4 * m + 2][q], a3 = w[4 * m + 3][q];
            const unsigned t0 = __builtin_amdgcn_perm(a1, a0, 0x05010400u), t1 = __builtin_amdgcn_perm(a1, a0, 0x07030602u);
            const unsigned t2 = __builtin_amdgcn_perm(a3, a2, 0x05010400u), t3 = __builtin_amdgcn_perm(a3, a2, 0x07030602u);
            const unsigned o0 = __builtin_amdgcn_perm(t2, t0, 0x05040100u), o1 = __builtin_amdgcn_perm(t2, t0, 0x07060302u);
            const unsigned o2 = __builtin_amdgcn_perm(t3, t1, 0x05040100u), o3 = __builtin_amdgcn_perm(t3, t1, 0x07060302u);
            acc[4 * q + 0] = __builtin_amdgcn_sdot4((int)o0, (int)cq[m], acc[4 * q + 0], false); acc[4 * q + 1] = __builtin_amdgcn_sdot4((int)o1, (int)cq[m], acc[4 * q + 1], false);
            acc[4 * q + 2] = __builtin_amdgcn_sdot4((int)o2, (int)cq[m], acc[4 * q + 2], false); acc[4 * q + 3] = __builtin_amdgcn_sdot4((int)o3, (int)cq[m], acc[4 * q + 3], false);
        }
    int h8v[8];
#pragma unroll
    for (int c = 0; c < 8; ++c) { auto rr = __builtin_amdgcn_permlane32_swap((unsigned)acc[c], (unsigned)acc[c + 8], false, false);
        unsigned r0 = rr[0], r1 = rr[1]; asm volatile("" : "+v"(r0), "+v"(r1));
        h8v[c] = (int)r0 + (int)r1; }
    const bool b4 = (lane >> 4) & 1, b3 = (lane >> 3) & 1;
    int h4[4];
#pragma unroll
    for (int c = 0; c < 4; ++c) { const int keep = b4 ? h8v[c + 4] : h8v[c], give = b4 ? h8v[c] : h8v[c + 4]; h4[c] = keep + __builtin_amdgcn_ds_swizzle(give, 0x401F); }
    int h2[2];
#pragma unroll
    for (int c = 0; c < 2; ++c) { const int keep = b3 ? h4[c + 2] : h4[c], give = b3 ? h4[c] : h4[c + 2]; h2[c] = keep + dpp_i<DPP_ROR8>(give); }
    const int srcl = ((lane >> 3) + 8 * (lane & 1) + 16 * ((lane >> 1) & 1) + 32 * ((lane >> 2) & 1)) * 4;
    const int q0 = __builtin_amdgcn_ds_bpermute(srcl, h2[0]), q1 = __builtin_amdgcn_ds_bpermute(srcl, h2[1]);
    f32x2_t o; o.x = xin.x + cs * (float)q0; o.y = xin.y + cs * (float)q1;
    __builtin_nontemporal_store(o, (GAS f32x2_t*)(F.out + (size_t)t * DM + mycol));
}

template <bool PHASE_B> __device__ __forceinline__ void p6_sliced(Frame& F) {
    const unsigned x = xb_xcc_id() & 7u;
    gu32* Q = F.ctl + (PHASE_B ? CW_QB : CW_QA);
    const int sub = F.lane & 7, gl = F.lane >> 3, rowoff = 16 * sub;
    const char* TAB0 = (const char*)(PHASE_B ? (const void*)F.V8 : (const void*)F.U8);
    unsigned s = 0; int j = 0, t0 = 0; bool have = false;
    for (; s < 8; ++s) {
        j = (int)((x + s) & 7u);
        unsigned c = 0;
        if (F.lane == 0) c = __hip_atomic_fetch_add((unsigned*)(Q + 64 * j), 1u, __ATOMIC_RELAXED, __HIP_MEMORY_SCOPE_AGENT);
        c = (unsigned)__builtin_amdgcn_readfirstlane((int)c);
        if (c < (unsigned)PE_NITEM) { t0 = (int)c * PE_TPI; have = true; break; }
    }
    if (!have) return;
    v4u ixA[2], ixB[2], wA[16], wB[16], auxA, auxB, aux2A = {}, aux2B = {}; float csA = 0.f, csB = 0.f;
#define PE_AUX(jj, t, aux, aux2, cs) do { if (PHASE_B) { aux = *(const GAS v4u*)(F.CQ + (size_t)(t) * 32 + gl * 4); cs = F.CS[t]; } \
        else { aux = *(const GAS v4u*)(F.XB + (size_t)(t) * DM + 128 * (jj) + 16 * sub); aux2 = *(const GAS v4u*)(F.XB + (size_t)(t) * DM + 128 * (jj) + 16 * sub + 8); cs = F.HINV[t]; } } while (0)
#define PE_COMPUTE(jj, t, aux, aux2, cs, w) do { if (PHASE_B) peB_compute(F, (jj), (t), aux, cs, w); else peA_compute(F, F.PA, (jj), (t), pe_quant16(aux, aux2, cs), w); } while (0)
#define PE_TAB(jj) ((const void*)(TAB0 + (size_t)(jj) * NEXP * 128))
    pe_load_ix(F, t0, ixA); pe_load_rows(PE_TAB(j), ixA, rowoff, wA); PE_AUX(j, t0, auxA, aux2A, csA); pe_load_ix(F, t0 + 1, ixB);
    for (;;) {
        unsigned vn = 0;
        if (F.lane == 0) vn = __hip_atomic_fetch_add((unsigned*)(Q + 64 * j), 1u, __ATOMIC_RELAXED, __HIP_MEMORY_SCOPE_AGENT);
        const void* TAB = PE_TAB(j);
#pragma unroll 1
        for (int k = 0; k < PE_TPI - 2; k += 2) {
            pe_load_rows(TAB, ixB, rowoff, wB); PE_AUX(j, t0 + k + 1, auxB, aux2B, csB);
            pe_load_ix(F, t0 + k + 2, ixA);
            PE_COMPUTE(j, t0 + k, auxA, aux2A, csA, wA);
            pe_load_rows(TAB, ixA, rowoff, wA); PE_AUX(j, t0 + k + 2, auxA, aux2A, csA); pe_load_ix(F, t0 + k + 3, ixB);
            PE_COMPUTE(j, t0 + k + 1, auxB, aux2B, csB, wB);
        }
        unsigned cn = (unsigned)__builtin_amdgcn_readfirstlane((int)vn);
        int jn = j; bool hn = cn < (unsigned)PE_NITEM;
        if (!hn) {
            for (++s; s < 8; ++s) {
                const int j2 = (int)((x + s) & 7u);
                unsigned c = 0;
                if (F.lane == 0) c = __hip_atomic_fetch_add((unsigned*)(Q + 64 * j2), 1u, __ATOMIC_RELAXED, __HIP_MEMORY_SCOPE_AGENT);
                c = (unsigned)__builtin_amdgcn_readfirstlane((int)c);
                if (c < (unsigned)PE_NITEM) { cn = c; jn = j2; hn = true; break; }
            }
        }
        const int tn = hn ? (int)cn * PE_TPI : t0;
        pe_load_rows(TAB, ixB, rowoff, wB); PE_AUX(j, t0 + PE_TPI - 1, auxB, aux2B, csB);
        pe_load_ix(F, tn, ixA);
        PE_COMPUTE(j, t0 + PE_TPI - 2, auxA, aux2A, csA, wA);
        pe_load_rows(PE_TAB(jn), ixA, rowoff, wA); PE_AUX(jn, tn, auxA, aux2A, csA); pe_load_ix(F, tn + 1, ixB);
        PE_COMPUTE(j, t0 + PE_TPI - 1, auxB, aux2B, csB, wB);
        if (!hn) break;
        j = jn; t0 = tn;
    }
#undef PE_TAB
#undef PE_AUX
#undef PE_COMPUTE
}

__device__ __forceinline__ void p6_fill_scales(Frame& F) {
    const char* src = (const char*)F.ws + (F.wave < 4 ? (size_t)WS_SCU + (size_t)F.wave * 16384 : (size_t)WS_SCV + (size_t)(F.wave - 4) * 16384) + F.lane * 16;
    LAS unsigned char* dst = F.lds + F.wave * 16384;
#pragma unroll
    for (int i = 0; i < 16; ++i) __builtin_amdgcn_global_load_lds((const unsigned*)(src + i * 1024), (LAS unsigned*)(dst + i * 1024), 16, 0, 0);
}
__device__ __forceinline__ void p6_reduce(Frame& F) {
    const int gw = F.vcu * NWAVES + F.wave, NGW = F.G * NWAVES, lane = F.lane;
    const int p0 = 16 * (lane >> 3) + (lane & 7);
    constexpr int NB = 4;
    asm volatile("s_waitcnt vmcnt(0)" ::: "memory"); __syncthreads();
    const LAS float* lscu = (const LAS float*)F.lds; const LAS float* lscv = (const LAS float*)(F.lds + 65536);
    for (int tb = gw * NB; tb < TOK; tb += NGW * NB) {
        int s[NB][2], e[NB][2]; float gt[NB][2], hs[NB];
#pragma unroll
        for (int b = 0; b < NB; ++b) {
            const int t = tb + b; hs[b] = F.HS[t];
            int a0 = 0, a1 = 0;
#pragma unroll
            for (int j = 0; j < 8; ++j) { const unsigned w = __builtin_nontemporal_load((const GAS unsigned*)F.PA + ((size_t)j * TOK + t) * 64 + lane); a0 += (int)(short)(w & 0xffffu); a1 += (int)w >> 16; }
            s[b][0] = a0; s[b][1] = a1;
#pragma unroll
            for (int hh = 0; hh < 2; ++hh) { const int p = p0 + 8 * hh; e[b][hh] = (int)F.EIDX[(size_t)t * 128 + p]; gt[b][hh] = F.GATE[(size_t)t * 128 + p]; }
        }
        float su[NB][2], sv[NB][2];
#pragma unroll
        for (int b = 0; b < NB; ++b)
#pragma unroll
            for (int hh = 0; hh < 2; ++hh) { su[b][hh] = lscu[e[b][hh]]; sv[b][hh] = lscv[e[b][hh]]; }
#pragma unroll
        for (int b = 0; b < NB; ++b) {
            const int t = tb + b;
            float cf[2]; float mx = 0.f;
#pragma unroll
            for (int hh = 0; hh < 2; ++hh) { const float a = hs[b] * su[b][hh] * (64.0f * (float)s[b][hh]);
                cf[hh] = gt[b][hh] * 0.5f * a * (1.0f + erff(a * 0.70710678118654752f)) * sv[b][hh]; mx = fmaxf(mx, fabsf(cf[hh])); }
#pragma unroll
            for (int o = 1; o < 64; o <<= 1) mx = fmaxf(mx, __shfl_xor(mx, o));
            const float sc = fmaxf(mx, 1e-30f) * (1.0f / 127.0f), inv = 1.0f / sc;
#pragma unroll
            for (int hh = 0; hh < 2; ++hh) {
                int v = ((int)rintf(cf[hh] * inv) & 0xff) << (8 * (lane & 3));
                v |= dpp_i<DPP_XOR1>(v); v |= dpp_i<DPP_XOR2>(v);
                if ((lane & 3) == 0) F.CQ[(size_t)t * 32 + ((p0 + 8 * hh) >> 2)] = (unsigned)v;
            }
            if (lane == 0) F.CS[t] = sc;
        }
    }
}

__device__ __forceinline__ void p5_scales(Frame& F) {
    const int gt = F.vcu * NWAVES * 64 + F.tid, NGT = F.G * NWAVES * 64;
    for (int t = gt; t < TOK; t += NGT) {
        float mx = 0.f, ss = 0.f;
#pragma unroll
        for (int q = 0; q < 4; ++q) { const f32x4 m = *(const GAS f32x4*)(F.MAXP + (size_t)t * 16 + 4 * q), p = *(const GAS f32x4*)(F.SSQ2P + (size_t)t * 16 + 4 * q);
            mx = fmaxf(mx, fmaxf(fmaxf(m[0], m[1]), fmaxf(m[2], m[3]))); ss += (p[0] + p[1]) + (p[2] + p[3]); }
        const float rstd2 = 1.0f / sqrtf(ss * (1.0f / DM) + pg8::EPS_F), sc = fmaxf(mx, 1e-20f) * (1.0f / 127.0f);
        F.HINV[t] = 1.0f / sc; F.HS[t] = sc * rstd2;
    }
}

#ifndef PROBE_REPEAT
#define PROBE_REPEAT -1
#endif
struct Args { const float* in[16]; float* out; unsigned char* ws; int ph_lo, ph_hi; };

template <class Sched> __device__ __forceinline__ void prep_tab_outproj(Frame& F, const Sched& S) {
    LAS float* tab = (LAS float*)(F.lds + TAB_OFF);
    pg8::Unit u;
    for (int i = 0; S.next(i, u) && i < 4; ++i) {
        if (F.tid < 256) {
            const int row = u.pm * 256 + F.tid;
            const f32x4 a0 = *(const GAS f32x4*)(F.SSQA + (size_t)row * 8), a1 = *(const GAS f32x4*)(F.SSQA + (size_t)row * 8 + 4);
            const f32x4 s0 = *(const GAS f32x4*)(F.SSQS + (size_t)row * 8), s1 = *(const GAS f32x4*)(F.SSQS + (size_t)row * 8 + 4);
            const float sa = ((a0[0] + a0[1]) + (a0[2] + a0[3])) + ((a1[0] + a1[1]) + (a1[2] + a1[3]));
            const float ss = ((s0[0] + s0[1]) + (s0[2] + s0[3])) + ((s1[0] + s1[1]) + (s1[2] + s1[3]));
            const float ra = 1.0f / sqrtf(sa * (1.0f / 512.0f) + pg8::EPS_F), rs = 1.0f / sqrtf(ss * (1.0f / 512.0f) + pg8::EPS_F);
            tab[(i * 256 + F.tid) * 2] = ra / rs; tab[(i * 256 + F.tid) * 2 + 1] = rs;
        }
    }
    LDS_WAIT(); __syncthreads();
}
template <class Sched> __device__ __forceinline__ void prep_tab_query(Frame& F, const Sched& S) {
    LAS float* tab = (LAS float*)(F.lds + TAB_OFF);
    pg8::Unit u;
    for (int i = 0; S.next(i, u) && i < 8; ++i) {
        if (F.tid < 256) {
            const int row = u.pm * 256 + F.tid; float s = 0.f;
#pragma unroll
            for (int j = 0; j < 4; ++j) { const f32x4 p = *(const GAS f32x4*)(F.SSQ2P + (size_t)row * 16 + 4 * j); s += (p[0] + p[1]) + (p[2] + p[3]); }
            tab[i * 256 + F.tid] = 1.0f / sqrtf(s * (1.0f / DM) + pg8::EPS_F);
        }
    }
    LDS_WAIT(); __syncthreads();
}

template <class Sched> __device__ __forceinline__ void prep_tab_inproj(Frame& F, const Sched& S) {
    LAS float* tab = (LAS float*)(F.lds + TAB_OFF);
    LAS float* gtab = (LAS float*)(F.lds + TAB_OFF + 8192);
    pg8::Unit u;
    for (int i = 0; S.next(i, u) && i < 8; ++i)
        if (F.tid < 256) tab[i * 256 + F.tid] = F.RSTD1[u.pm * 256 + F.tid];
    for (int i = F.tid; i < 640; i += NWAVES * 64) gtab[i] = (i < 64) ? F.q_norm_g[i] * pg8::QSCALE : (i < 128) ? F.k_norm_g[i - 64] : F.sgu_norm_g[i - 128];
    LDS_WAIT(); __syncthreads();
}
__device__ __forceinline__ void run_p1(Frame& F) {
    pg8::Gemm g{F.XB, F.Win_t, TOK, INW, DM}; pg8::StaticOrder S; S.init(TOK, INW, F.G, (int)blockIdx.x);
    prep_tab_inproj(F, S);
    pg8::EpiInProj E{(const LAS float*)(F.lds + TAB_OFF), (const LAS float*)(F.lds + TAB_OFF + 8192), F.Q, WS_TYPE_STRIDE / 2};
    pg8::gemm_phase<pg8::EpiInProj, pg8::StaticOrder, true, true>(F.lds + RING_OFF, g, S, E);
}
__device__ __forceinline__ void run_p3(Frame& F) {
    pg8::Gemm g{F.MIX, F.Wout_t, TOK, DM, DM}; pg8::StaticOrder S; S.init(TOK, DM, F.G, (int)blockIdx.x);
    prep_tab_outproj(F, S);
    pg8::EpiOutProj E{F.x, F.out, F.XB, F.SSQ2P, F.MAXP, (const LAS float*)(F.lds + TAB_OFF)};
    pg8::gemm_phase<pg8::EpiOutProj, pg8::StaticOrder, true, true>(F.lds + RING_OFF, g, S, E);
}
__device__ __forceinline__ void run_p4(Frame& F) {
    pg8::Gemm g{F.XB, F.Wq_t, TOK, QPW, DM}; pg8::StaticOrder S; S.init(TOK, QPW, F.G, (int)blockIdx.x);
    prep_tab_query(F, S);
    pg8::EpiQuery E{F.QP, (const LAS float*)(F.lds + TAB_OFF)};
    pg8::gemm_phase<pg8::EpiQuery, pg8::StaticOrder, true, true>(F.lds + RING_OFF, g, S, E);
}

__global__ void __launch_bounds__(NWAVES * 64, 2) hyb_fwd(Args args) {
    extern __shared__ __attribute__((aligned(16))) unsigned char lds[];
    Frame F;
    F.lds = (LAS unsigned char*)lds;
    F.MISC = (volatile LAS unsigned*)(F.lds + MISC_OFF);
    F.tid = threadIdx.x; F.lane = F.tid & 63; F.wave = __builtin_amdgcn_readfirstlane(F.tid >> 6);
    F.G = gridDim.x; { const int bx = blockIdx.x; F.vcu = (F.G % 8 == 0) ? (bx % 8) * (F.G / 8) + bx / 8 : bx; }
    unsigned char* ws = args.ws;
    F.ctl = (gu32*)(ws + WS_CTL);
    F.x = args.in[0]; F.norm1_g = args.in[1]; F.w_in = args.in[2]; F.q_norm_g = args.in[3]; F.k_norm_g = args.in[4]; F.sgu_norm_g = args.in[5]; F.sgu_w = args.in[6]; F.sgu_b = args.in[7];
    F.attn_out_g = args.in[8]; F.sgu_out_g = args.in[9]; F.w_out = args.in[10]; F.norm2_g = args.in[11]; F.w_query = args.in[12]; F.sub_keys = args.in[13]; F.expert_u = args.in[14]; F.expert_v = args.in[15];
    F.out = args.out;
    F.Win_t = (bf16*)(ws + WS_WIN); F.Wout_t = (bf16*)(ws + WS_WOUT); F.Wq_t = (bf16*)(ws + WS_WQ); F.SK = (bf16*)(ws + WS_SK); F.SGUW = (bf16*)(ws + WS_SGUW);
    F.U8 = (signed char*)(ws + WS_UB); F.V8 = (signed char*)(ws + WS_VB); F.ws = ws;
    F.H8 = (signed char*)(ws + WS_H8); F.MAXP = (float*)(ws + WS_MAXP); F.HINV = (float*)(ws + WS_HINV); F.HS = (float*)(ws + WS_HS); F.PA = (int*)(ws + WS_PA); F.CQ = (unsigned*)(ws + WS_COEF); F.CS = (float*)(ws + WS_COEF0);
    F.XB = (bf16*)(ws + WS_XB); F.Q = (bf16*)(ws + WS_Q); F.QP = (bf16*)(ws + WS_QP); F.MIX = (bf16*)(ws + WS_MIX);
    F.RSTD1 = (float*)(ws + WS_RSTD1); F.SSQA = (float*)(ws + WS_SSQA); F.SSQS = (float*)(ws + WS_SSQS); F.SSQ2P = (float*)(ws + WS_SSQ2P); F.GATE = (float*)(ws + WS_GATE); F.EIDX = (unsigned short*)(ws + WS_EIDX);
    for (int u = F.tid; u < (LDS_BYTES - LDSCTL_OFF) / 4; u += NWAVES * 64) ((LAS unsigned*)(F.lds + LDSCTL_OFF))[u] = 0u;
    __syncthreads();
    XcdBarrier bar; bar.bar = (unsigned*)(F.ctl + CW_BAR); bar.x = 0; bar.st = nullptr;
    const int lo = args.ph_lo, hi = args.ph_hi;
    if (hi - lo > 1) bar = xcd_barrier_post((unsigned*)(F.ctl + CW_BAR), F.MISC + 8);
#define IN(k) (lo <= (k) && (k) < hi)

#define SEAM(k) do { if (IN(k) && IN((k) + 1)) { xcd_barrier(bar); if (PROBE_REPEAT == 100 + (k)) { xcd_barrier(bar); xcd_barrier(bar); xcd_barrier(bar); xcd_barrier(bar); } } } while (0)

    if (IN(0)) { p0_prologue(F); if (PROBE_REPEAT == 0) { xcd_barrier(bar); p0_prologue(F); } } SEAM(0);
    if (IN(1)) { run_p1(F); if (PROBE_REPEAT == 1) { xcd_barrier(bar); run_p1(F); } } SEAM(1);
    if (IN(2)) { p2_mixers(F); if (PROBE_REPEAT == 2) { xcd_barrier(bar); p2_mixers(F); } } SEAM(2);
    if (IN(3)) { run_p3(F); if (PROBE_REPEAT == 3) { xcd_barrier(bar); run_p3(F); } } SEAM(3);
    if (IN(4)) { run_p4(F); if (PROBE_REPEAT == 4) { xcd_barrier(bar); run_p4(F); } }
    if (!(IN(4) && IN(5))) {   } else { asm volatile("s_waitcnt vmcnt(0)" ::: "memory"); __syncthreads(); }
    if (IN(5)) {
#pragma unroll 1
        for (int rep = 0; rep < (PROBE_REPEAT == 5 ? 2 : 1); ++rep) p5_topk(F);
#pragma unroll 1
        for (int rep = 0; rep < (PROBE_REPEAT == 15 ? 2 : 1); ++rep) p5_scales(F);
    } SEAM(5);
    if (IN(6)) {
        p6_fill_scales(F);
#pragma unroll 1
        for (int rep = 0; rep < (PROBE_REPEAT == 6 ? 2 : 1); ++rep) {
            if (rep) { xcd_barrier(bar); if (blockIdx.x == 0 && F.tid < 8) __hip_atomic_store((unsigned*)(F.ctl + CW_QA + 64 * F.tid), 0u, __ATOMIC_RELAXED, __HIP_MEMORY_SCOPE_AGENT); xcd_barrier(bar); }
            p6_sliced<false>(F);
        }
        if (hi - lo > 1) xcd_barrier(bar);
#pragma unroll 1
        for (int rep = 0; rep < (PROBE_REPEAT == 7 ? 2 : 1); ++rep) p6_reduce(F);
        if (hi - lo > 1) xcd_barrier(bar);
#pragma unroll 1
        for (int rep = 0; rep < (PROBE_REPEAT == 8 ? 2 : 1); ++rep) {
            if (rep) { xcd_barrier(bar); if (blockIdx.x == 0 && F.tid < 8) __hip_atomic_store((unsigned*)(F.ctl + CW_QB + 64 * F.tid), 0u, __ATOMIC_RELAXED, __HIP_MEMORY_SCOPE_AGENT); xcd_barrier(bar); }
            p6_sliced<true>(F);
        }
    }
#undef IN
#undef SEAM
}

extern "C" void kernel_launch(void* const* d_in, const int* in_sizes, int n_in, void* d_out, int out_size, void* d_ws, size_t ws_size, hipStream_t stream) {
    static int grid = 0;
    if (grid == 0) {
        if (n_in != 16 || in_sizes[0] != TOK * DM || out_size != TOK * DM || ws_size < WS_END) { fprintf(stderr, "kernel_launch: unexpected shapes (n_in %d, in0 %d, out %d, ws %zu)\n", n_in, n_in > 0 ? in_sizes[0] : -1, out_size, ws_size); grid = -1; return; }
        int dev = 0, cus = 0, per_cu = 0;
        if (hipGetDevice(&dev) != hipSuccess || hipDeviceGetAttribute(&cus, hipDeviceAttributeMultiprocessorCount, dev) != hipSuccess) { fprintf(stderr, "kernel_launch: device query failed\n"); grid = -1; return; }
        if (hipFuncSetAttribute((const void*)hyb_fwd, hipFuncAttributeMaxDynamicSharedMemorySize, LDS_BYTES) != hipSuccess) { fprintf(stderr, "kernel_launch: hipFuncSetAttribute failed\n"); grid = -1; return; }
        if (hipOccupancyMaxActiveBlocksPerMultiprocessor(&per_cu, (const void*)hyb_fwd, NWAVES * 64, LDS_BYTES) != hipSuccess || per_cu < 1) { fprintf(stderr, "kernel_launch: occupancy query reports %d blocks per CU\n", per_cu); per_cu = 1; }
        (void)hipGetLastError();
        grid = cus;
        if (grid % 8 != 0) grid -= grid % 8;
    }
    if (grid < 0) return;
    (void)hipMemsetAsync((char*)d_ws + WS_CTL, 0, CTL_ZERO_BYTES, stream);
    Args a{};
    for (int i = 0; i < 16; ++i) a.in[i] = (const float*)d_in[i];
    a.out = (float*)d_out; a.ws = (unsigned char*)d_ws;
    if (N_LAUNCHES == 1) { a.ph_lo = 0; a.ph_hi = NPHASE; hipLaunchKernelGGL(hyb_fwd, dim3(grid), dim3(NWAVES * 64), LDS_BYTES, stream, a); }
    else for (int li = 0; li < NPHASE; ++li) { a.ph_lo = li; a.ph_hi = li + 1; hipLaunchKernelGGL(hyb_fwd, dim3(grid), dim3(NWAVES * 64), LDS_BYTES, stream, a); }
}
```

```cpp
#include <hip/hip_runtime.h>
#include <cstdio>
#include <cstdint>
#include <cmath>
namespace pg8 {
#define PG8_LAS __attribute__((address_space(3)))
typedef unsigned short bf16_t;
typedef short bf16x8 __attribute__((ext_vector_type(8)));
typedef float f32x4 __attribute__((ext_vector_type(4)));
typedef unsigned u32x4 __attribute__((ext_vector_type(4)));
constexpr int BM = 256, BK = 64, HALF = 128, HTB = HALF * BK * 2  , STAGE_BYTES = 8 * HTB, NXCD = 8, WGM = 8;

__host__ __device__ __forceinline__ int lds_byte(int r, int c) { const int st = (r >> 4) * 2 + (c >> 5), rr = r & 15, cc = c & 31, ob = rr * 64 + cc * 2; return st * 1024 + (ob ^ (((ob >> 9) & 1) << 5)); }
__host__ __device__ __forceinline__ void stage_rc(int b, int& R, int& C) { const int st = b / 1024, sb = b % 1024, swz = sb ^ (((sb >> 9) & 1) << 5); R = (st >> 1) * 16 + swz / 64; C = (st & 1) * 32 + (swz % 64) / 2; }
__host__ __device__ __forceinline__ int perm32(int rho) { const int n = rho >> 4, i = rho & 15; return 8 * (i >> 2) + 4 * n + (i & 3); }

struct Unit { int pm, pn; };
struct Gemm { const bf16_t* A; const bf16_t* Bt; int M, N, K; };

struct StaticOrder {
    int nM, nN, nwg, G, c;
    __host__ __device__ void init(int M, int N, int G_, int c_) { nM = M / BM; nN = N / BM; nwg = nM * nN; G = G_; c = c_; }
    __host__ __device__ bool next(int i, Unit& u) const {
        const long L = (long)i * G + c; if (L >= nwg) return false;
        int wgid = (int)L; { const int q = nwg / NXCD, r = nwg % NXCD, xcd = wgid % NXCD, off = wgid / NXCD; wgid = (xcd < r ? xcd * (q + 1) : r * (q + 1) + (xcd - r) * q) + off; }
        const int nig = WGM * nN, gid = wgid / nig, fm = gid * WGM, gsz = (nM - fm) < WGM ? (nM - fm) : WGM;
        u.pm = fm + ((wgid % nig) % gsz); u.pn = (wgid % nig) / gsz; return true;
    }
    __device__ __forceinline__ void a_ready(const Unit&) const {}
    __device__ __forceinline__ void done(const Unit&) const {}
};


__device__ __forceinline__ unsigned cvt_pk_bf16(float lo, float hi) { unsigned r; asm volatile("v_cvt_pk_bf16_f32 %0, %1, %2" : "=v"(r) : "v"(lo), "v"(hi)); return r; }

constexpr float EPS_F = 1e-6f;
constexpr float QSCALE = 0.125f * 1.4426950408889634f;

struct EpiInProj {
    static constexpr bool PERM = true; static constexpr int MID_T = 0;
    const PG8_LAS float* tab;
    const PG8_LAS float* gtab;
    bf16_t* out0; size_t type_stride;
    __device__ __forceinline__ void operator()(const f32x4 (&acc)[2][2][4][2], const Unit& u, int ui, int wr, int wc, int fr, int fq) const {
        const int type = u.pn >> 1, half = u.pn & 1;
        bf16_t* base = out0 + (size_t)type * type_stride;
        const int colb = 256 * half + 64 * wc + 8 * fq;
        const bool normed = (type == 0) || (type == 1) || (type == 4);
        const int goff = (type == 0) ? 8 * fq : (type == 1) ? 64 + 8 * fq : 128 + colb;
        float g[2][8];
#pragma unroll
        for (int bj = 0; bj < 2; ++bj) {
            const f32x4 g0 = *(const PG8_LAS f32x4*)(gtab + goff + 32 * bj), g1 = *(const PG8_LAS f32x4*)(gtab + goff + 32 * bj + 4);
#pragma unroll
            for (int e = 0; e < 4; ++e) { g[bj][e] = normed ? g0[e] : 1.f; g[bj][4 + e] = normed ? g1[e] : 1.f; }
        }
#pragma unroll
        for (int ai = 0; ai < 2; ++ai)
#pragma unroll
            for (int m = 0; m < 4; ++m) {
                const int lr = ai * HALF + wr * 64 + m * 16 + fr, row = u.pm * BM + lr;
                const float rs = tab[ui * 256 + lr];
                f32x4 v[2][2];
                float ss = 0.f;
#pragma unroll
                for (int bj = 0; bj < 2; ++bj)
#pragma unroll
                    for (int n = 0; n < 2; ++n) { v[bj][n] = acc[ai][bj][m][n] * rs; const f32x4 x = v[bj][n]; ss += (x[0] * x[0] + x[1] * x[1]) + (x[2] * x[2] + x[3] * x[3]); }
                float r = 1.f;
                if (normed) { ss += __shfl_xor(ss, 16); ss += __shfl_xor(ss, 32); r = 1.0f / sqrtf(ss * (1.0f / 64.0f) + EPS_F); }
                bf16_t* rowp = base + (size_t)row * 512 + colb;
#pragma unroll
                for (int bj = 0; bj < 2; ++bj) {
                    const f32x4 a = v[bj][0], b = v[bj][1];
                    u32x4 w;
                    w.x = cvt_pk_bf16(a[0] * r * g[bj][0], a[1] * r * g[bj][1]); w.y = cvt_pk_bf16(a[2] * r * g[bj][2], a[3] * r * g[bj][3]);
                    w.z = cvt_pk_bf16(b[0] * r * g[bj][4], b[1] * r * g[bj][5]); w.w = cvt_pk_bf16(b[2] * r * g[bj][6], b[3] * r * g[bj][7]);
                    *(u32x4*)(rowp + 32 * bj) = w;
                }
            }
    }
};

struct EpiOutProj {
    static constexpr bool PERM = true; static constexpr int MID_T = 8;
    const float* x; float* x1; bf16_t* x1b; float* ssq2p; float* maxp; const PG8_LAS float* tab;
    __device__ __forceinline__ void mid(f32x4 (&acc)[2][2][4][2], const Unit&, int ui, int wr, int, int fr, int) const {
#pragma unroll
        for (int ai = 0; ai < 2; ++ai)
#pragma unroll
            for (int m = 0; m < 4; ++m) {
                const float rt = tab[(ui * 256 + ai * HALF + wr * 64 + m * 16 + fr) * 2];
#pragma unroll
                for (int bj = 0; bj < 2; ++bj)
#pragma unroll
                    for (int n = 0; n < 2; ++n) acc[ai][bj][m][n] *= rt;
            }
    }
    __device__ __forceinline__ void operator()(const f32x4 (&acc)[2][2][4][2], const Unit& u, int ui, int wr, int wc, int fr, int fq) const {
        const size_t cbase = (size_t)u.pn * BM + wc * 32 + 8 * fq;
        u32x4 xall[8][2];
#pragma unroll
        for (int it = 0; it < 8; ++it) { const int r_ = u.pm * BM + (it >> 2) * HALF + wr * 64 + (it & 3) * 16 + fr;
#pragma unroll
            for (int bj = 0; bj < 2; ++bj) xall[it][bj] = *(const u32x4*)(x1b + (size_t)r_ * 1024 + cbase + bj * HALF); }
#pragma unroll
        for (int it = 0; it < 8; ++it) {
            const int ai = it >> 2, m = it & 3;
            const int lr = ai * HALF + wr * 64 + m * 16 + fr, row = u.pm * BM + lr;
            const float rs = tab[(ui * 256 + lr) * 2 + 1];
            u32x4 xc[2];
#pragma unroll
            for (int bj = 0; bj < 2; ++bj) xc[bj] = xall[it][bj];
            float ss = 0.f, mx = 0.f;
#pragma unroll
            for (int bj = 0; bj < 2; ++bj) {
                const size_t off = (size_t)row * 1024 + cbase + bj * HALF;
                f32x4 xa, xb_; xa[0] = __builtin_bit_cast(float, xc[bj].x << 16); xa[1] = __builtin_bit_cast(float, xc[bj].x & 0xffff0000u); xa[2] = __builtin_bit_cast(float, xc[bj].y << 16); xa[3] = __builtin_bit_cast(float, xc[bj].y & 0xffff0000u);
                xb_[0] = __builtin_bit_cast(float, xc[bj].z << 16); xb_[1] = __builtin_bit_cast(float, xc[bj].z & 0xffff0000u); xb_[2] = __builtin_bit_cast(float, xc[bj].w << 16); xb_[3] = __builtin_bit_cast(float, xc[bj].w & 0xffff0000u);
                const f32x4 a = xa + acc[ai][bj][m][0] * rs, b = xb_ + acc[ai][bj][m][1] * rs;
                ss += (a[0] * a[0] + a[1] * a[1]) + (a[2] * a[2] + a[3] * a[3]) + (b[0] * b[0] + b[1] * b[1]) + (b[2] * b[2] + b[3] * b[3]);
                mx = fmaxf(mx, fmaxf(fmaxf(fmaxf(fabsf(a[0]), fabsf(a[1])), fmaxf(fabsf(a[2]), fabsf(a[3]))), fmaxf(fmaxf(fabsf(b[0]), fabsf(b[1])), fmaxf(fabsf(b[2]), fabsf(b[3])))));
                u32x4 w; w.x = cvt_pk_bf16(a[0], a[1]); w.y = cvt_pk_bf16(a[2], a[3]); w.z = cvt_pk_bf16(b[0], b[1]); w.w = cvt_pk_bf16(b[2], b[3]);
                *(u32x4*)(x1b + off) = w;
            }
            ss += __shfl_xor(ss, 16); ss += __shfl_xor(ss, 32); mx = fmaxf(mx, __shfl_xor(mx, 16)); mx = fmaxf(mx, __shfl_xor(mx, 32));
            if (fq == 0) { ssq2p[(size_t)row * 16 + u.pn * 4 + wc] = ss; maxp[(size_t)row * 16 + u.pn * 4 + wc] = mx; }
        }
    }
};

struct EpiQuery {
    static constexpr bool PERM = true; static constexpr int MID_T = 0;
    bf16_t* qp; const PG8_LAS float* tab;
    __device__ __forceinline__ void operator()(const f32x4 (&acc)[2][2][4][2], const Unit& u, int ui, int wr, int wc, int fr, int fq) const {
#pragma unroll
        for (int ai = 0; ai < 2; ++ai)
#pragma unroll
            for (int m = 0; m < 4; ++m) {
                const int lr = ai * HALF + wr * 64 + m * 16 + fr, row = u.pm * BM + lr;
                const float rs = tab[ui * 256 + lr];
#pragma unroll
                for (int bj = 0; bj < 2; ++bj) {
                    const size_t off = ((((size_t)(row >> 5) * 8 + u.pn) * 2 + bj) * 8 + 2 * wc + (fq >> 1)) * 512 + (size_t)(32 * (fq & 1) + (row & 31)) * 8;
                    const f32x4 a = acc[ai][bj][m][0] * rs, b = acc[ai][bj][m][1] * rs;
                    u32x4 w; w.x = cvt_pk_bf16(a[0], a[1]); w.y = cvt_pk_bf16(a[2], a[3]); w.z = cvt_pk_bf16(b[0], b[1]); w.w = cvt_pk_bf16(b[2], b[3]);
                    *(u32x4*)(qp + off) = w;
                }
            }
    }
};

template <class Epi, class Sched, bool ALIGN_EPI = false, bool SP2 = false>
__device__ __forceinline__ void gemm_phase(PG8_LAS unsigned char* lds, const Gemm g, const Sched& S, const Epi& E) {
    const int tid = threadIdx.x, wid = __builtin_amdgcn_readfirstlane(tid >> 6), lane = tid & 63, wr = wid >> 2, wc = wid & 3, fr = lane & 15, fq = lane >> 4;
    const int K = g.K, nt = K / BK;
    unsigned voffA[2], voffB[2];
#pragma unroll
    for (int i = 0; i < 2; ++i) { int R, C; stage_rc(tid * 16 + i * 8192, R, C); const int Rb = Epi::PERM ? ((R & ~31) + perm32(R & 31)) : R;
        voffA[i] = (unsigned)(R * K + C) * 2u; voffB[i] = (unsigned)(Rb * K + C) * 2u; }
    const size_t kstep = (size_t)(BK * 2);
    const size_t hstep = (size_t)HALF * K * 2;
    const size_t tstep = 2 * hstep;
    const unsigned ldsw = (unsigned)wid * 1024u;
    const int aoff = lds_byte(wr * 64 + fr, fq * 8), boff = lds_byte(wc * 32 + fr, fq * 8);
#define PG8_SA(b, h) (((b) * 2 + (h)) * HTB)
#define PG8_SB(b, h) ((4 + (b) * 2 + (h)) * HTB)
#define PG8_STAGE(bufoff, gbase, voff) do { _Pragma("unroll") for (int _i = 0; _i < 2; ++_i) \
        __builtin_amdgcn_global_load_lds((const unsigned*)((const char*)(gbase) + (voff)[_i]), (PG8_LAS unsigned*)(lds + (bufoff) + ldsw + _i * 8192), 16, 0, 0); } while (0)
#define PG8_LDA(dst, b, h) do { _Pragma("unroll") for (int m = 0; m < 4; ++m) _Pragma("unroll") for (int k = 0; k < 2; ++k) dst[m][k] = *(const PG8_LAS bf16x8*)(lds + PG8_SA(b, h) + aoff + m * 2048 + k * 1024); } while (0)
#define PG8_LDB(dst, b, h) do { _Pragma("unroll") for (int n = 0; n < 2; ++n) _Pragma("unroll") for (int k = 0; k < 2; ++k) dst[n][k] = *(const PG8_LAS bf16x8*)(lds + PG8_SB(b, h) + boff + n * 2048 + k * 1024); } while (0)
#define PG8_MMA(ai, bj, At, Bt) do { __builtin_amdgcn_s_setprio(1); _Pragma("unroll") for (int m = 0; m < 4; ++m) _Pragma("unroll") for (int n = 0; n < 2; ++n) _Pragma("unroll") for (int k = 0; k < 2; ++k) \
        acc[ai][bj][m][n] = __builtin_amdgcn_mfma_f32_16x16x32_bf16(Bt[n][k], At[m][k], acc[ai][bj][m][n], 0, 0, 0); __builtin_amdgcn_s_setprio(0); } while (0)
#define PG8_WAIT_V(n) asm volatile("s_waitcnt vmcnt(" #n ")" ::: "memory")
#define PG8_WAIT_L(n) asm volatile("s_waitcnt lgkmcnt(" #n ")" ::: "memory")
#define PG8_BAR __builtin_amdgcn_s_barrier()
#define PG8_SCHED __builtin_amdgcn_sched_barrier(0)
    Unit cur, nxt; int ui = 0;
    if (!S.next(0, cur)) return;
    f32x4 acc[2][2][4][2];
#pragma unroll
    for (int a = 0; a < 2; ++a)
#pragma unroll
        for (int b = 0; b < 2; ++b)
#pragma unroll
            for (int m = 0; m < 4; ++m)
#pragma unroll
                for (int n = 0; n < 2; ++n) acc[a][b][m][n] = (f32x4){0.f, 0.f, 0.f, 0.f};
    bf16x8 At[4][2], B0[2][2], B1[2][2];
    const char* cA = (const char*)g.A + (size_t)cur.pm * tstep; const char* cB = (const char*)g.Bt + (size_t)cur.pn * tstep;
    S.a_ready(cur);
    if constexpr (SP2) {
        PG8_STAGE(PG8_SB(0, 0), cB, voffB); PG8_STAGE(PG8_SB(0, 1), cB + hstep, voffB); PG8_STAGE(PG8_SA(0, 0), cA, voffA); PG8_STAGE(PG8_SA(0, 1), cA + hstep, voffA);
        if (wr == 1) PG8_BAR;
        PG8_WAIT_V(2); PG8_BAR;
        PG8_STAGE(PG8_SB(1, 0), cB + kstep, voffB); PG8_STAGE(PG8_SA(1, 0), cA + kstep, voffA); PG8_STAGE(PG8_SB(1, 1), cB + hstep + kstep, voffB);
        PG8_WAIT_V(6); PG8_BAR;
    } else {
        PG8_STAGE(PG8_SB(0, 0), cB, voffB); PG8_STAGE(PG8_SA(0, 0), cA, voffA); PG8_STAGE(PG8_SB(0, 1), cB + hstep, voffB); PG8_STAGE(PG8_SA(0, 1), cA + hstep, voffA);
        if (wr == 1) PG8_BAR;
        PG8_WAIT_V(4); PG8_BAR;
        PG8_STAGE(PG8_SB(1, 0), cB + kstep, voffB); PG8_STAGE(PG8_SA(1, 0), cA + kstep, voffA); PG8_STAGE(PG8_SB(1, 1), cB + hstep + kstep, voffB);
        PG8_WAIT_V(6); PG8_BAR;
    }
    for (;;) {
        const bool has_next = S.next(ui + 1, nxt);
        const char* nA = has_next ? (const char*)g.A + (size_t)nxt.pm * tstep : cA; const char* nB = has_next ? (const char*)g.Bt + (size_t)nxt.pn * tstep : cB;
        for (int t = 0; t < nt; t += 2) {
            if constexpr (Epi::MID_T > 0) { if (t == Epi::MID_T) E.mid(acc, cur, ui, wr, wc, fr, fq); }
            const bool last = (t == nt - 2);
            const char* a1 = cA + (size_t)(t + 1) * kstep;
            const char* a2 = last ? nA : cA + (size_t)(t + 2) * kstep; const char* b2 = last ? nB : cB + (size_t)(t + 2) * kstep;
            const char* a3 = a2 + kstep; const char* b3 = b2 + kstep;
            if (last && has_next) S.a_ready(nxt);
            if constexpr (SP2) {
            PG8_LDB(B0, 0, 0); PG8_LDB(B1, 0, 1); PG8_SCHED; PG8_LDA(At, 0, 0); PG8_STAGE(PG8_SA(1, 1), a1 + hstep, voffA);
            PG8_WAIT_V(8); PG8_WAIT_L(0); PG8_BAR; PG8_MMA(0, 0, At, B0); PG8_MMA(0, 1, At, B1); PG8_BAR; PG8_SCHED;
            PG8_LDA(At, 0, 1); PG8_STAGE(PG8_SB(0, 0), b2, voffB); PG8_STAGE(PG8_SB(0, 1), b2 + hstep, voffB); PG8_STAGE(PG8_SA(0, 0), a2, voffA);
            PG8_WAIT_V(8); PG8_WAIT_L(0); PG8_BAR; PG8_MMA(1, 0, At, B0); PG8_MMA(1, 1, At, B1); PG8_BAR; PG8_SCHED;
            PG8_LDB(B0, 1, 0); PG8_LDB(B1, 1, 1); PG8_SCHED; PG8_LDA(At, 1, 0); PG8_STAGE(PG8_SA(0, 1), a2 + hstep, voffA);
            PG8_WAIT_V(8); PG8_WAIT_L(0); PG8_BAR; PG8_MMA(0, 0, At, B0); PG8_MMA(0, 1, At, B1); PG8_BAR; PG8_SCHED;
            PG8_LDA(At, 1, 1); PG8_STAGE(PG8_SB(1, 0), b3, voffB); PG8_STAGE(PG8_SB(1, 1), b3 + hstep, voffB); PG8_STAGE(PG8_SA(1, 0), a3, voffA);
            PG8_WAIT_V(8); PG8_WAIT_L(0); PG8_BAR; PG8_MMA(1, 0, At, B0); PG8_MMA(1, 1, At, B1); PG8_BAR; PG8_SCHED;
            } else {
            PG8_LDB(B0, 0, 0); PG8_SCHED; PG8_LDA(At, 0, 0); PG8_STAGE(PG8_SA(1, 1), a1 + hstep, voffA);
            PG8_WAIT_L(8); PG8_BAR; PG8_WAIT_L(0); PG8_MMA(0, 0, At, B0); PG8_BAR; PG8_SCHED;
            PG8_LDB(B1, 0, 1); PG8_STAGE(PG8_SB(0, 0), b2, voffB);
            PG8_BAR; PG8_WAIT_L(0); PG8_MMA(0, 1, At, B1); PG8_BAR;
            PG8_LDA(At, 0, 1); PG8_STAGE(PG8_SA(0, 0), a2, voffA);
            PG8_BAR; PG8_WAIT_L(0); PG8_MMA(1, 0, At, B0); PG8_BAR; PG8_SCHED;
            PG8_STAGE(PG8_SB(0, 1), b2 + hstep, voffB);
            PG8_WAIT_V(6); PG8_BAR; PG8_MMA(1, 1, At, B1); PG8_BAR;
            PG8_LDB(B0, 1, 0); PG8_SCHED; PG8_LDA(At, 1, 0); PG8_STAGE(PG8_SA(0, 1), a2 + hstep, voffA);
            PG8_WAIT_L(8); PG8_BAR; PG8_WAIT_L(0); PG8_MMA(0, 0, At, B0); PG8_BAR; PG8_SCHED;
            PG8_LDB(B1, 1, 1); PG8_STAGE(PG8_SB(1, 0), b3, voffB);
            PG8_BAR; PG8_WAIT_L(0); PG8_MMA(0, 1, At, B1); PG8_BAR;
            PG8_LDA(At, 1, 1); PG8_STAGE(PG8_SA(1, 0), a3, voffA);
            PG8_BAR; PG8_WAIT_L(0); PG8_MMA(1, 0, At, B0); PG8_BAR; PG8_SCHED;
            PG8_STAGE(PG8_SB(1, 1), b3 + hstep, voffB);
            PG8_WAIT_V(6); PG8_BAR; PG8_MMA(1, 1, At, B1); PG8_BAR;
            }
        }
        if constexpr (ALIGN_EPI) { if (wr == 0) PG8_BAR; }
        E(acc, cur, ui, wr, wc, fr, fq); S.done(cur);
        if (!has_next) break;
#pragma unroll
        for (int a = 0; a < 2; ++a)
#pragma unroll
            for (int b = 0; b < 2; ++b)
#pragma unroll
                for (int m = 0; m < 4; ++m)
#pragma unroll
                    for (int n = 0; n < 2; ++n) acc[a][b][m][n] = (f32x4){0.f, 0.f, 0.f, 0.f};
        cur = nxt; cA = nA; cB = nB; ++ui;
        if constexpr (ALIGN_EPI) { if (wr == 1) PG8_BAR; }
    }
    PG8_WAIT_V(0);
    if constexpr (!ALIGN_EPI) { if (wr == 0) PG8_BAR; }
    PG8_BAR;
#undef PG8_SA
#undef PG8_SB
#undef PG8_STAGE
#undef PG8_LDA
#undef PG8_LDB
#undef PG8_MMA
#undef PG8_WAIT_V
#undef PG8_WAIT_L
#undef PG8_BAR
#undef PG8_SCHED
}
}

constexpr int NWAVES = 8;
constexpr int DM = 1024, BATCH = 8, SEQ = 4096, TOK = BATCH * SEQ;
constexpr int AW = 512, INW = 2560, QPW = 2048, NEXP = 16384;
constexpr int NPHASE = 7;
#ifndef MK_N_LAUNCHES
#define MK_N_LAUNCHES 1
#endif
constexpr int N_LAUNCHES = MK_N_LAUNCHES;

constexpr size_t MiB = 1u << 20;
constexpr size_t WS_CTL = 0, CTL_ZERO_BYTES = 64 * 1024;
constexpr size_t WS_WIN = 2 * MiB, WS_WOUT = 8 * MiB, WS_WQ = 10 * MiB, WS_SK = 14 * MiB, WS_SGUW = 14 * MiB + 512 * 1024, WS_RSTD1 = 15 * MiB;
constexpr size_t WS_SCU = 15 * MiB + 256 * 1024, WS_SCV = 15 * MiB + 512 * 1024;
constexpr size_t WS_UB = 16 * MiB, WS_VB = 48 * MiB;
constexpr size_t WS_XB = 80 * MiB;
constexpr size_t WS_Q = 144 * MiB, WS_TYPE_STRIDE = 32 * MiB;
constexpr size_t WS_QP = 144 * MiB;
constexpr size_t WS_MIX = 304 * MiB;
constexpr size_t WS_SSQA = 368 * MiB, WS_SSQS = 369 * MiB, WS_SSQ2P = 370 * MiB, WS_MAXP = 372 * MiB, WS_HINV = 374 * MiB;
constexpr size_t WS_PA = 144 * MiB;
constexpr size_t WS_COEF = 304 * MiB, WS_COEF0 = 320 * MiB, WS_H8 = 324 * MiB, WS_HS = 356 * MiB;
constexpr size_t WS_EIDX = 376 * MiB, WS_GATE = 392 * MiB, WS_END = 408 * MiB;
constexpr int CW_BAR = 1024;

constexpr int RING_OFF = 0, RING_BYTES = 131072;
constexpr int TAB_OFF = RING_BYTES, TAB_BYTES = 8192;
constexpr int LDSCTL_OFF = 153600, MISC_OFF = LDSCTL_OFF + 64;
constexpr int LDS_BYTES = 155648;
static_assert(MISC_OFF + 128 <= LDS_BYTES, "LDS map");

#define GAS __attribute__((address_space(1)))
#define LAS __attribute__((address_space(3)))
typedef unsigned short bf16;
typedef unsigned v4u __attribute__((ext_vector_type(4)));
typedef unsigned v2u __attribute__((ext_vector_type(2)));
typedef float f32x4 __attribute__((ext_vector_type(4)));
typedef float f32x16 __attribute__((ext_vector_type(16)));
typedef short bf16x8 __attribute__((ext_vector_type(8)));
typedef short s16x4 __attribute__((ext_vector_type(4)));
typedef __bf16 bf16x2_t __attribute__((ext_vector_type(2)));
typedef GAS unsigned gu32;
#define RLX_AGENT __ATOMIC_RELAXED, __HIP_MEMORY_SCOPE_AGENT
#define LDS_WAIT() asm volatile("s_waitcnt lgkmcnt(0)" ::: "memory")
#define VM_WAIT() asm volatile("s_waitcnt vmcnt(0)" ::: "memory")
__device__ __forceinline__ unsigned f2bf(float f) { unsigned u = __builtin_bit_cast(unsigned, f); return (u + 0x7fffu + ((u >> 16) & 1u)) >> 16; }
__device__ __forceinline__ unsigned pk2(float lo, float hi) { return pg8::cvt_pk_bf16(lo, hi); }
__device__ __forceinline__ float bf_lo(unsigned w) { return __builtin_bit_cast(float, w << 16); }
__device__ __forceinline__ float bf_hi(unsigned w) { return __builtin_bit_cast(float, w & 0xffff0000u); }
__device__ __forceinline__ int crow(int r, int hi) { return (r & 3) + 8 * (r >> 2) + 4 * hi; }
#define XB_TMO      128
#define XB_XCNT(j)  (256  + 64 * (j))
#define XB_XSUB(j)  (1280 + 64 * (j))
#define XB_XGEN(j)  (2304 + 64 * (j))
#define XB_TOP      3328
#define XB_TOPGEN   3392
#define XCD_BAR_WORDS 3456
#define XB_SPIN_CAP (1u << 18)

__device__ __forceinline__ unsigned xb_ld(unsigned* p)              { return __hip_atomic_load(p, __ATOMIC_RELAXED, __HIP_MEMORY_SCOPE_AGENT); }
__device__ __forceinline__ unsigned xb_add(unsigned* p, unsigned v) { return __hip_atomic_fetch_add(p, v, __ATOMIC_RELAXED, __HIP_MEMORY_SCOPE_AGENT); }
__device__ __forceinline__ unsigned xb_xcc_id() { return (unsigned)__builtin_amdgcn_s_getreg((3 << 11) | 20) & 0xFu; }
#define XB_SPIN(cond, bar) do { unsigned _sp = 0; while (cond) { __builtin_amdgcn_s_sleep(1); \
    if ((++_sp & 255u) == 0u) { if (xb_ld(&(bar)[XB_TMO])) break; if (_sp > XB_SPIN_CAP) { atomicAdd(&(bar)[XB_TMO], 1u); break; } } } } while (0)

struct XcdBarrier {
    unsigned* bar; unsigned x;
    volatile LAS unsigned* st;
};

__device__ __forceinline__ XcdBarrier xcd_barrier_post(unsigned* bar, volatile LAS unsigned* st) {
    XcdBarrier b; b.bar = bar; b.x = xb_xcc_id(); b.st = st;
    if (threadIdx.x == 0) (void)xb_add(&bar[XB_XCNT(b.x)], 1u);
    return b;
}
__device__ __forceinline__ void xcd_barrier_complete(unsigned* bar, unsigned x, unsigned& nloc, unsigned& nx) {
    const unsigned G = gridDim.x * gridDim.y * gridDim.z;
    unsigned sum, cnt, mine, sp = 0u;
    for (;;) {
        sum = 0u; cnt = 0u; mine = 0u;
#pragma unroll
        for (unsigned j = 0; j < 16; ++j) { const unsigned c = xb_ld(&bar[XB_XCNT(j)]); sum += c; cnt += (c > 0u) ? 1u : 0u; mine = (j == x) ? c : mine; }
        if (sum == G) break;
        __builtin_amdgcn_s_sleep(1);
        if ((++sp & 255u) == 0u) { if (xb_ld(&bar[XB_TMO])) break; if (sp > XB_SPIN_CAP) { atomicAdd(&bar[XB_TMO], 1u); break; } }
    }
    nloc = mine > 0u ? mine : 1u; nx = cnt > 0u ? cnt : 1u;
}

__device__ __forceinline__ void xcd_barrier(const XcdBarrier& b) {
    asm volatile("s_waitcnt vmcnt(0)" ::: "memory");
    __syncthreads();
    if (threadIdx.x == 0) {
        unsigned* bar = b.bar;
        __builtin_amdgcn_s_waitcnt(0);
        unsigned nloc = b.st[0], nx = b.st[1];
        if (nloc == 0u) { xcd_barrier_complete(bar, b.x, nloc, nx); b.st[0] = nloc; b.st[1] = nx; }
        const unsigned old = xb_add(&bar[XB_XSUB(b.x)], 1u);
        const unsigned gen = old / nloc;
        if (old + 1u == (gen + 1u) * nloc) {
            __builtin_amdgcn_fence(__ATOMIC_RELEASE, "agent");
            asm volatile("s_waitcnt vmcnt(0)" ::: "memory");
            const unsigned og = xb_add(&bar[XB_TOP], 1u);
            const unsigned tg = og / nx;
            if (og + 1u == (tg + 1u) * nx) xb_add(&bar[XB_TOPGEN], 1u);
            else XB_SPIN(xb_ld(&bar[XB_TOPGEN]) == tg, bar);
            __builtin_amdgcn_fence(__ATOMIC_ACQUIRE, "agent");
            xb_add(&bar[XB_XGEN(b.x)], 1u);
            asm volatile("s_waitcnt vmcnt(0)" ::: "memory");
        } else {
            XB_SPIN(xb_ld(&bar[XB_XGEN(b.x)]) == gen, bar);
            __builtin_amdgcn_fence(__ATOMIC_ACQUIRE, "agent");
            asm volatile("s_waitcnt vmcnt(0)" ::: "memory");
        }
    }
    __syncthreads();
}

struct Frame {
    LAS unsigned char* lds;
    volatile LAS unsigned* MISC;
    gu32* ctl;
    int tid, lane, wave;
    int vcu, G;
    unsigned char* ws;
    const float *x, *norm1_g, *w_in, *q_norm_g, *k_norm_g, *sgu_norm_g, *sgu_w, *sgu_b, *attn_out_g, *sgu_out_g, *w_out, *norm2_g, *w_query, *sub_keys, *expert_u, *expert_v;
    float* out;
    bf16 *Win_t, *Wout_t, *Wq_t, *SK, *SGUW, *XB, *Q, *QP, *MIX;
    float *RSTD1, *SSQA, *SSQS, *SSQ2P, *GATE, *HS, *CS, *MAXP, *HINV;
    signed char *U8, *H8, *V8; int* PA; unsigned* CQ;
    unsigned short* EIDX;
};

__device__ __forceinline__ float wave_sum(float v) {
#pragma unroll
    for (int o = 1; o < 64; o <<= 1) v += __shfl_xor(v, o);
    return v;
}

__device__ __forceinline__ void p0_transpose_item(const float* W, int K, int N, bf16* WT, const float* gain_a, const float* gain_b, int gsplit, LAS float* scr, int item, int lane, bool permute) {
    const int nblk = N / 32, kb = item / nblk, nb = item % nblk, k0 = 64 * kb, n0 = 32 * nb;
#pragma unroll 8
    for (int i = 0; i < 32; ++i) { const int kk = 2 * i + (lane >> 5); const int k = k0 + kk; const float gv = (k < gsplit) ? gain_a[k] : gain_b[k - gsplit];
        scr[kk * 33 + (lane & 31)] = __builtin_nontemporal_load((const GAS float*)(W + (size_t)k * N + n0 + (lane & 31))) * gv; }
    LDS_WAIT(); asm volatile("" ::: "memory");
    int orow0 = n0;
    if (permute) { const int l = n0 & 255; orow0 = (n0 & ~255) + 128 * ((l >> 5) & 1) + 32 * (l >> 6); }
    const int c = lane & 7;
#pragma unroll
    for (int j = 0; j < 4; ++j) { const int n = (lane >> 3) + 8 * j; const LAS float* s = scr + (8 * c) * 33 + n;
        v4u o; o.x = pk2(s[0 * 33], s[1 * 33]); o.y = pk2(s[2 * 33], s[3 * 33]); o.z = pk2(s[4 * 33], s[5 * 33]); o.w = pk2(s[6 * 33], s[7 * 33]);
        *(GAS v4u*)(WT + (size_t)(orow0 + n) * K + k0 + 8 * c) = o; }
    LDS_WAIT(); asm volatile("" ::: "memory");
}

__device__ __forceinline__ float row_to_bf16(const float* src, bf16* dst, const float* gain, int lane) {
    float ss = 0.f;
    f32x4 v[4];
#pragma unroll
    for (int j = 0; j < 4; ++j) v[j] = __builtin_nontemporal_load((const GAS f32x4*)(src + 4 * lane + 256 * j));
#pragma unroll
    for (int j = 0; j < 4; ++j) {
        f32x4 a = v[j];
        ss += (a[0] * a[0] + a[1] * a[1]) + (a[2] * a[2] + a[3] * a[3]);
        if (gain) a = a * *(const GAS f32x4*)(gain + 4 * lane + 256 * j);
        v2u o; o.x = pk2(a[0], a[1]); o.y = pk2(a[2], a[3]);
        *(GAS v2u*)(dst + 4 * lane + 256 * j) = o;
    }
    return ss;
}

__device__ __forceinline__ void p0_prologue(Frame& F) {
    LAS float* scr = (LAS float*)(F.lds + RING_OFF + F.wave * 16384);
    const int gw = F.vcu * NWAVES + F.wave, NGW = F.G * NWAVES;
    constexpr int I_IN = (DM / 64) * (INW / 32), I_OUT = (DM / 64) * (DM / 32), I_Q = (DM / 64) * (QPW / 32);
    for (int it = gw; it < I_IN + I_OUT + I_Q; it += NGW) {
        int r = it;
        if (r < I_IN) { p0_transpose_item(F.w_in, DM, INW, F.Win_t, F.norm1_g, F.norm1_g, DM, scr, r, F.lane, true); continue; } r -= I_IN;
        if (r < I_OUT) { p0_transpose_item(F.w_out, DM, DM, F.Wout_t, F.attn_out_g, F.sgu_out_g, AW, scr, r, F.lane, false); continue; } r -= I_OUT;
        p0_transpose_item(F.w_query, DM, QPW, F.Wq_t, F.norm2_g, F.norm2_g, DM, scr, r, F.lane, false);
    }
    for (int m = 2 * gw; m < TOK; m += 2 * NGW) {
        const float s0 = row_to_bf16(F.x + (size_t)m * DM, F.XB + (size_t)m * DM, nullptr, F.lane);
        const float s1 = row_to_bf16(F.x + (size_t)(m + 1) * DM, F.XB + (size_t)(m + 1) * DM, nullptr, F.lane);
        const float ss0 = wave_sum(s0), ss1 = wave_sum(s1);
        if (F.lane == 0) { F.RSTD1[m] = 1.0f / sqrtf(ss0 * (1.0f / DM) + pg8::EPS_F); F.RSTD1[m + 1] = 1.0f / sqrtf(ss1 * (1.0f / DM) + pg8::EPS_F); }
    }
    for (int e0 = 2 * gw; e0 < 2 * NEXP; e0 += 2 * NGW) {
        const bool isu = e0 < NEXP; const int r0 = isu ? e0 : e0 - NEXP;
        f32x4 v[2][4]; float mx[2] = {0.f, 0.f};
#pragma unroll
        for (int b = 0; b < 2; ++b) {
            const float* src = (isu ? F.expert_u : F.expert_v) + (size_t)(r0 + b) * DM + 4 * F.lane;
#pragma unroll
            for (int q = 0; q < 4; ++q) v[b][q] = __builtin_nontemporal_load((const GAS f32x4*)(src + 256 * q));
        }
#pragma unroll
        for (int b = 0; b < 2; ++b) {
#pragma unroll
            for (int q = 0; q < 4; ++q) { if (isu) v[b][q] = v[b][q] * *(const GAS f32x4*)(F.norm2_g + 4 * F.lane + 256 * q);
                mx[b] = fmaxf(mx[b], fmaxf(fmaxf(fabsf(v[b][q][0]), fabsf(v[b][q][1])), fmaxf(fabsf(v[b][q][2]), fabsf(v[b][q][3])))); }
#pragma unroll
            for (int o = 1; o < 64; o <<= 1) mx[b] = fmaxf(mx[b], __shfl_xor(mx[b], o));
            const float sc = fmaxf(mx[b], 1e-30f) * (1.0f / 127.0f), inv = 1.0f / sc; const int r = r0 + b;
            signed char* tab = isu ? F.U8 : F.V8;
#pragma unroll
            for (int q = 0; q < 4; ++q) { const int b0 = (int)rintf(v[b][q][0] * inv), b1 = (int)rintf(v[b][q][1] * inv), b2 = (int)rintf(v[b][q][2] * inv), b3 = (int)rintf(v[b][q][3] * inv);
                const unsigned o = (unsigned)(b0 & 0xff) | ((unsigned)(b1 & 0xff) << 8) | ((unsigned)(b2 & 0xff) << 16) | ((unsigned)(b3 & 0xff) << 24);
                *(GAS unsigned*)(tab + ((size_t)(2 * q + (F.lane >> 5)) * NEXP + r) * 128 + 4 * (F.lane & 31)) = o; }
            if (F.lane == 0) { float* scp = (float*)(F.ws + (isu ? WS_SCU : WS_SCV)); scp[r] = sc; }
        }
    }
    const int gt = F.vcu * NWAVES * 64 + F.tid, NGT = F.G * NWAVES * 64;
    for (int i = gt; i < 8 * 128 * 128; i += NGT) { const int g = i >> 14, t = (i >> 7) & 127, s = i & 127;
        const int o = ((((g * 4 + (t >> 5)) * 8 + (s >> 4)) * 64) + 32 * ((s >> 3) & 1) + (t & 31)) * 8 + (s & 7);
        F.SGUW[o] = (bf16)f2bf(s <= t ? F.sgu_w[i] : 0.f); }
    for (int i = gt; i < 2 * 128 * 128; i += NGT) F.SK[i] = (bf16)f2bf(F.sub_keys[i]);
}

constexpr int AT_OPITCH = 136;
constexpr int AT_OACC = 0, AT_LACC = 512 * AT_OPITCH, AT_VS = AT_LACC + 2048, AT_VS_WAVE = 32 * 128;
constexpr int AT_KS = AT_VS + NWAVES * AT_VS_WAVE, AT_KS_WAVE = 32 * 128;
static_assert(AT_KS + NWAVES * AT_KS_WAVE <= LDSCTL_OFF, "attention LDS");
__device__ __forceinline__ int at_rowmap(int p) { return (p & ~15) | ((p ^ (p >> 4)) & 15); }
__device__ __forceinline__ s16x4 vtr(const LAS unsigned char* p) { typedef short v4i16_t __attribute__((ext_vector_type(4))); return __builtin_bit_cast(s16x4, __builtin_amdgcn_ds_read_tr16_b64_v4i16((LAS v4i16_t*)p)); }

struct AtDesc { int b, h, span, dil, res, a; };
__device__ __forceinline__ AtDesc at_desc(int u, int stage, int idx) {
    AtDesc d; const int bh = u >> 3; d.b = bh >> 3; d.h = bh & 7; d.span = u & 7;
    if (stage == 0) { d.dil = 16; d.res = idx; d.a = d.span; }
    else if (stage == 1) { d.dil = 4; d.res = idx & 3; d.a = 4 * d.span + 2 * (idx >> 2); }
    else { d.dil = 1; d.res = 0; d.a = 16 * d.span + 2 * idx; }
    return d;
}
__device__ __forceinline__ void at_dma(LAS unsigned char* ks, LAS unsigned char* vs, const char* kptr, const char* vptr, size_t vrow8) {
#pragma unroll
    for (int it = 0; it < 4; ++it) __builtin_amdgcn_global_load_lds((const unsigned*)(kptr + it * vrow8), (LAS unsigned*)(ks + it * 1024), 16, 0, 0);
#pragma unroll
    for (int it = 0; it < 4; ++it) __builtin_amdgcn_global_load_lds((const unsigned*)(vptr + it * vrow8), (LAS unsigned*)(vs + it * 1024), 16, 0, 0);
}
__device__ __forceinline__ size_t at_koff(int lane, int h) { return (size_t)h * 128 + (size_t)((((lane & 7) ^ (lane >> 3)) & 7) << 4); }
__device__ __forceinline__ size_t at_voff(int lane, int h) { return (size_t)h * 128 + (size_t)(((lane & 7) ^ (((lane >> 4) & 1) << 2)) << 4); }
__device__ __forceinline__ void at_start(Frame& F, const AtDesc& d, int nt, bf16x8 (&qn)[2][4]) {
    const int lane = F.lane, r32 = lane & 31, hi = lane >> 5;
    const int j0 = (d.a >= 4) ? 0 : 4 - d.a;
    const size_t krow = (size_t)d.b * SEQ + d.res + (size_t)d.dil * (32 * (d.a - 4 + j0) + (lane >> 3));
    const char* kp = (const char*)(F.Q + WS_TYPE_STRIDE / 2) + krow * 1024; const char* vp = (const char*)(F.Q + 2 * (WS_TYPE_STRIDE / 2)) + krow * 1024;
    at_dma(F.lds + AT_KS + F.wave * AT_KS_WAVE, F.lds + AT_VS + F.wave * AT_VS_WAVE, kp + at_koff(lane, d.h), vp + at_voff(lane, d.h), (size_t)d.dil * 8 * 1024);
#pragma unroll
    for (int t = 0; t < 2; ++t) {
        const size_t qrow = (size_t)d.b * SEQ + d.res + (size_t)d.dil * (32 * (d.a + (t ? nt - 1 : 0)) + r32);
        const bf16* qp = F.Q + qrow * 512 + d.h * 64 + hi * 8;
#pragma unroll
        for (int d0 = 0; d0 < 4; ++d0) qn[t][d0] = *(const GAS bf16x8*)(qp + 16 * d0);
    }
}

template <int STAGE, int NT>
__device__ __forceinline__ void attn_task(Frame& F, const AtDesc& d, float sl, float mlog2, bf16x8 (&qn)[2][4], const AtDesc& nd, int nnt) {
    const int lane = F.lane, r32 = lane & 31, hi = lane >> 5;
    const int b = d.b, h = d.h, span = d.span, dil = d.dil, res = d.res, a = d.a;
    const size_t tokbase = (size_t)b * SEQ;
    LAS unsigned char* vs = F.lds + AT_VS + F.wave * AT_VS_WAVE;
    LAS unsigned char* ks = F.lds + AT_KS + F.wave * AT_KS_WAVE;
    bf16x8 qf[NT][4];
#pragma unroll
    for (int t = 0; t < NT; ++t)
#pragma unroll
        for (int d0 = 0; d0 < 4; ++d0) qf[t][d0] = qn[t][d0];
    f32x16 o[NT][2];
    float lsum[NT];
#pragma unroll
    for (int t = 0; t < NT; ++t) { o[t][0] = f32x16{}; o[t][1] = f32x16{}; lsum[t] = 0.f; }
    const float base_i = -sl * (float)(128 + r32) - mlog2 + sl * (float)(4 * hi);
    const int G = lane >> 4, gi = lane & 15, gq4 = gi >> 2, gp = gi & 3;
    const int j0 = (a >= 4) ? 0 : 4 - a;
    const size_t cstride = (size_t)dil * 32 * 1024, vrow8 = (size_t)dil * 8 * 1024;
    const size_t krow1 = tokbase + res + (size_t)dil * (32 * (a - 3 + j0) + (lane >> 3));
    const char* kptr = (const char*)(F.Q + WS_TYPE_STRIDE / 2) + krow1 * 1024 + at_koff(lane, h);
    const char* vptr = (const char*)(F.Q + 2 * (WS_TYPE_STRIDE / 2)) + krow1 * 1024 + at_voff(lane, h);
    bf16x8 kf[4], va[2][2];
#define AT_TOP() do { \
        asm volatile("s_waitcnt vmcnt(0)" ::: "memory"); \
        _Pragma("unroll") for (int d0 = 0; d0 < 4; ++d0) kf[d0] = *(const LAS bf16x8*)(ks + r32 * 128 + (((2 * d0 + hi) ^ (r32 & 7)) << 4)); \
          \
        _Pragma("unroll") for (int d0 = 0; d0 < 2; ++d0) \
            _Pragma("unroll") for (int ks_ = 0; ks_ < 2; ++ks_) { \
                const LAS unsigned char* pa = vs + (16 * ks_ + 4 * (G >> 1) + gq4) * 128 + ((64 * d0 + 32 * (G & 1) + 8 * gp) ^ (((gq4 >> 1) & 1) << 6)); \
                const s16x4 lo = vtr(pa), hi4 = vtr(pa + 8 * 128); \
                va[d0][ks_] = (bf16x8){lo[0], lo[1], lo[2], lo[3], hi4[0], hi4[1], hi4[2], hi4[3]}; } \
        LDS_WAIT(); } while (0)
#define AT_MATH(t, c) do { \
        f32x16 s; \
        const float bc = base_i + sl * (float)(32 * (c)); \
        _Pragma("unroll") for (int r = 0; r < 16; ++r) s[r] = bc + sl * (float)((r & 3) + 8 * (r >> 2)); \
        _Pragma("unroll") for (int d0 = 0; d0 < 4; ++d0) s = __builtin_amdgcn_mfma_f32_32x32x16_bf16(kf[d0], qf[t][d0], s, 0, 0, 0); \
          \
        const int dbase = 128 - 32 * (c) + r32 - 4 * hi; \
        float ls_ = lsum[t]; \
        if (((c) == 0) || ((c) == 4)) { \
            _Pragma("unroll") for (int r = 0; r < 16; ++r) { float p = __builtin_amdgcn_exp2f(s[r]); p = ((unsigned)(dbase - ((r & 3) + 8 * (r >> 2))) <= 128u) ? p : 0.f; s[r] = p; ls_ += p; } \
        } else { \
            _Pragma("unroll") for (int r = 0; r < 16; ++r) { const float p = __builtin_amdgcn_exp2f(s[r]); s[r] = p; ls_ += p; } \
        } \
        lsum[t] = ls_; \
        bf16x8 pb[2]; \
        _Pragma("unroll") for (int ks_ = 0; ks_ < 2; ++ks_) { v4u w; w.x = pk2(s[8 * ks_ + 0], s[8 * ks_ + 1]); w.y = pk2(s[8 * ks_ + 2], s[8 * ks_ + 3]); w.z = pk2(s[8 * ks_ + 4], s[8 * ks_ + 5]); w.w = pk2(s[8 * ks_ + 6], s[8 * ks_ + 7]); pb[ks_] = __builtin_bit_cast(bf16x8, w); } \
          \
        _Pragma("unroll") for (int d0 = 0; d0 < 2; ++d0) \
            _Pragma("unroll") for (int ks_ = 0; ks_ < 2; ++ks_) o[t][d0] = __builtin_amdgcn_mfma_f32_32x32x16_bf16(va[d0][ks_], pb[ks_], o[t][d0], 0, 0, 0); \
    } while (0)
#pragma unroll 1
    for (int j = j0; j < 3 + NT; ++j) {
        AT_TOP();
        at_dma(ks, vs, kptr, vptr, vrow8); kptr += cstride; vptr += cstride;
        AT_MATH(0, j);
        if (NT == 2) { if (j >= 1) AT_MATH(NT - 1, j - 1); }
    }
    AT_TOP();
    at_start(F, nd, nnt, qn);
    AT_MATH(NT - 1, 4);
#undef AT_MATH
#undef AT_TOP
    LAS float* lacc = (LAS float*)(F.lds + AT_LACC);
#pragma unroll
    for (int t = 0; t < NT; ++t) {
        float ls = lsum[t];
        ls += __shfl_xor(ls, 32);
        const int posq = res + dil * (32 * (a + t) + r32);
        const int pl = posq - span * 512;
        LAS unsigned char* orow = F.lds + AT_OACC + at_rowmap(pl) * AT_OPITCH;
        if (STAGE > 0) {
            ls += lacc[pl];
#pragma unroll
            for (int d0 = 0; d0 < 2; ++d0)
#pragma unroll
                for (int g4 = 0; g4 < 4; ++g4) { const v2u w = *(LAS v2u*)(orow + (32 * d0 + 8 * g4 + 4 * hi) * 2);
                    o[t][d0][4 * g4 + 0] += bf_lo(w.x); o[t][d0][4 * g4 + 1] += bf_hi(w.x); o[t][d0][4 * g4 + 2] += bf_lo(w.y); o[t][d0][4 * g4 + 3] += bf_hi(w.y); }
        }
        if (STAGE < 2) {
            if (hi == 0) lacc[pl] = ls;
#pragma unroll
            for (int d0 = 0; d0 < 2; ++d0)
#pragma unroll
                for (int g4 = 0; g4 < 4; ++g4) { v2u w; w.x = pk2(o[t][d0][4 * g4 + 0], o[t][d0][4 * g4 + 1]); w.y = pk2(o[t][d0][4 * g4 + 2], o[t][d0][4 * g4 + 3]);
                    *(LAS v2u*)(orow + (32 * d0 + 8 * g4 + 4 * hi) * 2) = w; }
        } else {
            const float inv = 1.0f / ls;
            float ss = 0.f;
#pragma unroll
            for (int d0 = 0; d0 < 2; ++d0)
#pragma unroll
                for (int g4 = 0; g4 < 4; ++g4) { const float a0 = o[t][d0][4 * g4 + 0] * inv, a1 = o[t][d0][4 * g4 + 1] * inv, a2 = o[t][d0][4 * g4 + 2] * inv, a3 = o[t][d0][4 * g4 + 3] * inv;
                    ss += (a0 * a0 + a1 * a1) + (a2 * a2 + a3 * a3);
                    v2u w; w.x = pk2(a0, a1); w.y = pk2(a2, a3);
                    *(LAS v2u*)(orow + (32 * d0 + 8 * g4 + 4 * hi) * 2) = w; }
            ss += __shfl_xor(ss, 32);
            if (hi == 0) F.SSQA[(tokbase + posq) * 8 + h] = ss;
            LDS_WAIT(); asm volatile("" ::: "memory");
#pragma unroll
            for (int it = 0; it < 4; ++it) { const int row = (lane >> 3) + 8 * it;
                const LAS unsigned char* src = F.lds + AT_OACC + at_rowmap(res + dil * (32 * (a + t) + row) - span * 512) * AT_OPITCH + (lane & 7) * 16;
                const v2u lo = *(const LAS v2u*)src, hi2 = *(const LAS v2u*)(src + 8);
                v4u ov; ov.x = lo.x; ov.y = lo.y; ov.z = hi2.x; ov.w = hi2.y;
                *(GAS v4u*)(F.MIX + (tokbase + res + (size_t)dil * (32 * (a + t) + row)) * 1024 + h * 64 + (lane & 7) * 8) = ov; }
            LDS_WAIT(); asm volatile("" ::: "memory");
        }
    }
}

__device__ __forceinline__ void attn_unit(Frame& F, int u, int un, float mlog2, bf16x8 (&qn)[2][4]) {
    const int h = (u >> 3) & 7;
    const float slope = __builtin_amdgcn_exp2f(-(float)(h + 1)) * 1.4426950408889634f;
    const int w = F.wave;
#pragma unroll 1
    for (int k = 0; k < 2; ++k) attn_task<0, 1>(F, at_desc(u, 0, 2 * w + k), slope * 16.f, mlog2, qn, k ? at_desc(u, 1, w) : at_desc(u, 0, 2 * w + 1), 1 + k);
    LDS_WAIT(); __syncthreads();
    attn_task<1, 2>(F, at_desc(u, 1, w), slope * 4.f, mlog2, qn, at_desc(u, 2, w), 2);
    LDS_WAIT(); __syncthreads();
    attn_task<2, 2>(F, at_desc(u, 2, w), slope, mlog2, qn, at_desc(un, 0, 2 * w), 1);
    LDS_WAIT(); __syncthreads();
}

constexpr int SG_PITCH = 192, SG_TILE = 128 * SG_PITCH;
static_assert(4 * SG_TILE <= RING_BYTES, "SGU LDS");
struct SguPre { v4u tile[4]; v4u sul[4]; };
constexpr int SG_SU_OFF = 4 * SG_TILE, SG_SU_WAVE = 32 * 144;
static_assert(SG_SU_OFF + NWAVES * SG_SU_WAVE <= LDSCTL_OFF, "SGU LDS");
__device__ __forceinline__ void sgu_load(Frame& F, int u, SguPre& p) {
    const int gp = u & 3, ch = (u >> 2) & 31, b = u >> 7;
    const int lane = F.lane, r32 = lane & 31, hi = lane >> 5, w = F.wave, gsel = w >> 2, tb = w & 3, g = 2 * gp + gsel, t = 32 * tb + r32;
    const size_t tok0 = (size_t)b * SEQ + (size_t)ch * 128;
    const bf16* SVN = F.Q + 4 * (WS_TYPE_STRIDE / 2); const bf16* SU = F.Q + 3 * (WS_TYPE_STRIDE / 2);
#pragma unroll
    for (int gg = 0; gg < 2; ++gg)
#pragma unroll
        for (int it = 0; it < 2; ++it) { const int idx = F.tid + 512 * it, s_ = idx >> 3, c8 = idx & 7;
            p.tile[2 * gg + it] = __builtin_nontemporal_load((const GAS v4u*)(SVN + (tok0 + s_) * 512 + (2 * gp + gg) * 64 + c8 * 8)); }
#pragma unroll
    for (int i = 0; i < 4; ++i) p.sul[i] = __builtin_nontemporal_load((const GAS v4u*)(SU + (tok0 + 32 * tb + (lane >> 3) + 8 * i) * 512 + g * 64 + (lane & 7) * 8));
}
__device__ __forceinline__ void sgu_phase(Frame& F) {
    const int lane = F.lane, r32 = lane & 31, hi = lane >> 5, w = F.wave, gsel = w >> 2, tb = w & 3, t = 32 * tb + r32;
    const int G = lane >> 4, gi = lane & 15, gq4 = gi >> 2, gpp = gi & 3;
    constexpr int NU = BATCH * 32 * 4;
    int u = F.vcu; if (u >= NU) return;
    bf16x8 wb[8]; float bias;
    { const int g = 2 * (u & 3) + gsel;
      const bf16* Wg = F.SGUW + ((size_t)(g * 4 + tb) * 8 * 64 + lane) * 8;
#pragma unroll
      for (int ks = 0; ks < 8; ++ks) wb[ks] = *(const GAS bf16x8*)(Wg + ks * 512);
      bias = F.sgu_b[g * 128 + t]; }
    SguPre pre; sgu_load(F, u, pre);
    for (int it_ = 0; u < NU; u += F.G, ++it_) {
        LAS unsigned char* buf = F.lds + (it_ & 1) * (2 * SG_TILE);
#pragma unroll
        for (int gg = 0; gg < 2; ++gg)
#pragma unroll
            for (int it = 0; it < 2; ++it) { const int idx = F.tid + 512 * it, s_ = idx >> 3, c8 = idx & 7; *(LAS v4u*)(buf + gg * SG_TILE + s_ * SG_PITCH + c8 * 16) = pre.tile[2 * gg + it]; }
        LAS unsigned char* sus = F.lds + SG_SU_OFF + w * SG_SU_WAVE;
#pragma unroll
        for (int i = 0; i < 4; ++i) *(LAS v4u*)(sus + ((lane >> 3) + 8 * i) * 144 + (lane & 7) * 16) = pre.sul[i];
        LDS_WAIT(); __syncthreads();
        const int un = (u + F.G < NU) ? u + F.G : u;
        sgu_load(F, un, pre);
        const int gp = u & 3, ch = (u >> 2) & 31, b = u >> 7, g = 2 * gp + gsel;
        const size_t tok0 = (size_t)b * SEQ + (size_t)ch * 128;
        const LAS unsigned char* ts = buf + gsel * SG_TILE;
        f32x16 acc[2]; acc[0] = f32x16{}; acc[1] = f32x16{};
#pragma unroll
        for (int ks = 0; ks < 8; ++ks) {
#pragma unroll
            for (int eb = 0; eb < 2; ++eb) {
                const LAS unsigned char* pa = ts + (16 * ks + 8 * (G >> 1) + gq4) * SG_PITCH + (32 * eb + 16 * (G & 1) + 4 * gpp) * 2;
                const s16x4 lo = vtr(pa), hi4 = vtr(pa + 4 * SG_PITCH);
                const bf16x8 va = (bf16x8){lo[0], lo[1], lo[2], lo[3], hi4[0], hi4[1], hi4[2], hi4[3]};
                acc[eb] = __builtin_amdgcn_mfma_f32_32x32x16_bf16(va, wb[ks], acc[eb], 0, 0, 0);
            }
        }
        float ss = 0.f;
#pragma unroll
        for (int eb = 0; eb < 2; ++eb)
#pragma unroll
            for (int g4 = 0; g4 < 4; ++g4) { const int e = 32 * eb + 8 * g4 + 4 * hi;
                const v2u sw = *(const LAS v2u*)(sus + r32 * 144 + e * 2);
                const float a0 = bf_lo(sw.x) * (acc[eb][4 * g4 + 0] + bias), a1 = bf_hi(sw.x) * (acc[eb][4 * g4 + 1] + bias), a2 = bf_lo(sw.y) * (acc[eb][4 * g4 + 2] + bias), a3 = bf_hi(sw.y) * (acc[eb][4 * g4 + 3] + bias);
                ss += (a0 * a0 + a1 * a1) + (a2 * a2 + a3 * a3);
                v2u wv; wv.x = pk2(a0, a1); wv.y = pk2(a2, a3); *(LAS v2u*)(sus + r32 * 144 + e * 2) = wv; }
        ss += __shfl_xor(ss, 32);
        if (hi == 0) F.SSQS[(tok0 + t) * 8 + g] = ss;
        LDS_WAIT(); asm volatile("" ::: "memory");
#pragma unroll
        for (int i = 0; i < 4; ++i) { const int row = (lane >> 3) + 8 * i; const v4u ov = *(const LAS v4u*)(sus + row * 144 + (lane & 7) * 16);
            *(GAS v4u*)(F.MIX + (tok0 + 32 * tb + row) * 1024 + 512 + g * 64 + (lane & 7) * 8) = ov; }
        LDS_WAIT(); asm volatile("" ::: "memory");
    }
    LDS_WAIT(); __syncthreads();
}

#ifndef P2_VARIANT
#define P2_VARIANT 0
#endif
__device__ __forceinline__ void p2_mixers(Frame& F) {
    float mq = fabsf(F.q_norm_g[F.lane]), mk = fabsf(F.k_norm_g[F.lane]);
#pragma unroll
    for (int o = 1; o < 64; o <<= 1) { mq = fmaxf(mq, __shfl_xor(mq, o)); mk = fmaxf(mk, __shfl_xor(mk, o)); }
    const float mlog2 = 8.0f * mq * mk * 1.4426950408889634f;
    {
        constexpr int NU = BATCH * 8 * 8;
        bf16x8 qn[2][4];
        if (F.vcu < NU) at_start(F, at_desc(F.vcu, 0, 2 * F.wave), 1, qn);
#pragma unroll 1
        for (int u = F.vcu; u < NU; u += F.G) attn_unit(F, u, (u + F.G < NU) ? u + F.G : u, mlog2, qn);
        asm volatile("s_waitcnt vmcnt(0)" ::: "memory"); __syncthreads();
    }
#pragma unroll 1
    for (int rep = 0; rep < (P2_VARIANT == 2 ? 2 : 1); ++rep)
    sgu_phase(F);
}

__device__ __forceinline__ unsigned f2ord(float f) { const unsigned u = __builtin_bit_cast(unsigned, f); return u ^ ((unsigned)((int)u >> 31) | 0x80000000u); }
__device__ __forceinline__ float ord2f(unsigned k) { const unsigned u = (k & 0x80000000u) ? (k ^ 0x80000000u) : ~k; return __builtin_bit_cast(float, u); }
#define CE_DESC(a, b) do { const unsigned _mx = max((a), (b)), _mn = min((a), (b)); (a) = _mx; (b) = _mn; } while (0)
__device__ __forceinline__ void sort16(unsigned (&k)[16]) {
#pragma unroll
    for (int k2 = 2; k2 <= 16; k2 <<= 1)
#pragma unroll
        for (int j = k2 >> 1; j > 0; j >>= 1)
#pragma unroll
            for (int i = 0; i < 16; ++i) { const int l = i ^ j; if (l > i) { if ((i & k2) == 0) CE_DESC(k[i], k[l]); else CE_DESC(k[l], k[i]); } }
}
__device__ __forceinline__ void merge16(unsigned (&a)[16], const unsigned (&b)[16]) {
#pragma unroll
    for (int i = 0; i < 16; ++i) a[i] = max(a[i], b[15 - i]);
#pragma unroll
    for (int j = 8; j > 0; j >>= 1)
#pragma unroll
        for (int i = 0; i < 16; ++i) { const int l = i ^ j; if (l > i) CE_DESC(a[i], a[l]); }
}
__device__ __forceinline__ void swap16(const unsigned (&x)[16], const unsigned (&y)[16], unsigned (&xo)[16], unsigned (&yo)[16]) {
#pragma unroll
    for (int i = 0; i < 16; ++i) { auto rr = __builtin_amdgcn_permlane32_swap(x[i], y[i], false, false); xo[i] = rr[0]; yo[i] = rr[1]; }
}

__host__ __device__ constexpr int cand0(int q) { return q < 16 ? q : q < 21 ? 0x20 + (q - 16) : q < 24 ? 0x40 + (q - 21) : q < 26 ? 0x60 + (q - 24) : q == 26 ? 0x80 : q == 27 ? 0xa0 : q == 28 ? 0xc0 : q == 29 ? 0xe0 : 0xff; }
__host__ __device__ constexpr int cand1(int q) { return q < 8 ? 0x10 + q : q < 12 ? 0x30 + (q - 8) : q < 14 ? 0x50 + (q - 12) : q < 16 ? 0x70 + (q - 14) : q == 16 ? 0x90 : q == 17 ? 0xb0 : q == 18 ? 0xd0 : q == 19 ? 0xf0 : 0xff; }

constexpr int TK_SK_BYTES = 2 * 128 * 256;
constexpr int TK_LDS_WAVE = 32 * 32 * 4, TK_SCR_OFF = TK_SK_BYTES;
static_assert(TK_SCR_OFF + NWAVES * TK_LDS_WAVE <= RING_BYTES, "top-k LDS");
__device__ __forceinline__ void tk_load_q(Frame& F, size_t t0, int hd, int half, int r32, int hi, bf16x8 (&qf)[8]) {
#pragma unroll
    for (int i = 0; i < 8; ++i) qf[i] = __builtin_nontemporal_load((const GAS bf16x8*)(F.QP + ((((t0 >> 5) * 8 + hd) * 2 + half) * 8 + i) * 512 + (size_t)(32 * hi + r32) * 8));
}
template <int HALF_> __device__ __forceinline__ void half_top16(Frame& F, const bf16x8 (&qf)[8], int r32, int hi, unsigned (&best)[16]) {
#pragma unroll
    for (int nb = 0; nb < 4; ++nb) {
        f32x16 acc;
#pragma unroll
        for (int r = 0; r < 16; ++r) acc[r] = 64.0f;
        const int row = HALF_ * 128 + 32 * nb + r32;
#pragma unroll
        for (int ks = 0; ks < 8; ++ks) { const bf16x8 a = *(const LAS bf16x8*)(F.lds + row * 256 + (((2 * ks + hi) ^ (row & 15)) << 4));
            acc = __builtin_amdgcn_mfma_f32_32x32x16_bf16(a, qf[ks], acc, 0, 0, 0); }
        unsigned k[16];
#pragma unroll
        for (int r = 0; r < 16; ++r) { const int n = 32 * nb + (r & 3) + 8 * (r >> 2) + 4 * hi; k[r] = (__builtin_bit_cast(unsigned, __builtin_amdgcn_fmed3f(acc[r], 4.0f, 124.0f)) & ~127u) | (unsigned)(127 - n); }
        sort16(k);
        if (nb == 0) {
#pragma unroll
            for (int i = 0; i < 16; ++i) best[i] = k[i];
        } else merge16(best, k);
    }
}

__device__ __forceinline__ void topk_task(Frame& F, int tb, int hd, bf16x8 (&qa)[8], bool has_next, int tb_next, int hd_next) {
    const int lane = F.lane, r32 = lane & 31, hi = lane >> 5;
    const size_t t0 = (size_t)tb * 32;
    unsigned bk[2][16];
    bf16x8 qb[8];
    tk_load_q(F, t0, hd, 1, r32, hi, qb);
    half_top16<0>(F, qa, r32, hi, bk[0]);
    if (has_next) tk_load_q(F, (size_t)tb_next * 32, hd_next, 0, r32, hi, qa);
    half_top16<1>(F, qb, r32, hi, bk[1]);
    unsigned xa[16], ya[16];
    swap16(bk[0], bk[1], xa, ya);
    merge16(xa, ya);
    unsigned A[16], B[16];
    swap16(xa, xa, A, B);
    LAS unsigned* tk = (LAS unsigned*)(F.lds + TK_SCR_OFF + F.wave * TK_LDS_WAVE) + r32 * 32;
#pragma unroll
    for (int i = 0; i < 16; ++i) tk[16 * hi + i] = hi ? B[i] : A[i];
    float v1[16], v2[16];
#pragma unroll
    for (int i = 0; i < 16; ++i) { v1[i] = __builtin_bit_cast(float, A[i] & ~127u); v2[i] = __builtin_bit_cast(float, B[i] & ~127u); }
    unsigned c0[16], c1[16];
#pragma unroll
    for (int q = 0; q < 32; ++q) {
        const int ij0 = cand0(q), ij1 = cand1(q);
        const float s0 = (ij0 == 0xff) ? 0.0f : v1[ij0 >> 4] + v2[ij0 & 15];
        const float s1 = (ij1 == 0xff) ? 0.0f : v1[ij1 >> 4] + v2[ij1 & 15];
        const unsigned k0 = (__builtin_bit_cast(unsigned, s0) & ~255u) | (unsigned)(ij0 & 255), k1 = (__builtin_bit_cast(unsigned, s1) & ~255u) | (unsigned)(ij1 & 255);
        const unsigned kk = hi ? k1 : k0;
        if (q < 16) c0[q] = kk; else c1[q - 16] = kk;
    }
    sort16(c0); sort16(c1); merge16(c0, c1);
    unsigned L0[16], L1[16];
    swap16(c0, c0, L0, L1);
    merge16(L0, L1);
    const float mx = __builtin_bit_cast(float, L0[0] & ~255u);
    float ex[16], den = 0.f;
#pragma unroll
    for (int i = 0; i < 16; ++i) { ex[i] = __expf(__builtin_bit_cast(float, L0[i] & ~255u) - mx); den += ex[i]; }
    const float rden = 1.0f / den;
    LDS_WAIT(); asm volatile("" ::: "memory");
    int ei[8]; float gt[8];
#pragma unroll
    for (int kk = 0; kk < 8; ++kk) {
        const unsigned key = hi ? L0[8 + kk] : L0[kk]; const float e = hi ? ex[8 + kk] : ex[kk];
        const int i = (key >> 4) & 15, j = key & 15;
        const int i1 = 127 - (int)(tk[i] & 127u), i2 = 127 - (int)(tk[16 + j] & 127u);
        ei[kk] = i1 * 128 + i2; gt[kk] = e * rden;
    }
    unsigned short* ep = F.EIDX + (t0 + r32) * 128 + hd * 16 + 8 * hi; float* gp = F.GATE + (t0 + r32) * 128 + hd * 16 + 8 * hi;
    *(GAS v4u*)ep = (v4u){(unsigned)ei[0] | ((unsigned)ei[1] << 16), (unsigned)ei[2] | ((unsigned)ei[3] << 16), (unsigned)ei[4] | ((unsigned)ei[5] << 16), (unsigned)ei[6] | ((unsigned)ei[7] << 16)};
    *(GAS f32x4*)gp = (f32x4){gt[0], gt[1], gt[2], gt[3]}; *(GAS f32x4*)(gp + 4) = (f32x4){gt[4], gt[5], gt[6], gt[7]};
    LDS_WAIT(); asm volatile("" ::: "memory");
}

__device__ __forceinline__ void p5_topk(Frame& F) {
    for (int i = F.tid; i < 2 * 128 * 16; i += NWAVES * 64) { const int row = i >> 4, ch = i & 15;
        *(LAS v4u*)(F.lds + row * 256 + ((ch ^ (row & 15)) << 4)) = *(const GAS v4u*)(F.SK + (size_t)row * 128 + ch * 8); }
    LDS_WAIT(); __syncthreads();
    pg8::StaticOrder S; S.init(TOK, QPW, F.G, (int)blockIdx.x);
    pg8::Unit u, un;
    bf16x8 qf[8];
    bool have = S.next(0, u);
    if (have) tk_load_q(F, (size_t)(u.pm * 8 + F.wave) * 32, u.pn, 0, F.lane & 31, F.lane >> 5, qf);
#pragma unroll 1
    for (int i = 0; have; ++i) {
        const bool hn = S.next(i + 1, un);
        topk_task(F, u.pm * 8 + F.wave, u.pn, qf, hn, un.pm * 8 + F.wave, un.pn);
        u = un; have = hn;
    }
    LDS_WAIT(); __syncthreads();
}

constexpr int PE_TPI = 32, PE_NITEM = TOK / PE_TPI;
constexpr int CW_QA = 8192, CW_QB = 8192 + 8 * 64;

template <int CTRL> __device__ __forceinline__ int dpp_i(int v) { return __builtin_amdgcn_update_dpp(0, v, CTRL, 0xf, 0xf, true); }
template <int CTRL> __device__ __forceinline__ float dpp_f(float v) { return __builtin_bit_cast(float, __builtin_amdgcn_update_dpp(0, __builtin_bit_cast(int, v), CTRL, 0xf, 0xf, true)); }
constexpr int DPP_XOR1 = 0xB1, DPP_XOR2 = 0x4E, DPP_HMIRROR = 0x141, DPP_ROR8 = 0x128;

__device__ __forceinline__ void pe_load_ix(Frame& F, int t, v4u (&ix)[2]) {
    const int gl = F.lane >> 3;
#pragma unroll
    for (int q = 0; q < 2; ++q) ix[q] = *(const GAS v4u*)(F.EIDX + (size_t)t * 128 + gl * 16 + 8 * q);
}
__device__ __forceinline__ void pe_load_rows(const void* TAB, const v4u (&ix)[2], int coloff, v4u (&w)[16]) {
#pragma unroll
    for (int i = 0; i < 16; ++i) { const unsigned pr = ix[i >> 3][(i >> 1) & 3]; const unsigned e = (i & 1) ? (pr >> 16) : (pr & 0xffffu);
        w[i] = *(const GAS v4u*)((const char*)TAB + (size_t)e * 128 + coloff); }
}
__device__ __forceinline__ v4u pe_quant16(const v4u& lo, const v4u& hi, float inv) {
    v4u o;
#pragma unroll
    for (int q = 0; q < 4; ++q) { const unsigned w0 = (q < 2) ? lo[2 * q] : hi[2 * q - 4], w1 = (q < 2) ? lo[2 * q + 1] : hi[2 * q - 3];
        const int b0 = (int)rintf(bf_lo(w0) * inv), b1 = (int)rintf(bf_hi(w0) * inv), b2 = (int)rintf(bf_lo(w1) * inv), b3 = (int)rintf(bf_hi(w1) * inv);
        o[q] = (unsigned)(b0 & 0xff) | ((unsigned)(b1 & 0xff) << 8) | ((unsigned)(b2 & 0xff) << 16) | ((unsigned)(b3 & 0xff) << 24); }
    return o;
}
__device__ __forceinline__ void peA_compute(Frame& F, int* PA, int j, int t, const v4u& hq, const v4u (&w)[16]) {
    const int gl = F.lane >> 3, sub = F.lane & 7;
    int r0 = 0, r1 = 0;
#pragma unroll
    for (int i = 0; i < 16; ++i) {
        int p = __builtin_amdgcn_sdot4((int)w[i].x, (int)hq.x, 0, false);
        p = __builtin_amdgcn_sdot4((int)w[i].y, (int)hq.y, p, false); p = __builtin_amdgcn_sdot4((int)w[i].z, (int)hq.z, p, false); p = __builtin_amdgcn_sdot4((int)w[i].w, (int)hq.w, p, false);
        p += dpp_i<DPP_XOR1>(p); p += dpp_i<DPP_XOR2>(p); p += dpp_i<DPP_HMIRROR>(p);
        if (i < 8) r0 = (sub == i) ? p : r0; else r1 = (sub == i - 8) ? p : r1;
    }
    const unsigned pk = ((unsigned)((r0 + 32) >> 6) & 0xffffu) | ((unsigned)((r1 + 32) >> 6) << 16);
    ((unsigned*)PA)[((size_t)j * TOK + t) * 64 + gl * 8 + sub] = pk;
}
__device__ __forceinline__ void peB_compute(Frame& F, int j, int t, const v4u& cq, float cs, const v4u (&w)[16]) {
    const int lane = F.lane, gl = lane >> 3, sub = lane & 7;
    typedef float f32x2_t __attribute__((ext_vector_type(2)));
    const int mycol = 128 * j + 2 * lane;
    const unsigned xw = *(const GAS unsigned*)(F.XB + (size_t)t * DM + mycol);
    f32x2_t xin; xin.x = bf_lo(xw); xin.y = bf_hi(xw);
    int acc[16];
#pragma unroll
    for (int c = 0; c < 16; ++c) acc[c] = 0;
#pragma unroll
    for (int m = 0; m < 4; ++m)
#pragma unroll
        for (int q = 0; q < 4; ++q) {
            const unsigned a0 = w[4 * m + 0][q], a1 = w[4 * m + 1][q], a2 = w[4 * m + 2][q], a3 = w[4 * m + 3][q];
            const unsigned t0 = __builtin_amdgcn_perm(a1, a0, 0x05010400u), t1 = __builtin_amdgcn_perm(a1, a0, 0x07030602u);
            const unsigned t2 = __builtin_amdgcn_perm(a3, a2, 0x05010400u), t3 = __builtin_amdgcn_perm(a3, a2, 0x07030602u);
            const unsigned o0 = __builtin_amdgcn_perm(t2, t0, 0x05040100u), o1 = __builtin_amdgcn_perm(t2, t0, 0x07060302u);
            const unsigned o2 = __builtin_amdgcn_perm(t3, t1, 0x05040100u), o3 = __builtin_amdgcn_perm(t3, t1, 0x07060302u);
            acc[4 * q + 0] = __builtin_amdgcn_sdot4((int)o0, (int)cq[m], acc[4 * q + 0], false); acc[4 * q + 1] = __builtin_amdgcn_sdot4((int)o1, (int)cq[m], acc[4 * q + 1], false);
            acc[4 * q + 2] = __builtin_amdgcn_sdot4((int)o2, (int)cq[m], acc[4 * q + 2], false); acc[4 * q + 3] = __builtin_amdgcn_sdot4((int)o3, (int)cq[m], acc[4 * q + 3], false);
        }
    int h8v[8];
#pragma unroll
    for (int c = 0; c < 8; ++c) { auto rr = __builtin_amdgcn_permlane32_swap((unsigned)acc[c], (unsigned)acc[c + 8], false, false);
        unsigned r0 = rr[0], r1 = rr[1]; asm volatile("" : "+v"(r0), "+v"(r1));
        h8v[c] = (int)r0 + (int)r1; }
    const bool b4 = (lane >> 4) & 1, b3 = (lane >> 3) & 1;
    int h4[4];
#pragma unroll
    for (int c = 0; c < 4; ++c) { const int keep = b4 ? h8v[c + 4] : h8v[c], give = b4 ? h8v[c] : h8v[c + 4]; h4[c] = keep + __builtin_amdgcn_ds_swizzle(give, 0x401F); }
    int h2[2];
#pragma unroll
    for (int c = 0; c < 2; ++c) { const int keep = b3 ? h4[c + 2] : h4[c], give = b3 ? h4[c] : h4[c + 2]; h2[c] = keep + dpp_i<DPP_ROR8>(give); }
    const int srcl = ((lane >> 3) + 8 * (lane & 1) + 16 * ((lane >> 1) & 1) + 32 * ((lane >> 2) & 1)) * 4;
    const int q0 = __builtin_amdgcn_ds_bpermute(srcl, h2[0]), q1 = __builtin_amdgcn_ds_bpermute(srcl, h2[1]);
    f32x2_t o; o.x = xin.x + cs * (float)q0; o.y = xin.y + cs * (float)q1;
    __builtin_nontemporal_store(o, (GAS f32x2_t*)(F.out + (size_t)t * DM + mycol));
}

template <bool PHASE_B> __device__ __forceinline__ void p6_sliced(Frame& F) {
    const unsigned x = xb_xcc_id() & 7u;
    gu32* Q = F.ctl + (PHASE_B ? CW_QB : CW_QA);
    const int sub = F.lane & 7, gl = F.lane >> 3, rowoff = 16 * sub;
    const char* TAB0 = (const char*)(PHASE_B ? (const void*)F.V8 : (const void*)F.U8);
    unsigned s = 0; int j = 0, t0 = 0; bool have = false;
    for (; s < 8; ++s) {
        j = (int)((x + s) & 7u);
        unsigned c = 0;
        if (F.lane == 0) c = __hip_atomic_fetch_add((unsigned*)(Q + 64 * j), 1u, __ATOMIC_RELAXED, __HIP_MEMORY_SCOPE_AGENT);
        c = (unsigned)__builtin_amdgcn_readfirstlane((int)c);
        if (c < (unsigned)PE_NITEM) { t0 = (int)c * PE_TPI; have = true; break; }
    }
    if (!have) return;
    v4u ixA[2], ixB[2], wA[16], wB[16], auxA, auxB, aux2A = {}, aux2B = {}; float csA = 0.f, csB = 0.f;
#define PE_AUX(jj, t, aux, aux2, cs) do { if (PHASE_B) { aux = *(const GAS v4u*)(F.CQ + (size_t)(t) * 32 + gl * 4); cs = F.CS[t]; } \
        else { aux = *(const GAS v4u*)(F.XB + (size_t)(t) * DM + 128 * (jj) + 16 * sub); aux2 = *(const GAS v4u*)(F.XB + (size_t)(t) * DM + 128 * (jj) + 16 * sub + 8); cs = F.HINV[t]; } } while (0)
#define PE_COMPUTE(jj, t, aux, aux2, cs, w) do { if (PHASE_B) peB_compute(F, (jj), (t), aux, cs, w); else peA_compute(F, F.PA, (jj), (t), pe_quant16(aux, aux2, cs), w); } while (0)
#define PE_TAB(jj) ((const void*)(TAB0 + (size_t)(jj) * NEXP * 128))
    pe_load_ix(F, t0, ixA); pe_load_rows(PE_TAB(j), ixA, rowoff, wA); PE_AUX(j, t0, auxA, aux2A, csA); pe_load_ix(F, t0 + 1, ixB);
    for (;;) {
        unsigned vn = 0;
        if (F.lane == 0) vn = __hip_atomic_fetch_add((unsigned*)(Q + 64 * j), 1u, __ATOMIC_RELAXED, __HIP_MEMORY_SCOPE_AGENT);
        const void* TAB = PE_TAB(j);
#pragma unroll 1
        for (int k = 0; k < PE_TPI - 2; k += 2) {
            pe_load_rows(TAB, ixB, rowoff, wB); PE_AUX(j, t0 + k + 1, auxB, aux2B, csB);
            pe_load_ix(F, t0 + k + 2, ixA);
            PE_COMPUTE(j, t0 + k, auxA, aux2A, csA, wA);
            pe_load_rows(TAB, ixA, rowoff, wA); PE_AUX(j, t0 + k + 2, auxA, aux2A, csA); pe_load_ix(F, t0 + k + 3, ixB);
            PE_COMPUTE(j, t0 + k + 1, auxB, aux2B, csB, wB);
        }
        unsigned cn = (unsigned)__builtin_amdgcn_readfirstlane((int)vn);
        int jn = j; bool hn = cn < (unsigned)PE_NITEM;
        if (!hn) {
            for (++s; s < 8; ++s) {
                const int j2 = (int)((x + s) & 7u);
                unsigned c = 0;
                if (F.lane == 0) c = __hip_atomic_fetch_add((unsigned*)(Q + 64 * j2), 1u, __ATOMIC_RELAXED, __HIP_MEMORY_SCOPE_AGENT);
                c = (unsigned)__builtin_amdgcn_readfirstlane((int)c);
                if (c < (unsigned)PE_NITEM) { cn = c; jn = j2; hn = true; break; }
            }
        }
        const int tn = hn ? (int)cn * PE_TPI : t0;
        pe_load_rows(TAB, ixB, rowoff, wB); PE_AUX(j, t0 + PE_TPI - 1, auxB, aux2B, csB);
        pe_load_ix(F, tn, ixA);
        PE_COMPUTE(j, t0 + PE_TPI - 2, auxA, aux2A, csA, wA);
        pe_load_rows(PE_TAB(jn), ixA, rowoff, wA); PE_AUX(jn, tn, auxA, aux2A, csA); pe_load_ix(F, tn + 1, ixB);
        PE_COMPUTE(j, t0 + PE_TPI - 1, auxB, aux2B, csB, wB);
        if (!hn) break;
        j = jn; t0 = tn;
    }
#undef PE_TAB
#undef PE_AUX
#undef PE_COMPUTE
}

__device__ __forceinline__ void p6_fill_scales(Frame& F) {
    const char* src = (const char*)F.ws + (F.wave < 4 ? (size_t)WS_SCU + (size_t)F.wave * 16384 : (size_t)WS_SCV + (size_t)(F.wave - 4) * 16384) + F.lane * 16;
    LAS unsigned char* dst = F.lds + F.wave * 16384;
#pragma unroll
    for (int i = 0; i < 16; ++i) __builtin_amdgcn_global_load_lds((const unsigned*)(src + i * 1024), (LAS unsigned*)(dst + i * 1024), 16, 0, 0);
}
__device__ __forceinline__ void p6_reduce(Frame& F) {
    const int gw = F.vcu * NWAVES + F.wave, NGW = F.G * NWAVES, lane = F.lane;
    const int p0 = 16 * (lane >> 3) + (lane & 7);
    constexpr int NB = 4;
    asm volatile("s_waitcnt vmcnt(0)" ::: "memory"); __syncthreads();
    const LAS float* lscu = (const LAS float*)F.lds; const LAS float* lscv = (const LAS float*)(F.lds + 65536);
    for (int tb = gw * NB; tb < TOK; tb += NGW * NB) {
        int s[NB][2], e[NB][2]; float gt[NB][2], hs[NB];
#pragma unroll
        for (int b = 0; b < NB; ++b) {
            const int t = tb + b; hs[b] = F.HS[t];
            int a0 = 0, a1 = 0;
#pragma unroll
            for (int j = 0; j < 8; ++j) { const unsigned w = __builtin_nontemporal_load((const GAS unsigned*)F.PA + ((size_t)j * TOK + t) * 64 + lane); a0 += (int)(short)(w & 0xffffu); a1 += (int)w >> 16; }
            s[b][0] = a0; s[b][1] = a1;
#pragma unroll
            for (int hh = 0; hh < 2; ++hh) { const int p = p0 + 8 * hh; e[b][hh] = (int)F.EIDX[(size_t)t * 128 + p]; gt[b][hh] = F.GATE[(size_t)t * 128 + p]; }
        }
        float su[NB][2], sv[NB][2];
#pragma unroll
        for (int b = 0; b < NB; ++b)
#pragma unroll
            for (int hh = 0; hh < 2; ++hh) { su[b][hh] = lscu[e[b][hh]]; sv[b][hh] = lscv[e[b][hh]]; }
#pragma unroll
        for (int b = 0; b < NB; ++b) {
            const int t = tb + b;
            float cf[2]; float mx = 0.f;
#pragma unroll
            for (int hh = 0; hh < 2; ++hh) { const float a = hs[b] * su[b][hh] * (64.0f * (float)s[b][hh]);
                cf[hh] = gt[b][hh] * 0.5f * a * (1.0f + erff(a * 0.70710678118654752f)) * sv[b][hh]; mx = fmaxf(mx, fabsf(cf[hh])); }
#pragma unroll
            for (int o = 1; o < 64; o <<= 1) mx = fmaxf(mx, __shfl_xor(mx, o));
            const float sc = fmaxf(mx, 1e-30f) * (1.0f / 127.0f), inv = 1.0f / sc;
#pragma unroll
            for (int hh = 0; hh < 2; ++hh) {
                int v = ((int)rintf(cf[hh] * inv) & 0xff) << (8 * (lane & 3));
                v |= dpp_i<DPP_XOR1>(v); v |= dpp_i<DPP_XOR2>(v);
                if ((lane & 3) == 0) F.CQ[(size_t)t * 32 + ((p0 + 8 * hh) >> 2)] = (unsigned)v;
            }
            if (lane == 0) F.CS[t] = sc;
        }
    }
}

__device__ __forceinline__ void p5_scales(Frame& F) {
    const int gt = F.vcu * NWAVES * 64 + F.tid, NGT = F.G * NWAVES * 64;
    for (int t = gt; t < TOK; t += NGT) {
        float mx = 0.f, ss = 0.f;
#pragma unroll
        for (int q = 0; q < 4; ++q) { const f32x4 m = *(const GAS f32x4*)(F.MAXP + (size_t)t * 16 + 4 * q), p = *(const GAS f32x4*)(F.SSQ2P + (size_t)t * 16 + 4 * q);
            mx = fmaxf(mx, fmaxf(fmaxf(m[0], m[1]), fmaxf(m[2], m[3]))); ss += (p[0] + p[1]) + (p[2] + p[3]); }
        const float rstd2 = 1.0f / sqrtf(ss * (1.0f / DM) + pg8::EPS_F), sc = fmaxf(mx, 1e-20f) * (1.0f / 127.0f);
        F.HINV[t] = 1.0f / sc; F.HS[t] = sc * rstd2;
    }
}

#ifndef PROBE_REPEAT
#define PROBE_REPEAT -1
#endif
struct Args { const float* in[16]; float* out; unsigned char* ws; int ph_lo, ph_hi; };

template <class Sched> __device__ __forceinline__ void prep_tab_outproj(Frame& F, const Sched& S) {
    LAS float* tab = (LAS float*)(F.lds + TAB_OFF);
    pg8::Unit u;
    for (int i = 0; S.next(i, u) && i < 4; ++i) {
        if (F.tid < 256) {
            const int row = u.pm * 256 + F.tid;
            const f32x4 a0 = *(const GAS f32x4*)(F.SSQA + (size_t)row * 8), a1 = *(const GAS f32x4*)(F.SSQA + (size_t)row * 8 + 4);
            const f32x4 s0 = *(const GAS f32x4*)(F.SSQS + (size_t)row * 8), s1 = *(const GAS f32x4*)(F.SSQS + (size_t)row * 8 + 4);
            const float sa = ((a0[0] + a0[1]) + (a0[2] + a0[3])) + ((a1[0] + a1[1]) + (a1[2] + a1[3]));
            const float ss = ((s0[0] + s0[1]) + (s0[2] + s0[3])) + ((s1[0] + s1[1]) + (s1[2] + s1[3]));
            const float ra = 1.0f / sqrtf(sa * (1.0f / 512.0f) + pg8::EPS_F), rs = 1.0f / sqrtf(ss * (1.0f / 512.0f) + pg8::EPS_F);
            tab[(i * 256 + F.tid) * 2] = ra / rs; tab[(i * 256 + F.tid) * 2 + 1] = rs;
        }
    }
    LDS_WAIT(); __syncthreads();
}
template <class Sched> __device__ __forceinline__ void prep_tab_query(Frame& F, const Sched& S) {
    LAS float* tab = (LAS float*)(F.lds + TAB_OFF);
    pg8::Unit u;
    for (int i = 0; S.next(i, u) && i < 8; ++i) {
        if (F.tid < 256) {
            const int row = u.pm * 256 + F.tid; float s = 0.f;
#pragma unroll
            for (int j = 0; j < 4; ++j) { const f32x4 p = *(const GAS f32x4*)(F.SSQ2P + (size_t)row * 16 + 4 * j); s += (p[0] + p[1]) + (p[2] + p[3]); }
            tab[i * 256 + F.tid] = 1.0f / sqrtf(s * (1.0f / DM) + pg8::EPS_F);
        }
    }
    LDS_WAIT(); __syncthreads();
}

template <class Sched> __device__ __forceinline__ void prep_tab_inproj(Frame& F, const Sched& S) {
    LAS float* tab = (LAS float*)(F.lds + TAB_OFF);
    LAS float* gtab = (LAS float*)(F.lds + TAB_OFF + 8192);
    pg8::Unit u;
    for (int i = 0; S.next(i, u) && i < 8; ++i)
        if (F.tid < 256) tab[i * 256 + F.tid] = F.RSTD1[u.pm * 256 + F.tid];
    for (int i = F.tid; i < 640; i += NWAVES * 64) gtab[i] = (i < 64) ? F.q_norm_g[i] * pg8::QSCALE : (i < 128) ? F.k_norm_g[i - 64] : F.sgu_norm_g[i - 128];
    LDS_WAIT(); __syncthreads();
}
__device__ __forceinline__ void run_p1(Frame& F) {
    pg8::Gemm g{F.XB, F.Win_t, TOK, INW, DM}; pg8::StaticOrder S; S.init(TOK, INW, F.G, (int)blockIdx.x);
    prep_tab_inproj(F, S);
    pg8::EpiInProj E{(const LAS float*)(F.lds + TAB_OFF), (const LAS float*)(F.lds + TAB_OFF + 8192), F.Q, WS_TYPE_STRIDE / 2};
    pg8::gemm_phase<pg8::EpiInProj, pg8::StaticOrder, true, true>(F.lds + RING_OFF, g, S, E);
}
__device__ __forceinline__ void run_p3(Frame& F) {
    pg8::Gemm g{F.MIX, F.Wout_t, TOK, DM, DM}; pg8::StaticOrder S; S.init(TOK, DM, F.G, (int)blockIdx.x);
    prep_tab_outproj(F, S);
    pg8::EpiOutProj E{F.x, F.out, F.XB, F.SSQ2P, F.MAXP, (const LAS float*)(F.lds + TAB_OFF)};
    pg8::gemm_phase<pg8::EpiOutProj, pg8::StaticOrder, true, true>(F.lds + RING_OFF, g, S, E);
}
__device__ __forceinline__ void run_p4(Frame& F) {
    pg8::Gemm g{F.XB, F.Wq_t, TOK, QPW, DM}; pg8::StaticOrder S; S.init(TOK, QPW, F.G, (int)blockIdx.x);
    prep_tab_query(F, S);
    pg8::EpiQuery E{F.QP, (const LAS float*)(F.lds + TAB_OFF)};
    pg8::gemm_phase<pg8::EpiQuery, pg8::StaticOrder, true, true>(F.lds + RING_OFF, g, S, E);
}

__global__ void __launch_bounds__(NWAVES * 64, 2) hyb_fwd(Args args) {
    extern __shared__ __attribute__((aligned(16))) unsigned char lds[];
    Frame F;
    F.lds = (LAS unsigned char*)lds;
    F.MISC = (volatile LAS unsigned*)(F.lds + MISC_OFF);
    F.tid = threadIdx.x; F.lane = F.tid & 63; F.wave = __builtin_amdgcn_readfirstlane(F.tid >> 6);
    F.G = gridDim.x; { const int bx = blockIdx.x; F.vcu = (F.G % 8 == 0) ? (bx % 8) * (F.G / 8) + bx / 8 : bx; }
    unsigned char* ws = args.ws;
    F.ctl = (gu32*)(ws + WS_CTL);
    F.x = args.in[0]; F.norm1_g = args.in[1]; F.w_in = args.in[2]; F.q_norm_g = args.in[3]; F.k_norm_g = args.in[4]; F.sgu_norm_g = args.in[5]; F.sgu_w = args.in[6]; F.sgu_b = args.in[7];
    F.attn_out_g = args.in[8]; F.sgu_out_g = args.in[9]; F.w_out = args.in[10]; F.norm2_g = args.in[11]; F.w_query = args.in[12]; F.sub_keys = args.in[13]; F.expert_u = args.in[14]; F.expert_v = args.in[15];
    F.out = args.out;
    F.Win_t = (bf16*)(ws + WS_WIN); F.Wout_t = (bf16*)(ws + WS_WOUT); F.Wq_t = (bf16*)(ws + WS_WQ); F.SK = (bf16*)(ws + WS_SK); F.SGUW = (bf16*)(ws + WS_SGUW);
    F.U8 = (signed char*)(ws + WS_UB); F.V8 = (signed char*)(ws + WS_VB); F.ws = ws;
    F.H8 = (signed char*)(ws + WS_H8); F.MAXP = (float*)(ws + WS_MAXP); F.HINV = (float*)(ws + WS_HINV); F.HS = (float*)(ws + WS_HS); F.PA = (int*)(ws + WS_PA); F.CQ = (unsigned*)(ws + WS_COEF); F.CS = (float*)(ws + WS_COEF0);
    F.XB = (bf16*)(ws + WS_XB); F.Q = (bf16*)(ws + WS_Q); F.QP = (bf16*)(ws + WS_QP); F.MIX = (bf16*)(ws + WS_MIX);
    F.RSTD1 = (float*)(ws + WS_RSTD1); F.SSQA = (float*)(ws + WS_SSQA); F.SSQS = (float*)(ws + WS_SSQS); F.SSQ2P = (float*)(ws + WS_SSQ2P); F.GATE = (float*)(ws + WS_GATE); F.EIDX = (unsigned short*)(ws + WS_EIDX);
    for (int u = F.tid; u < (LDS_BYTES - LDSCTL_OFF) / 4; u += NWAVES * 64) ((LAS unsigned*)(F.lds + LDSCTL_OFF))[u] = 0u;
    __syncthreads();
    XcdBarrier bar; bar.bar = (unsigned*)(F.ctl + CW_BAR); bar.x = 0; bar.st = nullptr;
    const int lo = args.ph_lo, hi = args.ph_hi;
    if (hi - lo > 1) bar = xcd_barrier_post((unsigned*)(F.ctl + CW_BAR), F.MISC + 8);
#define IN(k) (lo <= (k) && (k) < hi)

#define SEAM(k) do { if (IN(k) && IN((k) + 1)) { xcd_barrier(bar); if (PROBE_REPEAT == 100 + (k)) { xcd_barrier(bar); xcd_barrier(bar); xcd_barrier(bar); xcd_barrier(bar); } } } while (0)

    if (IN(0)) { p0_prologue(F); if (PROBE_REPEAT == 0) { xcd_barrier(bar); p0_prologue(F); } } SEAM(0);
    if (IN(1)) { run_p1(F); if (PROBE_REPEAT == 1) { xcd_barrier(bar); run_p1(F); } } SEAM(1);
    if (IN(2)) { p2_mixers(F); if (PROBE_REPEAT == 2) { xcd_barrier(bar); p2_mixers(F); } } SEAM(2);
    if (IN(3)) { run_p3(F); if (PROBE_REPEAT == 3) { xcd_barrier(bar); run_p3(F); } } SEAM(3);
    if (IN(4)) { run_p4(F); if (PROBE_REPEAT == 4) { xcd_barrier(bar); run_p4(F); } }
    if (!(IN(4) && IN(5))) {   } else { asm volatile("s_waitcnt vmcnt(0)" ::: "memory"); __syncthreads(); }
    if (IN(5)) {
#pragma unroll 1
        for (int rep = 0; rep < (PROBE_REPEAT == 5 ? 2 : 1); ++rep) p5_topk(F);
#pragma unroll 1
        for (int rep = 0; rep < (PROBE_REPEAT == 15 ? 2 : 1); ++rep) p5_scales(F);
    } SEAM(5);
    if (IN(6)) {
        p6_fill_scales(F);
#pragma unroll 1
        for (int rep = 0; rep < (PROBE_REPEAT == 6 ? 2 : 1); ++rep) {
            if (rep) { xcd_barrier(bar); if (blockIdx.x == 0 && F.tid < 8) __hip_atomic_store((unsigned*)(F.ctl + CW_QA + 64 * F.tid), 0u, __ATOMIC_RELAXED, __HIP_MEMORY_SCOPE_AGENT); xcd_barrier(bar); }
            p6_sliced<false>(F);
        }
        if (hi - lo > 1) xcd_barrier(bar);
#pragma unroll 1
        for (int rep = 0; rep < (PROBE_REPEAT == 7 ? 2 : 1); ++rep) p6_reduce(F);
        if (hi - lo > 1) xcd_barrier(bar);
#pragma unroll 1
        for (int rep = 0; rep < (PROBE_REPEAT == 8 ? 2 : 1); ++rep) {
            if (rep) { xcd_barrier(bar); if (blockIdx.x == 0 && F.tid < 8) __hip_atomic_store((unsigned*)(F.ctl + CW_QB + 64 * F.tid), 0u, __ATOMIC_RELAXED, __HIP_MEMORY_SCOPE_AGENT); xcd_barrier(bar); }
            p6_sliced<true>(F);
        }
    }
#undef IN
#undef SEAM
}

extern "C" void kernel_launch(void* const* d_in, const int* in_sizes, int n_in, void* d_out, int out_size, void* d_ws, size_t ws_size, hipStream_t stream) {
    static int grid = 0;
    if (grid == 0) {
        if (n_in != 16 || in_sizes[0] != TOK * DM || out_size != TOK * DM || ws_size < WS_END) { fprintf(stderr, "kernel_launch: unexpected shapes (n_in %d, in0 %d, out %d, ws %zu)\n", n_in, n_in > 0 ? in_sizes[0] : -1, out_size, ws_size); grid = -1; return; }
        int dev = 0, cus = 0, per_cu = 0;
        if (hipGetDevice(&dev) != hipSuccess || hipDeviceGetAttribute(&cus, hipDeviceAttributeMultiprocessorCount, dev) != hipSuccess) { fprintf(stderr, "kernel_launch: device query failed\n"); grid = -1; return; }
        if (hipFuncSetAttribute((const void*)hyb_fwd, hipFuncAttributeMaxDynamicSharedMemorySize, LDS_BYTES) != hipSuccess) { fprintf(stderr, "kernel_launch: hipFuncSetAttribute failed\n"); grid = -1; return; }
        if (hipOccupancyMaxActiveBlocksPerMultiprocessor(&per_cu, (const void*)hyb_fwd, NWAVES * 64, LDS_BYTES) != hipSuccess || per_cu < 1) { fprintf(stderr, "kernel_launch: occupancy query reports %d blocks per CU\n", per_cu); per_cu = 1; }
        (void)hipGetLastError();
        grid = cus;
        if (grid % 8 != 0) grid -= grid % 8;
    }
    if (grid < 0) return;
    (void)hipMemsetAsync((char*)d_ws + WS_CTL, 0, CTL_ZERO_BYTES, stream);
    Args a{};
    for (int i = 0; i < 16; ++i) a.in[i] = (const float*)d_in[i];
    a.out = (float*)d_out; a.ws = (unsigned char*)d_ws;
    if (N_LAUNCHES == 1) { a.ph_lo = 0; a.ph_hi = NPHASE; hipLaunchKernelGGL(hyb_fwd, dim3(grid), dim3(NWAVES * 64), LDS_BYTES, stream, a); }
    else for (int li = 0; li < NPHASE; ++li) { a.ph_lo = li; a.ph_hi = li + 1; hipLaunchKernelGGL(hyb_fwd, dim3(grid), dim3(NWAVES * 64), LDS_BYTES, stream, a); }
}
```
